# Optimizing an MI355X kernel written in HIP

```python
import math
import jax, jax.numpy as jnp
from jax import lax
import numpy as np

D_MODEL = 1024
BATCH = 8
SEQ = 2048
DEPTH = 2

GRID_W = 64
CTX_LEN = 256
D_HYENA = D_MODEL
D_LRU = D_MODEL
D_SC = D_MODEL
HYENA_ORDER = 2
HYENA_CONV_W = 3
HYENA_EMB_DIM = 33
HYENA_FILTER_W = 64
HYENA_FAST_DECAY = 0.3
HYENA_SLOW_DECAY = 1.5
HYENA_TARGET = 1e-2
HYENA_MAX_DECAY = math.log(HYENA_TARGET) / HYENA_FAST_DECAY
HYENA_MIN_DECAY = math.log(HYENA_TARGET) / HYENA_SLOW_DECAY
LRU_HEADS = 16
LRU_BLOCK = D_LRU // LRU_HEADS
LRU_CONV_W = 4
LRU_C = 8.0
SC_CONV_W = 3
N_EXPERTS = 16
EC_CAPACITY = 2
D_EXPERT = 2816
NORM_EPS = 1e-6
OFF_LRU_GATE = 3 * D_HYENA
OFF_LRU_REC = OFF_LRU_GATE + D_LRU
OFF_SC = OFF_LRU_REC + D_LRU
OFF_GATE = OFF_SC + 3 * D_SC
D_IN_PROJ = OFF_GATE + 3 * D_MODEL

kernel_name = 'hybrid_hyena_rglru_shortconv_ecmoe_dit'


def rmsnorm(x, g):
    xf = x.astype(jnp.float32)
    y = xf * lax.rsqrt(jnp.mean(xf * xf, axis=-1, keepdims=True) + NORM_EPS)
    return (y * g.astype(jnp.float32)).astype(x.dtype)


def modulate(x, shift, scale):
    return x * (1.0 + scale) + shift


def dwconv(x, w, b, left):
    K = w.shape[0]
    L = x.shape[1]
    xp = jnp.pad(x, ((0, 0), (left, K - 1 - left), (0, 0)))
    y = sum(xp[:, k:k + L] * w[k] for k in range(K))
    return y if b is None else y + b


def sincos_1d(pos, dim):
    half = dim // 2
    omega = 1.0 / (10000.0 ** (jnp.arange(half, dtype=jnp.float32) / half))
    ang = pos[:, None] * omega[None, :]
    return jnp.concatenate([jnp.sin(ang), jnp.cos(ang)], axis=-1)


def grid_pos_embed(rows):
    half = D_MODEL // 2
    emb_r = sincos_1d(jnp.arange(rows, dtype=jnp.float32), half)
    emb_c = sincos_1d(jnp.arange(GRID_W, dtype=jnp.float32), half)
    emb = jnp.concatenate([jnp.broadcast_to(emb_r[:, None, :], (rows, GRID_W, half)),
                           jnp.broadcast_to(emb_c[None, :, :], (rows, GRID_W, half))], axis=-1)
    return emb.reshape(rows * GRID_W, D_MODEL)


def hyena_frequency_response(L, w1, b1, w2, b2, w3, freq):
    f32 = jnp.float32
    bands = (HYENA_EMB_DIM - 1) // 2
    t01 = jnp.linspace(0.0, 1.0, L, dtype=f32)[:, None]
    w = (2.0 * math.pi / L) * jnp.arange(L, dtype=f32)[:, None]
    f = jnp.linspace(1e-4, bands - 1, bands, dtype=f32)[None, :]
    feats = jnp.concatenate([t01, jnp.cos(f * w), -jnp.sin(f * w)], axis=-1)
    h = jnp.sin(freq * (feats @ w1 + b1))
    h = jnp.sin(freq * (h @ w2 + b2))
    h = (h @ w3).astype(f32).reshape(L, HYENA_ORDER, 2, D_HYENA)
    deltas = jnp.linspace(HYENA_MIN_DECAY, HYENA_MAX_DECAY, D_HYENA, dtype=f32)
    h = h * jnp.exp(-t01 * jnp.abs(deltas))[:, None, None, :]
    fwd = h[:, :, 0]
    bwd = h[:0:-1, :, 1]
    buf = jnp.concatenate([fwd, jnp.zeros_like(fwd[:1]), bwd], axis=0)
    buf = buf / jnp.sum(jnp.abs(buf), axis=0, keepdims=True)
    return jnp.fft.rfft(buf, axis=0)


def fft_conv(u, kf, bias):
    L = u.shape[1]
    uf32 = u.astype(jnp.float32)
    uf = jnp.fft.rfft(uf32, n=2 * L, axis=1)
    y = jnp.fft.irfft(uf * kf[None], n=2 * L, axis=1)[:, :L]
    return (y + uf32 * bias.astype(jnp.float32)).astype(u.dtype)


def hyena_mixer(proj, conv_w, conv_b, kf, bias):
    u = dwconv(proj, conv_w, conv_b, HYENA_CONV_W // 2)
    x1, x2, v = jnp.split(u, 3, axis=-1)
    z = x1 * fft_conv(v, kf[:, 0], bias[0])
    return x2 * fft_conv(z, kf[:, 1], bias[1])


def _linear_combine(p, q):
    a1, b1 = p
    a2, b2 = q
    return a1 * a2, a2 * b1 + b2


def rglru(xc, wa, ba, wx, bx, lam, h0, reverse):
    B, L, _ = xc.shape
    xf = xc.astype(jnp.float32)
    xb = xf.reshape(B, L, LRU_HEADS, LRU_BLOCK)
    r = jax.nn.sigmoid(jnp.einsum('blhi,hij->blhj', xb, wa).reshape(B, L, D_LRU) + ba)
    i = jax.nn.sigmoid(jnp.einsum('blhi,hij->blhj', xb, wx).reshape(B, L, D_LRU) + bx)
    log_a = -LRU_C * r * jax.nn.softplus(-lam.astype(jnp.float32))
    a = jnp.exp(log_a)
    b = jnp.sqrt(-jnp.expm1(2.0 * log_a)) * (i * xf)
    first = L - 1 if reverse else 0
    b = b.at[:, first].add(a[:, first] * h0.astype(jnp.float32))
    _, h = lax.associative_scan(_linear_combine, (a, b), reverse=reverse, axis=1)
    return h.astype(xc.dtype)


def lru_scans(rec_in, p, h0_f, h0_b):
    xc = dwconv(rec_in, p['lru_conv_w'], p['lru_conv_b'], LRU_CONV_W // 2)
    hf = rglru(xc, p['lru_wa'][0], p['lru_ba'][0], p['lru_wx'][0], p['lru_bx'][0], p['lru_lambda'][0], h0_f, False)
    hb = rglru(xc, p['lru_wa'][1], p['lru_ba'][1], p['lru_wx'][1], p['lru_bx'][1], p['lru_lambda'][1], h0_b, True)
    return hf, hb


def shortconv_mixer(proj, conv_w):
    bg, cg, xv = jnp.split(proj, 3, axis=-1)
    return bg * dwconv(cg * xv, conv_w, None, SC_CONV_W // 2)


def mixer_sublayer(h, p, h0_f, h0_b):
    L = h.shape[1]
    proj = h @ p['w_in']
    hy_in, lru_gate, lru_rec, sc_in, gate_logits = jnp.split(proj, [OFF_LRU_GATE, OFF_LRU_REC, OFF_SC, OFF_GATE], axis=-1)
    kf = hyena_frequency_response(L, p['hy_filt_w1'], p['hy_filt_b1'], p['hy_filt_w2'], p['hy_filt_b2'], p['hy_filt_w3'], p['hy_filt_freq'])
    y_a = hyena_mixer(hy_in, p['hy_conv_w'], p['hy_conv_b'], kf, p['hy_bias'])
    hf, hb = lru_scans(lru_rec, p, h0_f, h0_b)
    y_b = jax.nn.gelu(lru_gate) * (hf + hb)
    y_c = shortconv_mixer(sc_in, p['sc_conv_w'])
    g_a, g_b, g_c = jnp.split(jax.nn.sigmoid(gate_logits), 3, axis=-1)
    merged = g_a * (y_a @ p['w_hy_out']) + g_b * (y_b @ p['w_lru_out']) + g_c * (y_c @ p['w_sc_out'])
    return merged @ p['w_o'], hf[:, -1], hb[:, 0]


def ec_moe(h, w_router, wg, wu, wd):
    n, d = h.shape[1], h.shape[2]
    cap = EC_CAPACITY * n // N_EXPERTS

    def per_set(hs):
        aff = jax.nn.softmax((hs @ w_router).astype(jnp.float32), axis=-1)
        gate, idx = lax.top_k(aff.T, cap)
        xs = hs[idx]
        hid = jax.nn.silu(jnp.einsum('ecd,edf->ecf', xs, wg)) * jnp.einsum('ecd,edf->ecf', xs, wu)
        ys = jnp.einsum('ecf,efd->ecd', hid, wd) * gate[..., None].astype(hs.dtype)
        return jnp.zeros_like(hs).at[idx.reshape(-1)].add(ys.reshape(-1, d))

    return jax.vmap(per_set)(h)


def setup_inputs(seed: int = 0) -> dict:
    key = jax.random.key(seed)
    ks = iter(jax.random.split(key, 48))
    f32 = jnp.float32

    def nrm(shape, scale):
        return scale * jax.random.normal(next(ks), shape, f32)

    D = D_MODEL
    a0 = jax.random.uniform(next(ks), (DEPTH, 2, D_LRU), f32, 0.9, 0.999) ** (1.0 / LRU_C)
    lru_lambda = jnp.log(a0) - jnp.log1p(-a0)
    return {
        'x': nrm((BATCH, SEQ, D), 1.0),
        'c': nrm((BATCH, D), 1.0),
        'ctx': nrm((BATCH, CTX_LEN, D), 1.0),
        'c_ctx': nrm((D,), 1.0),
        'w_ada': nrm((DEPTH, D, 6 * D), 0.02),
        'b_ada': nrm((DEPTH, 6 * D), 0.02),
        'norm1_g': 1.0 + nrm((DEPTH, D), 0.05),
        'norm2_g': 1.0 + nrm((DEPTH, D), 0.05),
        'w_in': nrm((DEPTH, D, D_IN_PROJ), D ** -0.5),
        'hy_conv_w': nrm((DEPTH, HYENA_CONV_W, 3 * D_HYENA), HYENA_CONV_W ** -0.5),
        'hy_conv_b': nrm((DEPTH, 3 * D_HYENA), 0.02),
        'hy_filt_w1': nrm((DEPTH, HYENA_EMB_DIM, HYENA_FILTER_W), HYENA_EMB_DIM ** -0.5),
        'hy_filt_b1': nrm((DEPTH, HYENA_FILTER_W), 0.1),
        'hy_filt_w2': nrm((DEPTH, HYENA_FILTER_W, HYENA_FILTER_W), HYENA_FILTER_W ** -0.5),
        'hy_filt_b2': nrm((DEPTH, HYENA_FILTER_W), 0.1),
        'hy_filt_w3': nrm((DEPTH, HYENA_FILTER_W, HYENA_ORDER * 2 * D_HYENA), HYENA_FILTER_W ** -0.5),
        'hy_filt_freq': 1.0 + nrm((DEPTH, HYENA_FILTER_W), 0.05),
        'hy_bias': nrm((DEPTH, HYENA_ORDER, D_HYENA), 1.0),
        'lru_conv_w': nrm((DEPTH, LRU_CONV_W, D_LRU), LRU_CONV_W ** -0.5),
        'lru_conv_b': nrm((DEPTH, D_LRU), 0.02),
        'lru_wa': nrm((DEPTH, 2, LRU_HEADS, LRU_BLOCK, LRU_BLOCK), LRU_BLOCK ** -0.5),
        'lru_ba': nrm((DEPTH, 2, D_LRU), 0.02),
        'lru_wx': nrm((DEPTH, 2, LRU_HEADS, LRU_BLOCK, LRU_BLOCK), LRU_BLOCK ** -0.5),
        'lru_bx': nrm((DEPTH, 2, D_LRU), 0.02),
        'lru_lambda': lru_lambda,
        'sc_conv_w': nrm((DEPTH, SC_CONV_W, D_SC), SC_CONV_W ** -0.5),
        'w_hy_out': nrm((DEPTH, D_HYENA, D), D_HYENA ** -0.5),
        'w_lru_out': nrm((DEPTH, D_LRU, D), D_LRU ** -0.5),
        'w_sc_out': nrm((DEPTH, D_SC, D), D_SC ** -0.5),
        'w_o': nrm((DEPTH, D, D), D ** -0.5),
        'w_router': nrm((DEPTH, D, N_EXPERTS), D ** -0.5),
        'w_exp_gate': nrm((DEPTH, N_EXPERTS, D, D_EXPERT), D ** -0.5),
        'w_exp_up': nrm((DEPTH, N_EXPERTS, D, D_EXPERT), D ** -0.5),
        'w_exp_down': nrm((DEPTH, N_EXPERTS, D_EXPERT, D), D_EXPERT ** -0.5),
        'final_norm_g': 1.0 + nrm((D,), 0.05),
    }


def reference(x, c, ctx, c_ctx, w_ada, b_ada, norm1_g, norm2_g, w_in, hy_conv_w, hy_conv_b,
              hy_filt_w1, hy_filt_b1, hy_filt_w2, hy_filt_b2, hy_filt_w3, hy_filt_freq, hy_bias,
              lru_conv_w, lru_conv_b, lru_wa, lru_ba, lru_wx, lru_bx, lru_lambda, sc_conv_w,
              w_hy_out, w_lru_out, w_sc_out, w_o, w_router, w_exp_gate, w_exp_up, w_exp_down,
              final_norm_g):
    B, n_lat, _ = x.shape
    ROWS = n_lat // GRID_W
    x = x + grid_pos_embed(ROWS).astype(x.dtype)[None]
    xc = ctx
    zeros_state = jnp.zeros((B, D_LRU), jnp.float32)
    for l in range(DEPTH):
        last = l == DEPTH - 1
        p = {
            'w_in': w_in[l], 'hy_conv_w': hy_conv_w[l], 'hy_conv_b': hy_conv_b[l],
            'hy_filt_w1': hy_filt_w1[l], 'hy_filt_b1': hy_filt_b1[l], 'hy_filt_w2': hy_filt_w2[l],
            'hy_filt_b2': hy_filt_b2[l], 'hy_filt_w3': hy_filt_w3[l], 'hy_filt_freq': hy_filt_freq[l],
            'hy_bias': hy_bias[l], 'lru_conv_w': lru_conv_w[l], 'lru_conv_b': lru_conv_b[l],
            'lru_wa': lru_wa[l], 'lru_ba': lru_ba[l], 'lru_wx': lru_wx[l], 'lru_bx': lru_bx[l],
            'lru_lambda': lru_lambda[l], 'sc_conv_w': sc_conv_w[l], 'w_hy_out': w_hy_out[l],
            'w_lru_out': w_lru_out[l], 'w_sc_out': w_sc_out[l], 'w_o': w_o[l],
        }
        mod_l = jnp.split((jax.nn.silu(c) @ w_ada[l] + b_ada[l])[:, None, :], 6, axis=-1)
        mod_c = jnp.split((jax.nn.silu(c_ctx) @ w_ada[l] + b_ada[l])[None, None, :], 6, axis=-1)
        h_lat = modulate(rmsnorm(x, norm1_g[l]), mod_l[0], mod_l[1])
        h_ctx = modulate(rmsnorm(xc, norm1_g[l]), mod_c[0], mod_c[1])
        if last:
            hf_c, hb_c = lru_scans(h_ctx @ p['w_in'][:, OFF_LRU_REC:OFF_SC], p, zeros_state, zeros_state)
            state_f, state_b = hf_c[:, -1], hb_c[:, 0]
        else:
            out_c, state_f, state_b = mixer_sublayer(h_ctx, p, zeros_state, zeros_state)
            xc = xc + mod_c[2] * out_c
            hc2 = modulate(rmsnorm(xc, norm2_g[l]), mod_c[3], mod_c[4])
            xc = xc + mod_c[5] * ec_moe(hc2, w_router[l], w_exp_gate[l], w_exp_up[l], w_exp_down[l])
        out_l, _, _ = mixer_sublayer(h_lat, p, state_f, state_b)
        x = x + mod_l[2] * out_l
        h2 = modulate(rmsnorm(x, norm2_g[l]), mod_l[3], mod_l[4])
        x = x + mod_l[5] * ec_moe(h2, w_router[l], w_exp_gate[l], w_exp_up[l], w_exp_down[l])
    return rmsnorm(x, final_norm_g)
```

```cpp
#include <hip/hip_runtime.h>
#include <cstdio>
#include <cstdint>
namespace pg8 {
#define PG8_LAS __attribute__((address_space(3)))
typedef unsigned short bf16_t;
typedef short bf16x8 __attribute__((ext_vector_type(8)));
typedef float f32x4 __attribute__((ext_vector_type(4)));
typedef unsigned u32x4 __attribute__((ext_vector_type(4)));
constexpr int BM = 256, BK = 64, HALF = 128, HTB = HALF * BK * 2  , STAGE_BYTES = 8 * HTB, NXCD = 8, WGM = 8;

__host__ __device__ __forceinline__ int lds_byte(int r, int c) { const int st = (r >> 4) * 2 + (c >> 5), rr = r & 15, cc = c & 31, ob = rr * 64 + cc * 2; return st * 1024 + (ob ^ (((ob >> 9) & 1) << 5)); }
__host__ __device__ __forceinline__ void stage_rc(int b, int& R, int& C) { const int st = b / 1024, sb = b % 1024, swz = sb ^ (((sb >> 9) & 1) << 5); R = (st >> 1) * 16 + swz / 64; C = (st & 1) * 32 + (swz % 64) / 2; }
__host__ __device__ __forceinline__ int perm32(int rho) { const int n = rho >> 4, i = rho & 15; return 8 * (i >> 2) + 4 * n + (i & 3); }

struct Unit { int pm, pn; };
struct Gemm { const bf16_t* A; const bf16_t* Bt; int M, N, K; };

struct StaticOrder {
    int nM, nN, nwg, G, c;
    __host__ __device__ void init(int M, int N, int G_, int c_) { nM = M / BM; nN = N / BM; nwg = nM * nN; G = G_; c = c_; }
    __host__ __device__ bool next(int i, Unit& u) const {
        const long L = (long)i * G + c; if (L >= nwg) return false;
        int wgid = (int)L; { const int q = nwg / NXCD, r = nwg % NXCD, xcd = wgid % NXCD, off = wgid / NXCD; wgid = (xcd < r ? xcd * (q + 1) : r * (q + 1) + (xcd - r) * q) + off; }
        const int nig = WGM * nN, gid = wgid / nig, fm = gid * WGM, gsz = (nM - fm) < WGM ? (nM - fm) : WGM;
        u.pm = fm + ((wgid % nig) % gsz); u.pn = (wgid % nig) / gsz; return true;
    }
    __device__ __forceinline__ void a_ready(const Unit&) const {}
    __device__ __forceinline__ void done(const Unit&) const {}
};
__device__ __forceinline__ unsigned cvt_pk_bf16(float lo, float hi) { unsigned r; asm volatile("v_cvt_pk_bf16_f32 %0, %1, %2" : "=v"(r) : "v"(lo), "v"(hi)); return r; }
typedef float f32x2 __attribute__((ext_vector_type(2)));
template <class Epi, class Sched, bool ALIGN_EPI = false, bool SP2 = false>
__device__ __forceinline__ void gemm_phase(PG8_LAS unsigned char* lds, const Gemm g, const Sched& S, const Epi& E) {
    int tid_ = threadIdx.x; asm volatile("" : "+v"(tid_));
    const int tid = tid_, wid = __builtin_amdgcn_readfirstlane(tid >> 6), lane = tid & 63, wr = wid >> 2, wc = wid & 3, fr = lane & 15, fq = lane >> 4;
    const int K = g.K, nt = K / BK;
    unsigned voffA[2], voffB[2];
#pragma unroll
    for (int i = 0; i < 2; ++i) { int R, C; stage_rc(tid * 16 + i * 8192, R, C); const int Rb = Epi::PERM ? ((R & ~31) + perm32(R & 31)) : R;
        voffA[i] = (unsigned)(R * K + C) * 2u; voffB[i] = (unsigned)(Rb * K + C) * 2u; }
    const size_t kstep = (size_t)(BK * 2);
    const size_t hstep = (size_t)HALF * K * 2;
    const size_t tstep = 2 * hstep;
    const unsigned ldsw = (unsigned)wid * 1024u;
    const int aoff = lds_byte(wr * 64 + fr, fq * 8), boff = lds_byte(wc * 32 + fr, fq * 8);
#define PG8_SA(b, h) (((b) * 2 + (h)) * HTB)
#define PG8_SB(b, h) ((4 + (b) * 2 + (h)) * HTB)
#define PG8_STAGE(bufoff, gbase, voff) do { _Pragma("unroll") for (int _i = 0; _i < 2; ++_i) \
        __builtin_amdgcn_global_load_lds((const unsigned*)((const char*)(gbase) + (voff)[_i]), (PG8_LAS unsigned*)(lds + (bufoff) + ldsw + _i * 8192), 16, 0, 0); } while (0)
#define PG8_LDA(dst, b, h) do { _Pragma("unroll") for (int m = 0; m < 4; ++m) _Pragma("unroll") for (int k = 0; k < 2; ++k) dst[m][k] = *(const PG8_LAS bf16x8*)(lds + PG8_SA(b, h) + aoff + m * 2048 + k * 1024); } while (0)
#define PG8_LDB(dst, b, h) do { _Pragma("unroll") for (int n = 0; n < 2; ++n) _Pragma("unroll") for (int k = 0; k < 2; ++k) dst[n][k] = *(const PG8_LAS bf16x8*)(lds + PG8_SB(b, h) + boff + n * 2048 + k * 1024); } while (0)
#define PG8_MMA(ai, bj, At, Bt) do { __builtin_amdgcn_s_setprio(1); _Pragma("unroll") for (int m = 0; m < 4; ++m) _Pragma("unroll") for (int n = 0; n < 2; ++n) _Pragma("unroll") for (int k = 0; k < 2; ++k) \
        acc[ai][bj][m][n] = __builtin_amdgcn_mfma_f32_16x16x32_bf16(Bt[n][k], At[m][k], acc[ai][bj][m][n], 0, 0, 0); __builtin_amdgcn_s_setprio(0); } while (0)
#define PG8_WAIT_V(n) asm volatile("s_waitcnt vmcnt(" #n ")" ::: "memory")
#define PG8_WAIT_L(n) asm volatile("s_waitcnt lgkmcnt(" #n ")" ::: "memory")
#define PG8_BAR __builtin_amdgcn_s_barrier()
#define PG8_SCHED __builtin_amdgcn_sched_barrier(0)
    Unit cur, nxt; int ui = 0;
    if (!S.next(0, cur)) return;
    f32x4 acc[2][2][4][2];
#pragma unroll
    for (int a = 0; a < 2; ++a)
#pragma unroll
        for (int b = 0; b < 2; ++b)
#pragma unroll
            for (int m = 0; m < 4; ++m)
#pragma unroll
                for (int n = 0; n < 2; ++n) acc[a][b][m][n] = (f32x4){0.f, 0.f, 0.f, 0.f};
    bf16x8 At[4][2], B0[2][2], B1[2][2];
    const char* cA = (const char*)g.A + (size_t)cur.pm * tstep; const char* cB = (const char*)g.Bt + (size_t)cur.pn * tstep;
    S.a_ready(cur);
    if constexpr (SP2) {
        PG8_STAGE(PG8_SB(0, 0), cB, voffB); PG8_STAGE(PG8_SB(0, 1), cB + hstep, voffB); PG8_STAGE(PG8_SA(0, 0), cA, voffA); PG8_STAGE(PG8_SA(0, 1), cA + hstep, voffA);
        if (wr == 1) PG8_BAR;
        PG8_WAIT_V(2); PG8_BAR;
        PG8_STAGE(PG8_SB(1, 0), cB + kstep, voffB); PG8_STAGE(PG8_SA(1, 0), cA + kstep, voffA); PG8_STAGE(PG8_SB(1, 1), cB + hstep + kstep, voffB);
        PG8_WAIT_V(6); PG8_BAR;
    } else {
        PG8_STAGE(PG8_SB(0, 0), cB, voffB); PG8_STAGE(PG8_SA(0, 0), cA, voffA); PG8_STAGE(PG8_SB(0, 1), cB + hstep, voffB); PG8_STAGE(PG8_SA(0, 1), cA + hstep, voffA);
        if (wr == 1) PG8_BAR;
        PG8_WAIT_V(4); PG8_BAR;
        PG8_STAGE(PG8_SB(1, 0), cB + kstep, voffB); PG8_STAGE(PG8_SA(1, 0), cA + kstep, voffA); PG8_STAGE(PG8_SB(1, 1), cB + hstep + kstep, voffB);
        PG8_WAIT_V(6); PG8_BAR;
    }
    for (;;) {
        const bool has_next = S.next(ui + 1, nxt);
        const char* nA = has_next ? (const char*)g.A + (size_t)nxt.pm * tstep : cA; const char* nB = has_next ? (const char*)g.Bt + (size_t)nxt.pn * tstep : cB;
        for (int t = 0; t < nt; t += 2) {
            const bool last = (t == nt - 2);
            const char* a1 = cA + (size_t)(t + 1) * kstep;
            const char* a2 = last ? nA : cA + (size_t)(t + 2) * kstep; const char* b2 = last ? nB : cB + (size_t)(t + 2) * kstep;
            const char* a3 = a2 + kstep; const char* b3 = b2 + kstep;
            if (last && has_next) S.a_ready(nxt);
            if constexpr (SP2) {
            PG8_LDB(B0, 0, 0); PG8_LDB(B1, 0, 1); PG8_SCHED; PG8_LDA(At, 0, 0); PG8_STAGE(PG8_SA(1, 1), a1 + hstep, voffA);
            PG8_WAIT_V(8); PG8_WAIT_L(0); PG8_BAR; PG8_MMA(0, 0, At, B0); PG8_MMA(0, 1, At, B1); PG8_BAR; PG8_SCHED;
            PG8_LDA(At, 0, 1); PG8_STAGE(PG8_SB(0, 0), b2, voffB); PG8_STAGE(PG8_SB(0, 1), b2 + hstep, voffB); PG8_STAGE(PG8_SA(0, 0), a2, voffA);
            PG8_WAIT_V(8); PG8_WAIT_L(0); PG8_BAR; PG8_MMA(1, 0, At, B0); PG8_MMA(1, 1, At, B1); PG8_BAR; PG8_SCHED;
            PG8_LDB(B0, 1, 0); PG8_LDB(B1, 1, 1); PG8_SCHED; PG8_LDA(At, 1, 0); PG8_STAGE(PG8_SA(0, 1), a2 + hstep, voffA);
            PG8_WAIT_V(8); PG8_WAIT_L(0); PG8_BAR; PG8_MMA(0, 0, At, B0); PG8_MMA(0, 1, At, B1); PG8_BAR; PG8_SCHED;
            PG8_LDA(At, 1, 1); PG8_STAGE(PG8_SB(1, 0), b3, voffB); PG8_STAGE(PG8_SB(1, 1), b3 + hstep, voffB); PG8_STAGE(PG8_SA(1, 0), a3, voffA);
            PG8_WAIT_V(8); PG8_WAIT_L(0); PG8_BAR; PG8_MMA(1, 0, At, B0); PG8_MMA(1, 1, At, B1); PG8_BAR; PG8_SCHED;
            } else {
            PG8_LDB(B0, 0, 0); PG8_SCHED; PG8_LDA(At, 0, 0); PG8_STAGE(PG8_SA(1, 1), a1 + hstep, voffA);
            PG8_WAIT_L(8); PG8_BAR; PG8_WAIT_L(0); PG8_MMA(0, 0, At, B0); PG8_BAR; PG8_SCHED;
            PG8_LDB(B1, 0, 1); PG8_STAGE(PG8_SB(0, 0), b2, voffB);
            PG8_BAR; PG8_WAIT_L(0); PG8_MMA(0, 1, At, B1); PG8_BAR;
            PG8_LDA(At, 0, 1); PG8_STAGE(PG8_SA(0, 0), a2, voffA);
            PG8_BAR; PG8_WAIT_L(0); PG8_MMA(1, 0, At, B0); PG8_BAR; PG8_SCHED;
            PG8_STAGE(PG8_SB(0, 1), b2 + hstep, voffB);
            PG8_WAIT_V(6); PG8_BAR; PG8_MMA(1, 1, At, B1); PG8_BAR;
            PG8_LDB(B0, 1, 0); PG8_SCHED; PG8_LDA(At, 1, 0); PG8_STAGE(PG8_SA(0, 1), a2 + hstep, voffA);
            PG8_WAIT_L(8); PG8_BAR; PG8_WAIT_L(0); PG8_MMA(0, 0, At, B0); PG8_BAR; PG8_SCHED;
            PG8_LDB(B1, 1, 1); PG8_STAGE(PG8_SB(1, 0), b3, voffB);
            PG8_BAR; PG8_WAIT_L(0); PG8_MMA(0, 1, At, B1); PG8_BAR;
            PG8_LDA(At, 1, 1); PG8_STAGE(PG8_SA(1, 0), a3, voffA);
            PG8_BAR; PG8_WAIT_L(0); PG8_MMA(1, 0, At, B0); PG8_BAR; PG8_SCHED;
            PG8_STAGE(PG8_SB(1, 1), b3 + hstep, voffB);
            PG8_WAIT_V(6); PG8_BAR; PG8_MMA(1, 1, At, B1); PG8_BAR;
            }
        }
        if constexpr (ALIGN_EPI) { if (wr == 0) PG8_BAR; }
        if constexpr (!Epi::AFTER_DRAIN) { E(acc, cur, wr, wc, fr, fq); S.done(cur); }
        if (!has_next) break;
#pragma unroll
        for (int a = 0; a < 2; ++a)
#pragma unroll
            for (int b = 0; b < 2; ++b)
#pragma unroll
                for (int m = 0; m < 4; ++m)
#pragma unroll
                    for (int n = 0; n < 2; ++n) acc[a][b][m][n] = (f32x4){0.f, 0.f, 0.f, 0.f};
        cur = nxt; cA = nA; cB = nB; ++ui;
        if constexpr (ALIGN_EPI) { if (wr == 1) PG8_BAR; }
    }
    PG8_WAIT_V(0);
    if constexpr (!ALIGN_EPI) { if (wr == 0) PG8_BAR; }
    PG8_BAR;
    if constexpr (Epi::AFTER_DRAIN) { E.fused(acc, cur, wr, wc, fr, fq, lds, wid, lane); S.done(cur); }
#undef PG8_SA
#undef PG8_SB
#undef PG8_STAGE
#undef PG8_LDA
#undef PG8_LDB
#undef PG8_MMA
#undef PG8_WAIT_V
#undef PG8_WAIT_L
#undef PG8_BAR
#undef PG8_SCHED
}
}
#define GAS __attribute__((address_space(1)))
#define LAS __attribute__((address_space(3)))
typedef unsigned short bf16;
typedef unsigned v4u __attribute__((ext_vector_type(4)));
typedef unsigned v2u __attribute__((ext_vector_type(2)));
typedef float f32x4 __attribute__((ext_vector_type(4)));
typedef float f32x2 __attribute__((ext_vector_type(2)));
typedef short bf16x8 __attribute__((ext_vector_type(8)));
typedef GAS unsigned gu32;
#define RLX_AGENT __ATOMIC_RELAXED, __HIP_MEMORY_SCOPE_AGENT
#define LDS_WAIT() asm volatile("s_waitcnt lgkmcnt(0)" ::: "memory")
#define VM_WAIT() asm volatile("s_waitcnt vmcnt(0)" ::: "memory")
__device__ __forceinline__ unsigned f2bf(float f) { unsigned u = __builtin_bit_cast(unsigned, f); return (u + 0x7fffu + ((u >> 16) & 1u)) >> 16; }
__device__ __forceinline__ unsigned pk2(float lo, float hi) { return f2bf(lo) | (f2bf(hi) << 16); }
__device__ __forceinline__ float bf2f(unsigned short b) { return __builtin_bit_cast(float, ((unsigned)b) << 16); }
__device__ __forceinline__ float bflo(unsigned w) { return __builtin_bit_cast(float, w << 16); }
__device__ __forceinline__ float bfhi(unsigned w) { return __builtin_bit_cast(float, w & 0xffff0000u); }
__device__ __forceinline__ float sigmoidf_(float x) { return __builtin_amdgcn_rcpf(1.0f + __expf(-x)); }
__device__ __forceinline__ float gelu_tanh_(float x) { const float t = 1.5957691216f * (x + 0.044715f * x * x * x); return x * __builtin_amdgcn_rcpf(1.0f + __expf(-t)); }
__device__ __forceinline__ float silu_(float x) { return x * __builtin_amdgcn_rcpf(1.0f + __expf(-x)); }

constexpr int D = 1024, NB = 8, SEQ = 2048, CTX = 256;
constexpr int MLAT = NB * SEQ, MCTX = NB * CTX, MTOT = MLAT + MCTX;
constexpr int NHY = 3072, N2 = 8192, NPR = 7168, NIN = 11264;
constexpr int NE = 16, DE = 2816, EROWS = 2304, NGU = 2 * DE;
constexpr int PR_GELU = 0, PR_REC = 1024, PR_BG = 2048, PR_P = 3072, PR_GATE = 4096;
constexpr int LCH = 64, NCHUNK = MTOT / LCH;

__device__ __forceinline__ int xcd_remap(int wgid, int nwg) { const int q = nwg / 8, r = nwg % 8, xcd = wgid % 8, off = wgid / 8; return (xcd < r ? xcd * (q + 1) : r * (q + 1) + (xcd - r) * q) + off; }

struct RectOrder {
    int nM1, nN1, n1, nM2, nN2, n2, pm2, pn2, G, c;
    __device__ void init(int nM1_, int nN1_, int nM2_, int nN2_, int pm2_, int pn2_, int G_, int c_) { nM1 = nM1_; nN1 = nN1_; n1 = nM1 * nN1; nM2 = nM2_; nN2 = nN2_; n2 = nM2 * nN2; pm2 = pm2_; pn2 = pn2_; G = G_; c = c_; }
    __device__ bool next(int i, pg8::Unit& u) const {
        const int L = i * G + c;
        if (L < n1) { const int wgid = xcd_remap(L, n1); const int nig = 8 * nN1, gid = wgid / nig, fm = gid * 8, gsz = (nM1 - fm) < 8 ? (nM1 - fm) : 8;
            u.pm = fm + ((wgid % nig) % gsz); u.pn = (wgid % nig) / gsz; return true; }
        const int L2 = L - n1; if (L2 >= n2) return false;
        u.pm = pm2 + L2 % nM2; u.pn = pn2 + L2 / nM2; return true;
    }
    __device__ __forceinline__ void a_ready(const pg8::Unit&) const {}
    __device__ __forceinline__ void done(const pg8::Unit&) const {}
};
struct GroupOrder {
    int mt, mstride, nt, nwg, G, c;
    __device__ void init(int nE, int mt_, int mstride_, int nt_, int G_, int c_) { mt = mt_; mstride = mstride_; nt = nt_; nwg = nE * mt * nt; G = G_; c = c_; }
    __device__ bool next(int i, pg8::Unit& u) const {
        const int L = i * G + c; if (L >= nwg) return false;
        const int wgid = xcd_remap(L, nwg); const int per = mt * nt, e = wgid / per, r = wgid % per;
        u.pm = e * mstride + r % mt; u.pn = e * nt + r / mt; return true;
    }
    __device__ __forceinline__ void a_ready(const pg8::Unit&) const {}
    __device__ __forceinline__ void done(const pg8::Unit&) const {}
};

#define EPI_ROW(u, ai, m) ((u).pm * 256 + wr * 64 + fr + (ai) * 128 + (m) * 16)
struct EpiPlainBf16 {
    static constexpr bool PERM = true, AFTER_DRAIN = false;
    bf16* O; int ldc;
    __device__ __forceinline__ void operator()(const f32x4 (&acc)[2][2][4][2], const pg8::Unit& u, int wr, int wc, int fr, int fq) const {
        const int col0 = u.pn * 256 + wc * 32 + 8 * fq;
#pragma unroll
        for (int ai = 0; ai < 2; ++ai)
#pragma unroll
            for (int m = 0; m < 4; ++m) { bf16* rowp = O + (size_t)EPI_ROW(u, ai, m) * ldc + col0;
#pragma unroll
                for (int bj = 0; bj < 2; ++bj) { const f32x4 v0 = acc[ai][bj][m][0], v1 = acc[ai][bj][m][1];
                    v4u w; w.x = pg8::cvt_pk_bf16(v0[0], v0[1]); w.y = pg8::cvt_pk_bf16(v0[2], v0[3]); w.z = pg8::cvt_pk_bf16(v1[0], v1[1]); w.w = pg8::cvt_pk_bf16(v1[2], v1[3]);
                    *(v4u*)(rowp + bj * 128) = w; } }
    }
};
struct EpiInProj {
    static constexpr bool PERM = true, AFTER_DRAIN = false;
    bf16* PR;
    __device__ __forceinline__ void operator()(const f32x4 (&acc)[2][2][4][2], const pg8::Unit& u, int wr, int wc, int fr, int fq) const {
        const int pn = u.pn;
        if (pn >= 12 && pn < 20) {
            const int col = PR_P + (pn - 12) * 128 + wc * 32 + 8 * fq;
#pragma unroll
            for (int ai = 0; ai < 2; ++ai)
#pragma unroll
                for (int m = 0; m < 4; ++m) { const f32x4 v0 = acc[ai][0][m][0] * acc[ai][1][m][0], v1 = acc[ai][0][m][1] * acc[ai][1][m][1];
                    v4u w; w.x = pg8::cvt_pk_bf16(v0[0], v0[1]); w.y = pg8::cvt_pk_bf16(v0[2], v0[3]); w.z = pg8::cvt_pk_bf16(v1[0], v1[1]); w.w = pg8::cvt_pk_bf16(v1[2], v1[3]);
                    *(v4u*)(PR + (size_t)EPI_ROW(u, ai, m) * NPR + col) = w; }
        } else {
            const int mode = pn < 4 ? 1 : (pn < 12 ? 0 : 2);
            const int col0 = (pn < 12 ? pn * 256 : PR_GATE + (pn - 20) * 256) + wc * 32 + 8 * fq;
#pragma unroll
            for (int ai = 0; ai < 2; ++ai)
#pragma unroll
                for (int m = 0; m < 4; ++m) { bf16* rowp = PR + (size_t)EPI_ROW(u, ai, m) * NPR + col0;
#pragma unroll
                    for (int bj = 0; bj < 2; ++bj) { f32x4 v0 = acc[ai][bj][m][0], v1 = acc[ai][bj][m][1];
                        if (mode == 1) {
#pragma unroll
                            for (int j = 0; j < 4; ++j) { v0[j] = gelu_tanh_(v0[j]); v1[j] = gelu_tanh_(v1[j]); } }
                        else if (mode == 2) {
#pragma unroll
                            for (int j = 0; j < 4; ++j) { v0[j] = sigmoidf_(v0[j]); v1[j] = sigmoidf_(v1[j]); } }
                        v4u w; w.x = pg8::cvt_pk_bf16(v0[0], v0[1]); w.y = pg8::cvt_pk_bf16(v0[2], v0[3]); w.z = pg8::cvt_pk_bf16(v1[0], v1[1]); w.w = pg8::cvt_pk_bf16(v1[2], v1[3]);
                        *(v4u*)(rowp + bj * 128) = w; } }
        }
    }
};
template <int VAR> struct EpiGate {
    static constexpr bool PERM = true, AFTER_DRAIN = false;
    const bf16* gates; float* M32; bf16* MB;
    __device__ __forceinline__ void operator()(const f32x4 (&acc)[2][2][4][2], const pg8::Unit& u, int wr, int wc, int fr, int fq) const {
        const int col0 = u.pn * 256 + wc * 32 + 8 * fq;
#pragma unroll
        for (int ai = 0; ai < 2; ++ai)
#pragma unroll
            for (int m = 0; m < 4; ++m) { const size_t row = (size_t)EPI_ROW(u, ai, m);
#pragma unroll
                for (int bj = 0; bj < 2; ++bj) { const int col = col0 + bj * 128;
                    const v4u g = *(const v4u*)(gates + row * NPR + col);
                    f32x4 v0 = acc[ai][bj][m][0], v1 = acc[ai][bj][m][1];
                    v0[0] *= bflo(g.x); v0[1] *= bfhi(g.x); v0[2] *= bflo(g.y); v0[3] *= bfhi(g.y); v1[0] *= bflo(g.z); v1[1] *= bfhi(g.z); v1[2] *= bflo(g.w); v1[3] *= bfhi(g.w);
                    float* mp = M32 + row * D + col;
                    if (VAR >= 1) { v0 += *(const f32x4*)mp; v1 += *(const f32x4*)(mp + 4); }
                    if (VAR <= 1) { *(f32x4*)mp = v0; *(f32x4*)(mp + 4) = v1; }
                    else { v4u w; w.x = pg8::cvt_pk_bf16(v0[0], v0[1]); w.y = pg8::cvt_pk_bf16(v0[2], v0[3]); w.z = pg8::cvt_pk_bf16(v1[0], v1[1]); w.w = pg8::cvt_pk_bf16(v1[2], v1[3]);
                        *(v4u*)(MB + row * D + col) = w; } } }
    }
};
struct EpiResid {
    static constexpr bool PERM = false, AFTER_DRAIN = false;
    float* X; const float* modg;
    __device__ __forceinline__ void operator()(const f32x4 (&acc)[2][2][4][2], const pg8::Unit& u, int wr, int wc, int fr, int fq) const {
        const int r = u.pm < 64 ? (u.pm >> 3) : 8; const float* mg = modg + (size_t)r * 6144;
        const int col0 = u.pn * 256 + wc * 32 + 4 * fq;
        f32x4 gv[2][2];
#pragma unroll
        for (int bj = 0; bj < 2; ++bj)
#pragma unroll
            for (int n = 0; n < 2; ++n) gv[bj][n] = *(const f32x4*)(mg + col0 + bj * 128 + n * 16);
#pragma unroll
        for (int ai = 0; ai < 2; ++ai)
#pragma unroll
            for (int m = 0; m < 4; ++m) { float* rowp = X + (size_t)EPI_ROW(u, ai, m) * D + col0;
#pragma unroll
                for (int bj = 0; bj < 2; ++bj)
#pragma unroll
                    for (int n = 0; n < 2; ++n) { float* p = rowp + bj * 128 + n * 16; *(f32x4*)p = *(const f32x4*)p + gv[bj][n] * acc[ai][bj][m][n]; } }
    }
};
struct EpiSwiglu {
    static constexpr bool PERM = true, AFTER_DRAIN = false;
    bf16* HID;
    __device__ __forceinline__ void operator()(const f32x4 (&acc)[2][2][4][2], const pg8::Unit& u, int wr, int wc, int fr, int fq) const {
        const int jn = u.pn % 22; const int col = jn * 128 + wc * 32 + 8 * fq;
#pragma unroll
        for (int ai = 0; ai < 2; ++ai)
#pragma unroll
            for (int m = 0; m < 4; ++m) { f32x4 v0, v1;
#pragma unroll
                for (int j = 0; j < 4; ++j) { v0[j] = silu_(acc[ai][0][m][0][j]) * acc[ai][1][m][0][j]; v1[j] = silu_(acc[ai][0][m][1][j]) * acc[ai][1][m][1][j]; }
                v4u w; w.x = pg8::cvt_pk_bf16(v0[0], v0[1]); w.y = pg8::cvt_pk_bf16(v0[2], v0[3]); w.z = pg8::cvt_pk_bf16(v1[0], v1[1]); w.w = pg8::cvt_pk_bf16(v1[2], v1[3]);
                *(v4u*)(HID + (size_t)EPI_ROW(u, ai, m) * DE + col) = w; }
    }
};
struct EpiYs {
    static constexpr bool PERM = false, AFTER_DRAIN = false;
    float* YS;
    __device__ __forceinline__ void operator()(const f32x4 (&acc)[2][2][4][2], const pg8::Unit& u, int wr, int wc, int fr, int fq) const {
        const int col0 = (u.pn & 3) * 256 + wc * 32 + 4 * fq;
#pragma unroll
        for (int ai = 0; ai < 2; ++ai)
#pragma unroll
            for (int m = 0; m < 4; ++m) { float* rowp = YS + (size_t)EPI_ROW(u, ai, m) * D + col0;
#pragma unroll
                for (int bj = 0; bj < 2; ++bj)
#pragma unroll
                    for (int n = 0; n < 2; ++n) *(f32x4*)(rowp + bj * 128 + n * 16) = acc[ai][bj][m][n]; }
    }
};
#define XB_TMO      128
#define XB_XCNT(j)  (256  + 64 * (j))
#define XB_XSUB(j)  (1280 + 64 * (j))
#define XB_XGEN(j)  (2304 + 64 * (j))
#define XB_TOP      3328
#define XB_TOPGEN   3392
#define XCD_BAR_WORDS 3456
#define XB_SPIN_CAP (1u << 18)

__device__ __forceinline__ unsigned xb_ld(unsigned* p)              { return __hip_atomic_load(p, __ATOMIC_RELAXED, __HIP_MEMORY_SCOPE_AGENT); }
__device__ __forceinline__ unsigned xb_add(unsigned* p, unsigned v) { return __hip_atomic_fetch_add(p, v, __ATOMIC_RELAXED, __HIP_MEMORY_SCOPE_AGENT); }
__device__ __forceinline__ unsigned xb_xcc_id() { return (unsigned)__builtin_amdgcn_s_getreg((3 << 11) | 20) & 0xFu; }
#define XB_SPIN(cond, bar) do { unsigned _sp = 0; while (cond) { __builtin_amdgcn_s_sleep(1); \
    if ((++_sp & 255u) == 0u) { if (xb_ld(&(bar)[XB_TMO])) break; if (_sp > XB_SPIN_CAP) { atomicAdd(&(bar)[XB_TMO], 1u); break; } } } } while (0)

struct XcdBarrier {
    unsigned* bar; unsigned x;
    volatile LAS unsigned* st;
};

__device__ __forceinline__ XcdBarrier xcd_barrier_post(unsigned* bar, volatile LAS unsigned* st) {
    XcdBarrier b; b.bar = bar; b.x = xb_xcc_id(); b.st = st;
    if (threadIdx.x == 0) (void)xb_add(&bar[XB_XCNT(b.x)], 1u);
    return b;
}
__device__ __forceinline__ void xcd_barrier_complete(unsigned* bar, unsigned x, unsigned& nloc, unsigned& nx) {
    const unsigned G = gridDim.x * gridDim.y * gridDim.z;
    unsigned sum, cnt, mine, sp = 0u;
    for (;;) {
        sum = 0u; cnt = 0u; mine = 0u;
#pragma unroll
        for (unsigned j = 0; j < 16; ++j) { const unsigned c = xb_ld(&bar[XB_XCNT(j)]); sum += c; cnt += (c > 0u) ? 1u : 0u; mine = (j == x) ? c : mine; }
        if (sum == G) break;
        __builtin_amdgcn_s_sleep(1);
        if ((++sp & 255u) == 0u) { if (xb_ld(&bar[XB_TMO])) break; if (sp > XB_SPIN_CAP) { atomicAdd(&bar[XB_TMO], 1u); break; } }
    }
    nloc = mine > 0u ? mine : 1u; nx = cnt > 0u ? cnt : 1u;
}

__device__ __forceinline__ void xcd_barrier(const XcdBarrier& b) {
    asm volatile("s_waitcnt vmcnt(0)" ::: "memory");
    __syncthreads();
    if (threadIdx.x == 0) {
        unsigned* bar = b.bar;
        __builtin_amdgcn_s_waitcnt(0);
        unsigned nloc = b.st[0], nx = b.st[1];
        if (nloc == 0u) { xcd_barrier_complete(bar, b.x, nloc, nx); b.st[0] = nloc; b.st[1] = nx; }
        const unsigned old = xb_add(&bar[XB_XSUB(b.x)], 1u);
        const unsigned gen = old / nloc;
        if (old + 1u == (gen + 1u) * nloc) {
            __builtin_amdgcn_fence(__ATOMIC_RELEASE, "agent");
            asm volatile("s_waitcnt vmcnt(0)" ::: "memory");
            const unsigned og = xb_add(&bar[XB_TOP], 1u);
            const unsigned tg = og / nx;
            if (og + 1u == (tg + 1u) * nx) xb_add(&bar[XB_TOPGEN], 1u);
            else XB_SPIN(xb_ld(&bar[XB_TOPGEN]) == tg, bar);
            __builtin_amdgcn_fence(__ATOMIC_ACQUIRE, "agent");
            xb_add(&bar[XB_XGEN(b.x)], 1u);
            asm volatile("s_waitcnt vmcnt(0)" ::: "memory");
        } else {
            XB_SPIN(xb_ld(&bar[XB_XGEN(b.x)]) == gen, bar);
            __builtin_amdgcn_fence(__ATOMIC_ACQUIRE, "agent");
            asm volatile("s_waitcnt vmcnt(0)" ::: "memory");
        }
    }
    __syncthreads();
}
constexpr size_t MiB = 1u << 20;
constexpr size_t al_(size_t x) { return (x + MiB - 1) / MiB * MiB; }
constexpr size_t WS_CTL = 0, CTL_ZERO_BYTES = 1 * MiB;
constexpr size_t WS_MOD  = 1 * MiB;
constexpr size_t WS_WIN  = WS_MOD + 1 * MiB;
constexpr size_t WS_WOUT = WS_WIN + al_(2ull * NIN * D * 2);
constexpr size_t WS_WLRU = WS_WOUT + al_(2ull * 4 * D * D * 2);
constexpr size_t WS_WGU  = WS_WLRU + 1 * MiB;
constexpr size_t WS_WD   = WS_WGU + al_(16ull * NGU * D * 2);
constexpr size_t WS_X    = WS_WD + al_(16ull * D * DE * 2);
constexpr size_t WS_FH2  = WS_X + al_((size_t)MTOT * D * 4);
constexpr size_t WS_TF   = WS_FH2 + 2 * MiB;
constexpr size_t TF_LAYER = (size_t)4 * D * (SEQ + CTX) * 4, TF_CTX_OFF = (size_t)4 * D * SEQ * 4;
constexpr size_t WS_H    = WS_TF + al_(2 * TF_LAYER);
constexpr size_t WS_R    = WS_H + al_((size_t)MTOT * D * 2);
constexpr size_t WS_HYT  = WS_R;
constexpr size_t WS_PR   = WS_HYT + al_((size_t)NHY * MTOT * 2);
constexpr size_t WS_YAT  = WS_PR + al_((size_t)MTOT * NPR * 2);
constexpr size_t WS_YCAT = WS_YAT + al_((size_t)D * MTOT * 2);
constexpr size_t WS_REND = WS_YCAT + al_(3ull * MTOT * D * 2);
constexpr size_t WS_XS   = WS_R;
constexpr size_t WS_HID  = WS_XS + al_((size_t)NE * EROWS * D * 2);
constexpr size_t WS_YS   = WS_HID + al_((size_t)NE * EROWS * DE * 2);
static_assert(WS_YS + (size_t)NE * EROWS * D * 4 <= WS_REND, "MoE overlay fits");
constexpr size_t WS_M32  = WS_REND;
constexpr size_t WS_MB   = WS_M32 + al_((size_t)MTOT * D * 4);
constexpr size_t WS_AFF  = WS_MB + al_((size_t)MTOT * D * 2);
constexpr size_t WS_SELG = WS_AFF + 2 * MiB;
constexpr size_t WS_INV  = WS_SELG + 1 * MiB;
constexpr size_t WS_AGG  = WS_INV + 2 * MiB;
constexpr size_t WS_END  = WS_AGG + al_(2ull * NCHUNK * D * 2 * 4);
constexpr int CW_BAR = 4096;
constexpr int LDS_BYTES = 147456, MISC_OFF = 131072 + 320;
constexpr int NPHASE = 23;

struct Args { const float* in[35]; float* out; unsigned char* ws; int ph_lo, ph_hi, li, pad; };
struct Frame { LAS unsigned char* lds; int tid, lane, wave, vcu, G; };

__device__ __forceinline__ float wave_sum(float v) {
#pragma unroll
    for (int o = 1; o < 64; o <<= 1) v += __shfl_xor(v, o);
    return v;
}
__device__ __forceinline__ void tr_item(const float* src, size_t ld, bf16* dst, size_t K, LAS float* scr, int lane) {
#pragma unroll 8
    for (int i = 0; i < 32; ++i) { const int kk = 2 * i + (lane >> 5); scr[kk * 33 + (lane & 31)] = src[(size_t)kk * ld + (lane & 31)]; }
    LDS_WAIT(); asm volatile("" ::: "memory");
    const int c = lane & 7;
#pragma unroll
    for (int j = 0; j < 4; ++j) { const int n = (lane >> 3) + 8 * j; const LAS float* s = scr + (8 * c) * 33 + n;
        v4u o; o.x = pk2(s[0 * 33], s[1 * 33]); o.y = pk2(s[2 * 33], s[3 * 33]); o.z = pk2(s[4 * 33], s[5 * 33]); o.w = pk2(s[6 * 33], s[7 * 33]);
        *(v4u*)(dst + (size_t)n * K + 8 * c) = o; }
    LDS_WAIT(); asm volatile("" ::: "memory");
}
__device__ __forceinline__ int win_src_col(int n0) {
    if (n0 < 3072) return n0;
    const int m = n0 - 3072;
    if (m < 1024) return 3072 + m;
    if (m < 2048) return 4096 + (m - 1024);
    if (m < 3072) return 5120 + (m - 2048);
    if (m < 5120) { const int q = m - 3072, j = q >> 8, r = q & 255; return r < 128 ? 6144 + 128 * j + r : 7168 + 128 * j + (r - 128); }
    return 8192 + (m - 5120);
}

__device__ __forceinline__ void ph_prologue(const Args& a, const Frame& F) {
    const int gw = F.vcu * 8 + F.wave, NGW = F.G * 8, lane = F.lane;
    float* X = (float*)(a.ws + WS_X);
    for (int t = gw; t < SEQ; t += NGW) {
        const int gr = t >> 6, gc = t & 63; f32x4 pe[4];
#pragma unroll
        for (int j = 0; j < 4; ++j)
#pragma unroll
            for (int i = 0; i < 4; ++i) { const int cc = 4 * lane + 256 * j + i; const float pos = (float)(cc < 512 ? gr : gc); const int c2 = cc & 511, idx = c2 & 255;
                const float om = 1.0f / powf(10000.0f, (float)idx * (1.0f / 256.0f)); const float ang = pos * om; pe[j][i] = c2 < 256 ? sinf(ang) : cosf(ang); }
        for (int b = 0; b < NB; ++b) { const size_t row = (size_t)b * SEQ + t; const f32x4* xr = (const f32x4*)(a.in[0] + row * D) + lane; f32x4* xo = (f32x4*)(X + row * D) + lane;
#pragma unroll
            for (int j = 0; j < 4; ++j) xo[64 * j] = xr[64 * j] + pe[j]; }
    }
    for (int r = gw; r < MCTX; r += NGW) { const f32x4* xr = (const f32x4*)(a.in[2] + (size_t)r * D) + lane; f32x4* xo = (f32x4*)(X + (size_t)(MLAT + r) * D) + lane;
#pragma unroll
        for (int j = 0; j < 4; ++j) xo[64 * j] = xr[64 * j]; }
    {
        LAS float* S = (LAS float*)F.lds;
        LAS float* red = S + 9 * 1024;
        for (int i = F.tid; i < 9 * 1024; i += 512) { const float v = i < 8192 ? a.in[1][i] : a.in[3][i - 8192]; S[i] = v / (1.0f + expf(-v)); }
        __syncthreads();
        float* MOD = (float*)(a.ws + WS_MOD);
        for (int it = F.vcu; it < 2 * 96; it += F.G) {
            const int l = it / 96, cb = it % 96, cj = F.tid & 63, ks = F.tid >> 6;
            const float* w = a.in[4] + (size_t)l * D * 6144 + cb * 64 + cj; float acc[9];
#pragma unroll
            for (int r = 0; r < 9; ++r) acc[r] = 0.f;
            for (int k = ks * 128; k < ks * 128 + 128; ++k) { const float wv = w[(size_t)k * 6144];
#pragma unroll
                for (int r = 0; r < 9; ++r) acc[r] += S[r * 1024 + k] * wv; }
#pragma unroll
            for (int r = 0; r < 9; ++r) red[(ks * 9 + r) * 64 + cj] = acc[r];
            __syncthreads();
            for (int o = F.tid; o < 9 * 64; o += 512) { const int r = o >> 6, c2 = o & 63; float s = a.in[5][(size_t)l * 6144 + cb * 64 + c2];
#pragma unroll
                for (int k2 = 0; k2 < 8; ++k2) s += red[(k2 * 9 + r) * 64 + c2];
                MOD[((size_t)l * 9 + r) * 6144 + cb * 64 + c2] = s; }
            __syncthreads();
        }
    }
    {
        LAS float* scr = (LAS float*)(F.lds + F.wave * 16384);
        bf16* WIN = (bf16*)(a.ws + WS_WIN); bf16* WOUT = (bf16*)(a.ws + WS_WOUT);
        constexpr int I_IN = 16 * (NIN / 32), I_OUT = 16 * 32;
        constexpr int NIT = 2 * I_IN + 8 * I_OUT;
        for (int it = gw; it < NIT; it += NGW) {
            if (it < 2 * I_IN) { const int l = it / I_IN, r = it % I_IN, kb = r / (NIN / 32), nb = r % (NIN / 32);
                tr_item(a.in[8] + (size_t)l * D * NIN + (size_t)(64 * kb) * NIN + win_src_col(32 * nb), NIN, WIN + (size_t)l * NIN * D + (size_t)(32 * nb) * D + 64 * kb, D, scr, lane); }
            else { const int r0 = it - 2 * I_IN, mi = r0 / I_OUT, r = r0 % I_OUT, l = mi >> 2, w = mi & 3, kb = r / 32, nb = r % 32;
                tr_item(a.in[26 + w] + (size_t)l * D * D + (size_t)(64 * kb) * D + 32 * nb, D, WOUT + ((size_t)l * 4 + w) * D * D + (size_t)(32 * nb) * D + 64 * kb, D, scr, lane); }
        }
    }
    __syncthreads();
    {
        LAS float* feats = (LAS float*)F.lds;
        LAS float* h1 = feats + 8 * 36;
        float* FH2 = (float*)(a.ws + WS_FH2);
        for (int it = F.vcu; it < 2 * 288; it += F.G) {
            const int l = it / 288, tb = it % 288, tl = F.tid >> 6, j = F.tid & 63;
            const int tt = tb * 8 + tl; const int L = tt < SEQ ? SEQ : CTX, t = tt < SEQ ? tt : tt - SEQ;
            if (j < 33) { const float wv = (6.283185307179586f / (float)L) * (float)t; float v;
                if (j == 0) v = (float)t / (float)(L - 1);
                else { const int bi = (j - 1) & 15; const float f = 1e-4f + (float)bi * ((15.0f - 1e-4f) / 15.0f); v = j <= 16 ? cosf(f * wv) : -sinf(f * wv); }
                feats[tl * 36 + j] = v; }
            __syncthreads();
            { const float* w1 = a.in[11] + (size_t)l * 33 * 64; float s = a.in[12][l * 64 + j];
              for (int m = 0; m < 33; ++m) s += feats[tl * 36 + m] * w1[m * 64 + j];
              h1[tl * 64 + j] = sinf(a.in[16][l * 64 + j] * s); }
            __syncthreads();
            { const float* w2 = a.in[13] + (size_t)l * 64 * 64; float s = a.in[14][l * 64 + j];
              for (int m = 0; m < 64; ++m) s += h1[tl * 64 + m] * w2[m * 64 + j];
              FH2[((size_t)l * 2304 + tt) * 64 + j] = sinf(a.in[16][l * 64 + j] * s); }
            __syncthreads();
        }
    }
}

__device__ __forceinline__ void ph_filters(const Args& a, const Frame& F) {
    LAS float* w3s = (LAS float*)F.lds;
    LAS float* red = w3s + 256;
    LAS float* nrm = red + 16;
    for (int it = F.vcu; it < 3 * D; it += F.G) {
        const int sel = it / D, c = it % D, l = sel == 2 ? 1 : 0; const bool isctx = sel == 1;
        const int L = isctx ? CTX : SEQ; const float* FH2 = (const float*)(a.ws + WS_FH2) + ((size_t)l * 2304 + (isctx ? SEQ : 0)) * 64;
        float* TF = (float*)(a.ws + WS_TF + (size_t)l * TF_LAYER + (isctx ? TF_CTX_OFF : 0));
        if (F.tid < 256) { const int od = F.tid >> 6, j = F.tid & 63; w3s[od * 64 + j] = a.in[15][((size_t)l * 64 + j) * 4096 + od * 1024 + c]; }
        __syncthreads();
        const float delta = -3.0701134573f + (float)c * ((-15.3505672866f + 3.0701134573f) / 1023.0f);
        const float ad = fabsf(delta);
        float kv[4][4]; float s0 = 0.f, s1 = 0.f;
#pragma unroll
        for (int q = 0; q < 4; ++q) { const int t = F.tid + 512 * q;
            if (t < L) { const f32x4* hp = (const f32x4*)(FH2 + (size_t)t * 64); float d[4] = {0.f, 0.f, 0.f, 0.f};
#pragma unroll
                for (int jj = 0; jj < 16; ++jj) { const f32x4 hv = hp[jj];
#pragma unroll
                    for (int od = 0; od < 4; ++od) { const LAS float* wp = w3s + od * 64 + jj * 4; d[od] += hv[0] * wp[0] + hv[1] * wp[1] + hv[2] * wp[2] + hv[3] * wp[3]; } }
                const float win = expf(-((float)t / (float)(L - 1)) * ad);
#pragma unroll
                for (int od = 0; od < 4; ++od) kv[q][od] = d[od] * win;
                s0 += fabsf(kv[q][0]) + (t > 0 ? fabsf(kv[q][1]) : 0.f); s1 += fabsf(kv[q][2]) + (t > 0 ? fabsf(kv[q][3]) : 0.f);
            } else {
#pragma unroll
                for (int od = 0; od < 4; ++od) kv[q][od] = 0.f; } }
        s0 = wave_sum(s0); s1 = wave_sum(s1);
        if (F.lane == 0) { red[F.wave * 2] = s0; red[F.wave * 2 + 1] = s1; }
        __syncthreads();
        if (F.tid < 2) { float s = 0.f; for (int w = 0; w < 8; ++w) s += red[w * 2 + F.tid]; nrm[F.tid] = 1.0f / s; }
        __syncthreads();
        const float i0 = nrm[0], i1 = nrm[1];
#pragma unroll
        for (int q = 0; q < 4; ++q) { const int t = F.tid + 512 * q;
            if (t < L) {
#pragma unroll
                for (int od = 0; od < 4; ++od) TF[((size_t)od * D + c) * L + t] = kv[q][od] * (od < 2 ? i0 : i1); } }
        __syncthreads();
    }
}

__device__ __forceinline__ void ph_wexp(const Args& a, const Frame& F, int l) {
    const int gw = F.vcu * 8 + F.wave, NGW = F.G * 8, lane = F.lane;
    LAS float* scr = (LAS float*)(F.lds + F.wave * 16384);
    bf16* WGU = (bf16*)(a.ws + WS_WGU); bf16* WD = (bf16*)(a.ws + WS_WD);
    constexpr int I_GU = 16 * (NGU / 32), I_D = (DE / 64) * 32;
    constexpr int NIT = NE * (I_GU + I_D);
    for (int it = gw; it < NIT; it += NGW) {
        if (it < NE * I_GU) { const int e = it / I_GU, r = it % I_GU, kb = r / (NGU / 32), nb = r % (NGU / 32); const int n0 = 32 * nb, jt = n0 >> 8, rr = n0 & 255;
            const float* src = (rr < 128 ? a.in[31] : a.in[32]) + ((size_t)l * NE + e) * D * DE + (size_t)(64 * kb) * DE + 128 * jt + (rr & 127);
            tr_item(src, DE, WGU + (size_t)e * NGU * D + (size_t)n0 * D + 64 * kb, D, scr, lane); }
        else { const int r0 = it - NE * I_GU, e = r0 / I_D, r = r0 % I_D, kb = r / 32, nb = r % 32;
            tr_item(a.in[33] + ((size_t)l * NE + e) * DE * D + (size_t)(64 * kb) * D + 32 * nb, D, WD + (size_t)e * D * DE + (size_t)(32 * nb) * DE + 64 * kb, DE, scr, lane); }
    }
}

template <int MODE, bool COMB> __device__ __forceinline__ void ph_norm(const Args& a, const Frame& F, int l) {
    const int gw = F.vcu * 8 + F.wave, NGW = F.G * 8, lane = F.lane;
    float* X = (float*)(a.ws + WS_X); bf16* H = (bf16*)(a.ws + WS_H);
    const float* MOD = (const float*)(a.ws + WS_MOD);
    LAS float* WRt = (LAS float*)F.lds;
    if (MODE == 1) { const float* wr = a.in[30] + (size_t)l * D * NE; for (int i = F.tid; i < D * NE; i += 512) WRt[(i & 15) * 1024 + (i >> 4)] = wr[i]; __syncthreads(); }
    const float* g = MODE == 0 ? a.in[6] + l * D : (MODE == 1 ? a.in[7] + l * D : a.in[34]);
    const int nrows = MODE == 2 ? MLAT : MTOT;
    for (int row = gw; row < nrows; row += NGW) {
        const int r = row < MLAT ? (row >> 11) : 8;
        f32x4* xr = (f32x4*)(X + (size_t)row * D) + lane; f32x4 v[4];
#pragma unroll
        for (int j = 0; j < 4; ++j) v[j] = xr[64 * j];
        if (COMB) {
            const int lp = MODE == 2 ? 1 : l - 1;
            const int* INV = (const int*)(a.ws + WS_INV) + (size_t)row * NE; const float* SELG = (const float*)(a.ws + WS_SELG); const float* YS = (const float*)(a.ws + WS_YS);
            const int myinv = INV[lane & 15]; f32x4 acc[4];
#pragma unroll
            for (int j = 0; j < 4; ++j) acc[j] = (f32x4){0.f, 0.f, 0.f, 0.f};
#pragma unroll
            for (int e = 0; e < NE; ++e) { const int s = __builtin_amdgcn_readlane(myinv, e);
                if (s >= 0) { const float gt = SELG[e * EROWS + s]; const f32x4* yr = (const f32x4*)(YS + ((size_t)e * EROWS + s) * D) + lane;
#pragma unroll
                    for (int j = 0; j < 4; ++j) acc[j] += gt * yr[64 * j]; } }
            const f32x4* m5 = (const f32x4*)(MOD + ((size_t)lp * 9 + r) * 6144 + 5 * 1024) + lane;
#pragma unroll
            for (int j = 0; j < 4; ++j) v[j] += m5[64 * j] * acc[j];
            if (MODE != 2) {
#pragma unroll
                for (int j = 0; j < 4; ++j) xr[64 * j] = v[j]; }
        }
        float ss = 0.f;
#pragma unroll
        for (int j = 0; j < 4; ++j) ss += (v[j][0] * v[j][0] + v[j][1] * v[j][1]) + (v[j][2] * v[j][2] + v[j][3] * v[j][3]);
        const float rstd = 1.0f / sqrtf(wave_sum(ss) * (1.0f / D) + 1e-6f);
        const f32x4* gp = (const f32x4*)g + lane;
        if (MODE == 2) { f32x4* o = (f32x4*)(a.out + (size_t)row * D) + lane;
#pragma unroll
            for (int j = 0; j < 4; ++j) o[64 * j] = v[j] * rstd * gp[64 * j];
        } else {
            const float* mrow = MOD + ((size_t)l * 9 + r) * 6144 + (MODE == 0 ? 0 : 3 * 1024);
            const f32x4* sh = (const f32x4*)mrow + lane; const f32x4* sc = (const f32x4*)(mrow + 1024) + lane;
            v2u* o8 = (v2u*)(H + (size_t)row * D) + lane;
#pragma unroll
            for (int j = 0; j < 4; ++j) { v[j] = (v[j] * rstd * gp[64 * j]) * (1.0f + sc[64 * j]) + sh[64 * j]; v2u w; w.x = pk2(v[j][0], v[j][1]); w.y = pk2(v[j][2], v[j][3]); o8[64 * j] = w; }
            if (MODE == 1) {
                float mine = 0.f;
#pragma unroll 1
                for (int e = 0; e < NE; ++e) { float s = 0.f;
#pragma unroll
                    for (int j = 0; j < 4; ++j) { const f32x4 w = *(const LAS f32x4*)(WRt + e * 1024 + 4 * lane + 256 * j); s += (v[j][0] * w[0] + v[j][1] * w[1]) + (v[j][2] * w[2] + v[j][3] * w[3]); }
                    s = wave_sum(s); if ((lane & 15) == e) mine = s; }
                float mx = mine;
#pragma unroll
                for (int o = 1; o < 16; o <<= 1) mx = fmaxf(mx, __shfl_xor(mx, o));
                const float p = expf(mine - mx); float den = p;
#pragma unroll
                for (int o = 1; o < 16; o <<= 1) den += __shfl_xor(den, o);
                if (lane < NE) ((float*)(a.ws + WS_AFF))[(size_t)row * NE + lane] = p / den;
            }
        }
    }
}

__device__ __forceinline__ void ph_rank(const Args& a, const Frame& F, int l) {
    LAS unsigned long long* keys = (LAS unsigned long long*)F.lds;
    const float* AFF = (const float*)(a.ws + WS_AFF); float* SELG = (float*)(a.ws + WS_SELG); int* INV = (int*)(a.ws + WS_INV);
    const bf16* H = (const bf16*)(a.ws + WS_H); bf16* XS = (bf16*)(a.ws + WS_XS);
    const int nitems = 512 + (l == 0 ? 128 : 0);
    for (int it = F.vcu; it < nitems; it += F.G) {
        int b, e, n, cap, row0, slot0, i;
        if (it < 512) { const int q = it & 3; e = (it >> 2) & 15; b = it >> 6; n = SEQ; cap = 256; row0 = b * SEQ; slot0 = b * 256; i = q * 512 + F.tid; }
        else { const int r = it - 512; e = r & 15; b = r >> 4; n = CTX; cap = 32; row0 = MLAT + b * CTX; slot0 = 2048 + b * 32; i = F.tid < CTX ? F.tid : -1; }
        for (int j = F.tid; j < n; j += 512) { const float v = AFF[(size_t)(row0 + j) * NE + e]; keys[j] = ((unsigned long long)__builtin_bit_cast(unsigned, v) << 32) | (unsigned)(0xFFFFFFFFu - (unsigned)j); }
        __syncthreads();
        int slot = -1; float gate = 0.f;
        if (i >= 0) { const unsigned long long ki = keys[i]; int cnt = 0;
            for (int j = 0; j < n; j += 4) { const unsigned long long k0 = keys[j], k1 = keys[j + 1], k2 = keys[j + 2], k3 = keys[j + 3]; cnt += (k0 > ki) + (k1 > ki) + (k2 > ki) + (k3 > ki); }
            if (cnt < cap) { slot = slot0 + cnt; gate = __builtin_bit_cast(float, (unsigned)(ki >> 32)); SELG[e * EROWS + slot] = gate; }
            INV[(size_t)(row0 + i) * NE + e] = slot; }
        unsigned long long m = __ballot(slot >= 0);
        while (m) { const int src = __builtin_ctzll(m); m &= m - 1;
            const int s = __shfl(slot, src), ii = __shfl(i, src);
            const v4u* hp = (const v4u*)(H + (size_t)(row0 + ii) * D) + F.lane; v4u* xp = (v4u*)(XS + ((size_t)e * EROWS + s) * D) + F.lane;
            xp[0] = hp[0]; xp[64] = hp[64]; }
        __syncthreads();
    }
}
__device__ __forceinline__ float conv3_at(const bf16* rowp, int t, int L, float w0, float w1, float w2, float bias) {
    const float xm = t > 0 ? bf2f(rowp[t - 1]) : 0.f, x0 = bf2f(rowp[t]), xp = t < L - 1 ? bf2f(rowp[t + 1]) : 0.f;
    return w0 * xm + w1 * x0 + w2 * xp + bias;
}
template <int L> __device__ __forceinline__ void hyena_direct_item(const Args& a, const Frame& F, int l, int c) {
    constexpr int NBQ = L == SEQ ? 4 : 8, NPASS = NB / NBQ, TP = L >= 512 ? L / 512 : 1, BP = NBQ * L / 512 / TP;
    constexpr int ROW0 = L == SEQ ? 0 : MLAT;
    LAS float* kk = (LAS float*)F.lds;
    LAS float* ub = kk + 2 * L;
    LAS float* zb = ub + NBQ * L;
    const bf16* HYT = (const bf16*)(a.ws + WS_HYT); bf16* YAT = (bf16*)(a.ws + WS_YAT);
    const float* TF = (const float*)(a.ws + WS_TF + (size_t)l * TF_LAYER + (L == SEQ ? 0 : TF_CTX_OFF));
    const float* cw = a.in[9] + (size_t)l * 3 * NHY; const float* cb = a.in[10] + (size_t)l * NHY;
    float w[3][3], bs[3];
#pragma unroll
    for (int s = 0; s < 3; ++s) { bs[s] = cb[s * D + c];
#pragma unroll
        for (int k = 0; k < 3; ++k) w[s][k] = cw[k * NHY + s * D + c]; }
    const float hb0 = a.in[17][((size_t)l * 2 + 0) * D + c], hb1 = a.in[17][((size_t)l * 2 + 1) * D + c];
    int tq[TP], bq[BP];
#pragma unroll
    for (int i = 0; i < TP; ++i) tq[i] = L >= 512 ? F.tid + 512 * i : (F.tid & (L - 1));
#pragma unroll
    for (int i = 0; i < BP; ++i) bq[i] = L >= 512 ? i : (F.tid / L) + (512 / L) * i;
    for (int ps = 0; ps < NPASS; ++ps) {
        for (int i = F.tid; i < NBQ * L; i += 512) { const int b = i / L, t = i % L; const bf16* rp = HYT + (size_t)(2 * D + c) * MTOT + ROW0 + (ps * NBQ + b) * L;
            ub[i] = conv3_at(rp, t, L, w[2][0], w[2][1], w[2][2], bs[2]); }
#pragma unroll 1
        for (int o = 0; o < 2; ++o) {
            __syncthreads();
            for (int t = F.tid; t < L; t += 512) { kk[L - 1 + t] = TF[((size_t)(o * 2 + 0) * D + c) * L + t]; if (t > 0) kk[L - 1 - t] = TF[((size_t)(o * 2 + 1) * D + c) * L + t]; }
            __syncthreads();
            const LAS float* src = o == 0 ? ub : zb;
            float acc[TP][BP];
#pragma unroll
            for (int i = 0; i < TP; ++i)
#pragma unroll
                for (int j = 0; j < BP; ++j) acc[i][j] = 0.f;
            for (int s = 0; s < L; ++s) { float kv[TP], uv[BP];
#pragma unroll
                for (int i = 0; i < TP; ++i) kv[i] = kk[tq[i] - s + L - 1];
#pragma unroll
                for (int j = 0; j < BP; ++j) uv[j] = src[bq[j] * L + s];
#pragma unroll
                for (int i = 0; i < TP; ++i)
#pragma unroll
                    for (int j = 0; j < BP; ++j) acc[i][j] += kv[i] * uv[j]; }
            __syncthreads();
#pragma unroll
            for (int i = 0; i < TP; ++i)
#pragma unroll
                for (int j = 0; j < BP; ++j) { const int t = tq[i], b = bq[j]; const int gb = ps * NBQ + b;
                    const bf16* rp = HYT + (size_t)(o * D + c) * MTOT + ROW0 + gb * L;
                    const float xg = o == 0 ? conv3_at(rp, t, L, w[0][0], w[0][1], w[0][2], bs[0]) : conv3_at(rp, t, L, w[1][0], w[1][1], w[1][2], bs[1]);
                    const float uin = src[b * L + t];
                    const float r = xg * (acc[i][j] + uin * (o == 0 ? hb0 : hb1));
                    if (o == 0) zb[b * L + t] = r; else YAT[(size_t)c * MTOT + ROW0 + gb * L + t] = (bf16)f2bf(r); }
        }
        __syncthreads();
    }
}

__device__ __forceinline__ void ph_sc(const Args& a, const Frame& F, int l, int nrows) {
    const int gw = F.vcu * 8 + F.wave, NGW = F.G * 8, lane = F.lane;
    const bf16* PR = (const bf16*)(a.ws + WS_PR); bf16* YC = (bf16*)(a.ws + WS_YCAT) + 2ull * MTOT * D;
    const float* cw = a.in[25] + (size_t)l * 3 * D;
    float w[3][16];
#pragma unroll
    for (int k = 0; k < 3; ++k)
#pragma unroll
        for (int j = 0; j < 16; ++j) w[k][j] = cw[k * D + lane * 16 + j];
    for (int row = gw; row < nrows; row += NGW) {
        const int L = row < MLAT ? SEQ : CTX, t = row < MLAT ? (row & (SEQ - 1)) : ((row - MLAT) & (CTX - 1));
        const bf16* pp = PR + (size_t)row * NPR + PR_P + lane * 16;
        v4u z = (v4u){0u, 0u, 0u, 0u};
        v4u m0 = z, m1 = z, n0 = z, n1 = z;
        if (t > 0) { m0 = *(const v4u*)(pp - NPR); m1 = *(const v4u*)(pp - NPR + 8); }
        if (t < L - 1) { n0 = *(const v4u*)(pp + NPR); n1 = *(const v4u*)(pp + NPR + 8); }
        const v4u c0 = *(const v4u*)pp, c1 = *(const v4u*)(pp + 8);
        const bf16* bp = PR + (size_t)row * NPR + PR_BG + lane * 16; const v4u g0 = *(const v4u*)bp, g1 = *(const v4u*)(bp + 8);
        unsigned mm[8] = {m0.x, m0.y, m0.z, m0.w, m1.x, m1.y, m1.z, m1.w}, cc[8] = {c0.x, c0.y, c0.z, c0.w, c1.x, c1.y, c1.z, c1.w}, nn[8] = {n0.x, n0.y, n0.z, n0.w, n1.x, n1.y, n1.z, n1.w}, gg[8] = {g0.x, g0.y, g0.z, g0.w, g1.x, g1.y, g1.z, g1.w};
        unsigned o[8];
#pragma unroll
        for (int j = 0; j < 8; ++j) {
            const float lo = bflo(gg[j]) * (w[0][2 * j] * bflo(mm[j]) + w[1][2 * j] * bflo(cc[j]) + w[2][2 * j] * bflo(nn[j]));
            const float hi = bfhi(gg[j]) * (w[0][2 * j + 1] * bfhi(mm[j]) + w[1][2 * j + 1] * bfhi(cc[j]) + w[2][2 * j + 1] * bfhi(nn[j]));
            o[j] = pk2(lo, hi); }
        v4u* op = (v4u*)(YC + (size_t)row * D + lane * 16); op[0] = (v4u){o[0], o[1], o[2], o[3]}; op[1] = (v4u){o[4], o[5], o[6], o[7]};
    }
}

__device__ __forceinline__ void ph_transpose_ya(const Args& a, const Frame& F, int nrows) {
    const int gw = F.vcu * 8 + F.wave, NGW = F.G * 8, lane = F.lane;
    LAS unsigned short* tl = (LAS unsigned short*)(F.lds + F.wave * 16384);
    const bf16* YAT = (const bf16*)(a.ws + WS_YAT); bf16* YA = (bf16*)(a.ws + WS_YCAT);
    const int nitems = (nrows / 64) * 16;
    for (int it = gw; it < nitems; it += NGW) {
        const int tb = it >> 4, cb = it & 15, tok0 = tb * 64, c0 = cb * 64;
        for (int i = 0; i < 64; ++i) tl[i * 66 + lane] = YAT[(size_t)(c0 + i) * MTOT + tok0 + lane];
        LDS_WAIT(); asm volatile("" ::: "memory");
        unsigned o[32];
#pragma unroll
        for (int j = 0; j < 32; ++j) o[j] = (unsigned)tl[(2 * j) * 66 + lane] | ((unsigned)tl[(2 * j + 1) * 66 + lane] << 16);
        v4u* op = (v4u*)(YA + (size_t)(tok0 + lane) * D + c0);
#pragma unroll
        for (int j = 0; j < 8; ++j) op[j] = (v4u){o[4 * j], o[4 * j + 1], o[4 * j + 2], o[4 * j + 3]};
        LDS_WAIT(); asm volatile("" ::: "memory");
    }
}

template <int PASS> __device__ __forceinline__ void lru_item(const Args& a, const Frame& F, int l, int q, int hd) {
    LAS float* raw = (LAS float*)F.lds;
    LAS float* xc = raw + 67 * 64;
    LAS float* GT = xc + 64 * 65;
    const bf16* PR = (const bf16*)(a.ws + WS_PR);
    const bool isctx = q >= 256; const int b = isctx ? (q - 256) >> 2 : q >> 5, qi = isctx ? (q - 256) & 3 : q & 31;
    const int L = isctx ? CTX : SEQ, seq0 = isctx ? MLAT + b * CTX : b * SEQ, t0 = qi * 64, c0 = hd * 64;
    const int tid = F.tid;
    __syncthreads();
    for (int i = tid; i < 67 * 64; i += 512) { const int tr = i >> 6, ch = i & 63, t = t0 - 2 + tr;
        raw[i] = (t >= 0 && t < L) ? bf2f(PR[(size_t)(seq0 + t) * NPR + PR_REC + c0 + ch]) : 0.f; }
    __syncthreads();
    { const float* cw = a.in[18] + (size_t)l * 4 * D + c0; const float* cb = a.in[19] + (size_t)l * D + c0;
      for (int i = tid; i < 64 * 64; i += 512) { const int tt = i >> 6, ch = i & 63;
          xc[tt * 65 + ch] = cw[ch] * raw[tt * 64 + ch] + cw[D + ch] * raw[(tt + 1) * 64 + ch] + cw[2 * D + ch] * raw[(tt + 2) * 64 + ch] + cw[3 * D + ch] * raw[(tt + 3) * 64 + ch] + cb[ch]; } }
    __syncthreads();
    {
      const int tt = tid & 63, og = __builtin_amdgcn_readfirstlane(tid >> 6), dir = og >> 2, ax = (og >> 1) & 1, j0 = (og & 1) * 32;
      const float* W = (ax ? a.in[22] : a.in[20]) + ((((size_t)l * 2 + dir) * 16 + hd) * 64) * 64 + j0;
      const float* bias = (ax ? a.in[23] : a.in[21]) + ((size_t)l * 2 + dir) * D + c0 + j0;
      float acc[32];
#pragma unroll
      for (int j = 0; j < 32; ++j) acc[j] = bias[j];
      for (int k = 0; k < 64; ++k) { const float xv = xc[tt * 65 + k]; const float* wk = W + k * 64;
#pragma unroll
          for (int j = 0; j < 32; ++j) acc[j] += xv * wk[j]; }
      LAS float* gp = GT + (dir * 2 + ax) * 64 * 65 + tt * 65 + j0;
#pragma unroll
      for (int j = 0; j < 32; ++j) gp[j] = 1.0f / (1.0f + expf(-acc[j])); }
    __syncthreads();
    {
      for (int i = tid; i < 2 * 64 * 64; i += 512) { const int dir = i >> 12, tt = (i >> 6) & 63, ch = i & 63;
          const float lam = a.in[24][((size_t)l * 2 + dir) * D + c0 + ch];
          const float sp = lam > 15.f ? expf(-lam) : log1pf(expf(-lam));
          LAS float* pr = GT + (dir * 2) * 64 * 65 + tt * 65 + ch; LAS float* pi = pr + 64 * 65;
          const float la = -8.0f * pr[0] * sp; const float av = expf(la); const float bv = sqrtf(-expm1f(2.0f * la)) * (pi[0] * xc[tt * 65 + ch]);
          pr[0] = av; pi[0] = bv; } }
    __syncthreads();
    float* AGG = (float*)(a.ws + WS_AGG);
    if (tid < 128) { const int dir = tid >> 6, ch = tid & 63; LAS float* pa = GT + (dir * 2) * 64 * 65 + ch; LAS float* pb = pa + 64 * 65;
        float h = 0.f;
        if (PASS == 2) {
            const float* ag = AGG + ((size_t)dir * NCHUNK) * D * 2 + (size_t)(c0 + ch) * 2;
            if (dir == 0) {
                if (!isctx) for (int p = 0; p < 4; ++p) { const float* g = ag + (size_t)(256 + b * 4 + p) * D * 2; h = g[0] * h + g[1]; }
                const int base = isctx ? 256 + b * 4 : b * 32;
                for (int p = 0; p < qi; ++p) { const float* g = ag + (size_t)(base + p) * D * 2; h = g[0] * h + g[1]; }
            } else {
                if (!isctx) for (int p = 3; p >= 0; --p) { const float* g = ag + (size_t)(256 + b * 4 + p) * D * 2; h = g[0] * h + g[1]; }
                const int base = isctx ? 256 + b * 4 : b * 32, last = isctx ? 3 : 31;
                for (int p = last; p > qi; --p) { const float* g = ag + (size_t)(base + p) * D * 2; h = g[0] * h + g[1]; }
            }
        }
        float ap = 1.f;
        if (dir == 0) { for (int tt = 0; tt < 64; ++tt) { const float av = pa[tt * 65]; h = av * h + pb[tt * 65]; ap *= av; if (PASS == 2) pb[tt * 65] = h; } }
        else { for (int tt = 63; tt >= 0; --tt) { const float av = pa[tt * 65]; h = av * h + pb[tt * 65]; ap *= av; if (PASS == 2) pb[tt * 65] = h; } }
        if (PASS == 1) { float* g = AGG + (((size_t)dir * NCHUNK + q) * D + c0 + ch) * 2; g[0] = ap; g[1] = h; }
    }
    if (PASS == 2) {
        __syncthreads();
        bf16* YB = (bf16*)(a.ws + WS_YCAT) + (size_t)MTOT * D;
        for (int i = tid; i < 64 * 64; i += 512) { const int tt = i >> 6, ch = i & 63; const size_t row = (size_t)seq0 + t0 + tt;
            const float gg = bf2f(PR[row * NPR + PR_GELU + c0 + ch]);
            YB[row * D + c0 + ch] = (bf16)f2bf(gg * (GT[(0 * 2 + 1) * 64 * 65 + tt * 65 + ch] + GT[(1 * 2 + 1) * 64 * 65 + tt * 65 + ch])); }
    }
}
#ifndef MK_SINGLE
#define MK_SINGLE 0
#endif
__global__ void __launch_bounds__(512, 2) mk_fwd(Args args) {
    extern __shared__ __attribute__((aligned(16))) unsigned char lds[];
    Frame F;
    F.lds = (LAS unsigned char*)lds;
    F.tid = threadIdx.x; F.lane = F.tid & 63; F.wave = __builtin_amdgcn_readfirstlane(F.tid >> 6);
    F.G = gridDim.x; { const int bx = blockIdx.x; F.vcu = (F.G % 8 == 0) ? (bx % 8) * (F.G / 8) + bx / 8 : bx; }
    volatile LAS unsigned* MISC = (volatile LAS unsigned*)(F.lds + MISC_OFF);
    for (int u = F.tid; u < 32; u += 512) MISC[u] = 0u;
    __syncthreads();
    unsigned* ctl = (unsigned*)(args.ws + WS_CTL);
    XcdBarrier bar; bar.bar = ctl + CW_BAR + args.li * XCD_BAR_WORDS; bar.x = 0; bar.st = nullptr;
    if (MK_SINGLE) bar = xcd_barrier_post(ctl + CW_BAR + args.li * XCD_BAR_WORDS, MISC + 8);
    const int lo = args.ph_lo, hi = args.ph_hi;
#define IN(k) (lo <= (k) && (k) < hi)
#define SEAM(k) do { if (MK_SINGLE && IN((k) + 1)) xcd_barrier(bar); } while (0)
    const int bid = (int)blockIdx.x; const int vcu0 = F.vcu, G0 = F.G;
#define LAUNDER() do { int t_ = threadIdx.x; asm volatile("" : "+v"(t_)); F.tid = t_; F.lane = t_ & 63; F.wave = __builtin_amdgcn_readfirstlane(t_ >> 6); int g_ = G0, v_ = vcu0; asm volatile("" : "+s"(g_), "+s"(v_)); F.G = g_; F.vcu = v_; } while (0)
    LAS unsigned char* ring = F.lds;

    if (IN(0)) { LAUNDER(); ph_prologue(args, F); SEAM(0); }
    if (IN(1)) { LAUNDER(); ph_filters(args, F); SEAM(1); }
#pragma unroll 1
    for (int l = 0; l < 2; ++l) {
        const int pb = 2 + 10 * l;
        const int mrows = l == 0 ? MTOT : MLAT;
        bf16* WIN = (bf16*)(args.ws + WS_WIN) + (size_t)l * NIN * D; bf16* WOUT = (bf16*)(args.ws + WS_WOUT) + (size_t)l * 4 * D * D;
        bf16* H = (bf16*)(args.ws + WS_H); bf16* PR = (bf16*)(args.ws + WS_PR); bf16* YCAT = (bf16*)(args.ws + WS_YCAT);
        if (IN(pb + 0)) {
            LAUNDER();
            if (l == 0) ph_norm<0, false>(args, F, l); else ph_norm<0, true>(args, F, l);
            __syncthreads();
            LAUNDER();
            ph_wexp(args, F, l);
            SEAM(pb + 0);
        }
        if (IN(pb + 1)) {
            { pg8::Gemm g{WIN, H, NHY, mrows, D}; RectOrder S; S.init(NHY / 256, mrows / 256, 0, 0, 0, 0, F.G, bid);
              EpiPlainBf16 E{(bf16*)(args.ws + WS_HYT), MTOT};
              pg8::gemm_phase<EpiPlainBf16, RectOrder, true, true>(ring, g, S, E); }
            { pg8::Gemm g{H, WIN + (size_t)NHY * D, MTOT, N2, D}; RectOrder S;
              if (l == 0) S.init(MTOT / 256, N2 / 256, 0, 0, 0, 0, F.G, bid); else S.init(MLAT / 256, N2 / 256, MCTX / 256, 4, MLAT / 256, 4, F.G, bid);
              EpiInProj E{PR};
              pg8::gemm_phase<EpiInProj, RectOrder, true, true>(ring, g, S, E); }
            SEAM(pb + 1);
        }
        if (IN(pb + 2)) {
            LAUNDER();
            for (int it = F.vcu; it < NCHUNK * 16; it += F.G) lru_item<1>(args, F, l, it >> 4, it & 15);
            __syncthreads();
            LAUNDER();
            for (int c = F.vcu; c < D; c += F.G) hyena_direct_item<SEQ>(args, F, l, c);
            LAUNDER();
            if (l == 0) for (int c = F.vcu; c < D; c += F.G) hyena_direct_item<CTX>(args, F, l, c);
            LAUNDER();
            ph_sc(args, F, l, mrows);
            SEAM(pb + 2);
        }
        if (IN(pb + 3)) {
            LAUNDER();
            for (int it = F.vcu; it < (mrows / LCH) * 16; it += F.G) lru_item<2>(args, F, l, it >> 4, it & 15);
            __syncthreads();
            LAUNDER();
            ph_transpose_ya(args, F, mrows);
            SEAM(pb + 3);
        }
        if (IN(pb + 4)) {
            float* M32 = (float*)(args.ws + WS_M32); bf16* MB = (bf16*)(args.ws + WS_MB);
            RectOrder S; S.init(mrows / 256, 4, 0, 0, 0, 0, F.G, bid);
            { pg8::Gemm g{YCAT, WOUT, mrows, D, D}; EpiGate<0> E{PR + PR_GATE, M32, MB}; pg8::gemm_phase<EpiGate<0>, RectOrder, true, true>(ring, g, S, E); }
            { pg8::Gemm g{YCAT + (size_t)MTOT * D, WOUT + (size_t)D * D, mrows, D, D}; EpiGate<1> E{PR + PR_GATE + 1024, M32, MB}; pg8::gemm_phase<EpiGate<1>, RectOrder, true, true>(ring, g, S, E); }
            { pg8::Gemm g{YCAT + 2ull * MTOT * D, WOUT + 2ull * D * D, mrows, D, D}; EpiGate<2> E{PR + PR_GATE + 2048, M32, MB}; pg8::gemm_phase<EpiGate<2>, RectOrder, true, true>(ring, g, S, E); }
            SEAM(pb + 4);
        }
        if (IN(pb + 5)) {
            pg8::Gemm g{(bf16*)(args.ws + WS_MB), WOUT + 3ull * D * D, mrows, D, D}; RectOrder S; S.init(mrows / 256, 4, 0, 0, 0, 0, F.G, bid);
            EpiResid E{(float*)(args.ws + WS_X), (const float*)(args.ws + WS_MOD) + (size_t)l * 9 * 6144 + 2 * 1024};
            pg8::gemm_phase<EpiResid, RectOrder, true, true>(ring, g, S, E);
            SEAM(pb + 5);
        }
        if (IN(pb + 6)) { LAUNDER(); ph_norm<1, false>(args, F, l); SEAM(pb + 6); }
        if (IN(pb + 7)) { LAUNDER(); ph_rank(args, F, l); SEAM(pb + 7); }
        if (IN(pb + 8)) {
            pg8::Gemm g{(bf16*)(args.ws + WS_XS), (bf16*)(args.ws + WS_WGU), NE * EROWS, NE * NGU, D}; GroupOrder S; S.init(NE, l == 0 ? 9 : 8, 9, 22, F.G, bid);
            EpiSwiglu E{(bf16*)(args.ws + WS_HID)};
            pg8::gemm_phase<EpiSwiglu, GroupOrder, true, true>(ring, g, S, E);
            SEAM(pb + 8);
        }
        if (IN(pb + 9)) {
            pg8::Gemm g{(bf16*)(args.ws + WS_HID), (bf16*)(args.ws + WS_WD), NE * EROWS, NE * D, DE}; GroupOrder S; S.init(NE, l == 0 ? 9 : 8, 9, 4, F.G, bid);
            EpiYs E{(float*)(args.ws + WS_YS)};
            pg8::gemm_phase<EpiYs, GroupOrder, true, true>(ring, g, S, E);
            SEAM(pb + 9);
        }
    }
    if (IN(22)) { LAUNDER(); ph_norm<2, true>(args, F, 1); }
#undef IN
#undef SEAM
}

extern "C" void kernel_launch(void* const* d_in, const int* in_sizes, int n_in, void* d_out, int out_size, void* d_ws, size_t ws_size, hipStream_t stream) {
    static int grid = 0;
    if (grid == 0) {
        if (n_in != 35 || out_size != MLAT * D || ws_size < WS_END) { fprintf(stderr, "kernel_launch: unexpected shapes (n_in %d, out %d, ws %zu < %zu)\n", n_in, out_size, ws_size, (size_t)WS_END); grid = -1; return; }
        int dev = 0, cus = 0, per_cu = 0;
        if (hipGetDevice(&dev) != hipSuccess || hipDeviceGetAttribute(&cus, hipDeviceAttributeMultiprocessorCount, dev) != hipSuccess) { grid = -1; return; }
        if (hipFuncSetAttribute((const void*)mk_fwd, hipFuncAttributeMaxDynamicSharedMemorySize, LDS_BYTES) != hipSuccess) { fprintf(stderr, "kernel_launch: hipFuncSetAttribute failed\n"); grid = -1; return; }
        if (hipOccupancyMaxActiveBlocksPerMultiprocessor(&per_cu, (const void*)mk_fwd, 512, LDS_BYTES) != hipSuccess || per_cu < 1) fprintf(stderr, "kernel_launch: occupancy query says %d\n", per_cu);
        (void)hipGetLastError();
        grid = cus;
    }
    if (grid < 0) return;
    if (hipMemsetAsync((char*)d_ws + WS_CTL, 0, CTL_ZERO_BYTES, stream) != hipSuccess) return;
    Args a{};
    for (int i = 0; i < 35; ++i) a.in[i] = (const float*)d_in[i];
    a.out = (float*)d_out; a.ws = (unsigned char*)d_ws; a.pad = 0;
#if MK_SINGLE
    a.ph_lo = 0; a.ph_hi = NPHASE; a.li = 0;
    hipLaunchKernelGGL(mk_fwd, dim3(grid), dim3(512), LDS_BYTES, stream, a);
#else
    for (int p = 0; p < NPHASE; ++p) { a.ph_lo = p; a.ph_hi = p + 1; a.li = 0; hipLaunchKernelGGL(mk_fwd, dim3(grid), dim3(512), LDS_BYTES, stream, a); }
#endif
}
```

```cpp
#include <hip/hip_runtime.h>
#include <cstdio>
#include <cstdint>
namespace pg8 {
#define PG8_LAS __attribute__((address_space(3)))
typedef unsigned short bf16_t;
typedef short bf16x8 __attribute__((ext_vector_type(8)));
typedef float f32x4 __attribute__((ext_vector_type(4)));
typedef unsigned u32x4 __attribute__((ext_vector_type(4)));
constexpr int BM = 256, BK = 64, HALF = 128, HTB = HALF * BK * 2  , STAGE_BYTES = 8 * HTB, NXCD = 8, WGM = 8;

__host__ __device__ __forceinline__ int lds_byte(int r, int c) { const int st = (r >> 4) * 2 + (c >> 5), rr = r & 15, cc = c & 31, ob = rr * 64 + cc * 2; return st * 1024 + (ob ^ (((ob >> 9) & 1) << 5)); }
__host__ __device__ __forceinline__ void stage_rc(int b, int& R, int& C) { const int st = b / 1024, sb = b % 1024, swz = sb ^ (((sb >> 9) & 1) << 5); R = (st >> 1) * 16 + swz / 64; C = (st & 1) * 32 + (swz % 64) / 2; }
__host__ __device__ __forceinline__ int perm32(int rho) { const int n = rho >> 4, i = rho & 15; return 8 * (i >> 2) + 4 * n + (i & 3); }

struct Unit { int pm, pn; };
struct Gemm { const bf16_t* A; const bf16_t* Bt; int M, N, K; };

struct StaticOrder {
    int nM, nN, nwg, G, c;
    __host__ __device__ void init(int M, int N, int G_, int c_) { nM = M / BM; nN = N / BM; nwg = nM * nN; G = G_; c = c_; }
    __host__ __device__ bool next(int i, Unit& u) const {
        const long L = (long)i * G + c; if (L >= nwg) return false;
        int wgid = (int)L; { const int q = nwg / NXCD, r = nwg % NXCD, xcd = wgid % NXCD, off = wgid / NXCD; wgid = (xcd < r ? xcd * (q + 1) : r * (q + 1) + (xcd - r) * q) + off; }
        const int nig = WGM * nN, gid = wgid / nig, fm = gid * WGM, gsz = (nM - fm) < WGM ? (nM - fm) : WGM;
        u.pm = fm + ((wgid % nig) % gsz); u.pn = (wgid % nig) / gsz; return true;
    }
    __device__ __forceinline__ void a_ready(const Unit&) const {}
    __device__ __forceinline__ void done(const Unit&) const {}
};
__device__ __forceinline__ unsigned cvt_pk_bf16(float lo, float hi) { unsigned r; asm volatile("v_cvt_pk_bf16_f32 %0, %1, %2" : "=v"(r) : "v"(lo), "v"(hi)); return r; }
typedef float f32x2 __attribute__((ext_vector_type(2)));
typedef int i32x4_ __attribute__((ext_vector_type(4))); typedef int i32x8_ __attribute__((ext_vector_type(8)));
__device__ __forceinline__ bf16x8 frag_lo(i32x8_ v) { const i32x4_ t = __builtin_shufflevector(v, v, 0, 1, 2, 3); return __builtin_bit_cast(bf16x8, t); }
__device__ __forceinline__ bf16x8 frag_hi(i32x8_ v) { const i32x4_ t = __builtin_shufflevector(v, v, 4, 5, 6, 7); return __builtin_bit_cast(bf16x8, t); }
__device__ __forceinline__ i32x8_ cat8(bf16x8 lo, bf16x8 hi) { const i32x4_ a = __builtin_bit_cast(i32x4_, lo), b = __builtin_bit_cast(i32x4_, hi); return __builtin_shufflevector(a, b, 0, 1, 2, 3, 4, 5, 6, 7); }
template <class Epi, class Sched, bool ALIGN_EPI = false, bool SP2 = false, bool FP8 = false>
__device__ __forceinline__ void gemm_phase(PG8_LAS unsigned char* lds, const Gemm g, const Sched& S, const Epi& E) {
    int tid_ = threadIdx.x; asm volatile("" : "+v"(tid_));
    const int tid = tid_, wid = __builtin_amdgcn_readfirstlane(tid >> 6), lane = tid & 63, wr = wid >> 2, wc = wid & 3, fr = lane & 15, fq = lane >> 4;
    const int K = g.K, nt = K / BK;
    unsigned voffA[2], voffB[2];
#pragma unroll
    for (int i = 0; i < 2; ++i) { int R, C; stage_rc(tid * 16 + i * 8192, R, C); const int Rb = Epi::PERM ? ((R & ~31) + perm32(R & 31)) : R;
        const int ch = C >> 3; const unsigned Cb = FP8 ? (unsigned)(((ch & 3) * 2 + (ch >> 2)) * 16) : (unsigned)C * 2u;
        voffA[i] = (unsigned)(R * K) * 2u + Cb; voffB[i] = (unsigned)(Rb * K) * 2u + Cb; }
    const size_t kstep = (size_t)(BK * 2);
    const size_t hstep = (size_t)HALF * K * 2;
    const size_t tstep = 2 * hstep;
    const unsigned ldsw = (unsigned)wid * 1024u;
    const int aoff = lds_byte(wr * 64 + fr, fq * 8), boff = lds_byte(wc * 32 + fr, fq * 8);
#define PG8_SA(b, h) (((b) * 2 + (h)) * HTB)
#define PG8_SB(b, h) ((4 + (b) * 2 + (h)) * HTB)
#define PG8_STAGE(bufoff, gbase, voff) do { _Pragma("unroll") for (int _i = 0; _i < 2; ++_i) \
        __builtin_amdgcn_global_load_lds((const unsigned*)((const char*)(gbase) + (voff)[_i]), (PG8_LAS unsigned*)(lds + (bufoff) + ldsw + _i * 8192), 16, 0, 0); } while (0)
#define PG8_LDA(dst, b, h) do { _Pragma("unroll") for (int m = 0; m < 4; ++m) { dst[m].lo = *(const PG8_LAS i32x4_*)(lds + PG8_SA(b, h) + aoff + m * 2048); dst[m].hi = *(const PG8_LAS i32x4_*)(lds + PG8_SA(b, h) + aoff + m * 2048 + 1024); } } while (0)
#define PG8_LDB(dst, b, h) do { _Pragma("unroll") for (int n = 0; n < 2; ++n) { dst[n].lo = *(const PG8_LAS i32x4_*)(lds + PG8_SB(b, h) + boff + n * 2048); dst[n].hi = *(const PG8_LAS i32x4_*)(lds + PG8_SB(b, h) + boff + n * 2048 + 1024); } } while (0)
#define PG8_MMA(ai, bj, At, Bt) do { __builtin_amdgcn_s_setprio(1); if constexpr (FP8) { _Pragma("unroll") for (int m = 0; m < 4; ++m) _Pragma("unroll") for (int n = 0; n < 2; ++n) \
        asm volatile("v_mfma_scale_f32_16x16x128_f8f6f4 %0, %1, %2, %0, %3, %4 op_sel_hi:[0,0,0]" : "+v"(acc[ai][bj][m][n]) : "v"(Bt[n]), "v"(At[m]), "v"(sclw), "v"(scla)); } \
        else { _Pragma("unroll") for (int m = 0; m < 4; ++m) _Pragma("unroll") for (int n = 0; n < 2; ++n) { \
        acc[ai][bj][m][n] = __builtin_amdgcn_mfma_f32_16x16x32_bf16(frag_lo(Bt[n]), frag_lo(At[m]), acc[ai][bj][m][n], 0, 0, 0); \
        acc[ai][bj][m][n] = __builtin_amdgcn_mfma_f32_16x16x32_bf16(frag_hi(Bt[n]), frag_hi(At[m]), acc[ai][bj][m][n], 0, 0, 0); } } __builtin_amdgcn_s_setprio(0); } while (0)
#define PG8_WAIT_V(n) asm volatile("s_waitcnt vmcnt(" #n ")" ::: "memory")
#define PG8_WAIT_L(n) asm volatile("s_waitcnt lgkmcnt(" #n ")" ::: "memory")
#define PG8_BAR __builtin_amdgcn_s_barrier()
#define PG8_SCHED __builtin_amdgcn_sched_barrier(0)
    Unit cur, nxt; int ui = 0;
    if (!S.next(0, cur)) return;
    f32x4 acc[2][2][4][2];
#pragma unroll
    for (int a = 0; a < 2; ++a)
#pragma unroll
        for (int b = 0; b < 2; ++b)
#pragma unroll
            for (int m = 0; m < 4; ++m)
#pragma unroll
                for (int n = 0; n < 2; ++n) acc[a][b][m][n] = (f32x4){0.f, 0.f, 0.f, 0.f};
    i32x8_ At[4], B0[2], B1[2];
    int sclw = 0x7a7a7a7a, scla = 0x7f7f7f7f;
    if constexpr (FP8) asm volatile("" : "+v"(sclw), "+v"(scla));
    const char* cA = (const char*)g.A + (size_t)cur.pm * tstep; const char* cB = (const char*)g.Bt + (size_t)cur.pn * tstep;
    S.a_ready(cur);
    if constexpr (SP2) {
        PG8_STAGE(PG8_SB(0, 0), cB, voffB); PG8_STAGE(PG8_SB(0, 1), cB + hstep, voffB); PG8_STAGE(PG8_SA(0, 0), cA, voffA); PG8_STAGE(PG8_SA(0, 1), cA + hstep, voffA);
        if (wr == 1) PG8_BAR;
        PG8_WAIT_V(2); PG8_BAR;
        PG8_STAGE(PG8_SB(1, 0), cB + kstep, voffB); PG8_STAGE(PG8_SA(1, 0), cA + kstep, voffA); PG8_STAGE(PG8_SB(1, 1), cB + hstep + kstep, voffB);
        PG8_WAIT_V(6); PG8_BAR;
    } else {
        PG8_STAGE(PG8_SB(0, 0), cB, voffB); PG8_STAGE(PG8_SA(0, 0), cA, voffA); PG8_STAGE(PG8_SB(0, 1), cB + hstep, voffB); PG8_STAGE(PG8_SA(0, 1), cA + hstep, voffA);
        if (wr == 1) PG8_BAR;
        PG8_WAIT_V(4); PG8_BAR;
        PG8_STAGE(PG8_SB(1, 0), cB + kstep, voffB); PG8_STAGE(PG8_SA(1, 0), cA + kstep, voffA); PG8_STAGE(PG8_SB(1, 1), cB + hstep + kstep, voffB);
        PG8_WAIT_V(6); PG8_BAR;
    }
    for (;;) {
        const bool has_next = S.next(ui + 1, nxt);
        const char* nA = has_next ? (const char*)g.A + (size_t)nxt.pm * tstep : cA; const char* nB = has_next ? (const char*)g.Bt + (size_t)nxt.pn * tstep : cB;
#pragma unroll 1
        for (int t = 0; t < nt; t += 2) {
            const bool last = (t == nt - 2);
            const char* a1 = cA + (size_t)(t + 1) * kstep;
            const char* a2 = last ? nA : cA + (size_t)(t + 2) * kstep; const char* b2 = last ? nB : cB + (size_t)(t + 2) * kstep;
            const char* a3 = a2 + kstep; const char* b3 = b2 + kstep;
            if (last && has_next) S.a_ready(nxt);
            if constexpr (SP2) {
            PG8_LDB(B0, 0, 0); PG8_LDB(B1, 0, 1); PG8_SCHED; PG8_LDA(At, 0, 0); PG8_STAGE(PG8_SA(1, 1), a1 + hstep, voffA);
            PG8_WAIT_V(8); PG8_WAIT_L(0); PG8_BAR; PG8_MMA(0, 0, At, B0); PG8_MMA(0, 1, At, B1); PG8_BAR; PG8_SCHED;
            PG8_LDA(At, 0, 1); PG8_STAGE(PG8_SB(0, 0), b2, voffB); PG8_STAGE(PG8_SB(0, 1), b2 + hstep, voffB); PG8_STAGE(PG8_SA(0, 0), a2, voffA);
            PG8_WAIT_V(8); PG8_WAIT_L(0); PG8_BAR; PG8_MMA(1, 0, At, B0); PG8_MMA(1, 1, At, B1); PG8_BAR; PG8_SCHED;
            PG8_LDB(B0, 1, 0); PG8_LDB(B1, 1, 1); PG8_SCHED; PG8_LDA(At, 1, 0); PG8_STAGE(PG8_SA(0, 1), a2 + hstep, voffA);
            PG8_WAIT_V(8); PG8_WAIT_L(0); PG8_BAR; PG8_MMA(0, 0, At, B0); PG8_MMA(0, 1, At, B1); PG8_BAR; PG8_SCHED;
            PG8_LDA(At, 1, 1); PG8_STAGE(PG8_SB(1, 0), b3, voffB); PG8_STAGE(PG8_SB(1, 1), b3 + hstep, voffB); PG8_STAGE(PG8_SA(1, 0), a3, voffA);
            PG8_WAIT_V(8); PG8_WAIT_L(0); PG8_BAR; PG8_MMA(1, 0, At, B0); PG8_MMA(1, 1, At, B1); PG8_BAR; PG8_SCHED;
            } else {
            PG8_LDB(B0, 0, 0); PG8_SCHED; PG8_LDA(At, 0, 0); PG8_STAGE(PG8_SA(1, 1), a1 + hstep, voffA);
            PG8_WAIT_L(8); PG8_BAR; PG8_WAIT_L(0); PG8_MMA(0, 0, At, B0); PG8_BAR; PG8_SCHED;
            PG8_LDB(B1, 0, 1); PG8_STAGE(PG8_SB(0, 0), b2, voffB);
            PG8_BAR; PG8_WAIT_L(0); PG8_MMA(0, 1, At, B1); PG8_BAR;
            PG8_LDA(At, 0, 1); PG8_STAGE(PG8_SA(0, 0), a2, voffA);
            PG8_BAR; PG8_WAIT_L(0); PG8_MMA(1, 0, At, B0); PG8_BAR; PG8_SCHED;
            PG8_STAGE(PG8_SB(0, 1), b2 + hstep, voffB);
            PG8_WAIT_V(6); PG8_BAR; PG8_MMA(1, 1, At, B1); PG8_BAR;
            PG8_LDB(B0, 1, 0); PG8_SCHED; PG8_LDA(At, 1, 0); PG8_STAGE(PG8_SA(0, 1), a2 + hstep, voffA);
            PG8_WAIT_L(8); PG8_BAR; PG8_WAIT_L(0); PG8_MMA(0, 0, At, B0); PG8_BAR; PG8_SCHED;
            PG8_LDB(B1, 1, 1); PG8_STAGE(PG8_SB(1, 0), b3, voffB);
            PG8_BAR; PG8_WAIT_L(0); PG8_MMA(0, 1, At, B1); PG8_BAR;
            PG8_LDA(At, 1, 1); PG8_STAGE(PG8_SA(1, 0), a3, voffA);
            PG8_BAR; PG8_WAIT_L(0); PG8_MMA(1, 0, At, B0); PG8_BAR; PG8_SCHED;
            PG8_STAGE(PG8_SB(1, 1), b3 + hstep, voffB);
            PG8_WAIT_V(6); PG8_BAR; PG8_MMA(1, 1, At, B1); PG8_BAR;
            }
        }
        if constexpr (ALIGN_EPI) { if (wr == 0) PG8_BAR; }
        if constexpr (FP8) asm volatile("s_nop 15\n\ts_nop 15" ::: "memory");
        if constexpr (!Epi::AFTER_DRAIN) { E(acc, cur, wr, wc, fr, fq); S.done(cur); }
        if (!has_next) break;
        if (!(Epi::CHAIN && E.keep(cur))) {
#pragma unroll
        for (int a = 0; a < 2; ++a)
#pragma unroll
            for (int b = 0; b < 2; ++b)
#pragma unroll
                for (int m = 0; m < 4; ++m)
#pragma unroll
                    for (int n = 0; n < 2; ++n) acc[a][b][m][n] = (f32x4){0.f, 0.f, 0.f, 0.f};
        }
        cur = nxt; cA = nA; cB = nB; ++ui;
        if constexpr (ALIGN_EPI) { if (wr == 1) PG8_BAR; }
    }
    PG8_WAIT_V(0);
    if constexpr (!ALIGN_EPI) { if (wr == 0) PG8_BAR; }
    PG8_BAR;
    if constexpr (Epi::AFTER_DRAIN) { E.fused(acc, cur, wr, wc, fr, fq, lds, wid, lane); S.done(cur); }
#undef PG8_SA
#undef PG8_SB
#undef PG8_STAGE
#undef PG8_LDA
#undef PG8_LDB
#undef PG8_MMA
#undef PG8_WAIT_V
#undef PG8_WAIT_L
#undef PG8_BAR
#undef PG8_SCHED
}
}
#define GAS __attribute__((address_space(1)))
#define LAS __attribute__((address_space(3)))
typedef unsigned short bf16;
typedef unsigned v4u __attribute__((ext_vector_type(4)));
typedef unsigned v2u __attribute__((ext_vector_type(2)));
typedef float f32x4 __attribute__((ext_vector_type(4)));
typedef float f32x2 __attribute__((ext_vector_type(2)));
typedef short bf16x8 __attribute__((ext_vector_type(8)));
typedef GAS unsigned gu32;
#define RLX_AGENT __ATOMIC_RELAXED, __HIP_MEMORY_SCOPE_AGENT
#define LDS_WAIT() asm volatile("s_waitcnt lgkmcnt(0)" ::: "memory")
#define VM_WAIT() asm volatile("s_waitcnt vmcnt(0)" ::: "memory")
__device__ __forceinline__ unsigned f2bf(float f) { unsigned u = __builtin_bit_cast(unsigned, f); return (u + 0x7fffu + ((u >> 16) & 1u)) >> 16; }
__device__ __forceinline__ unsigned pk2(float lo, float hi) { return f2bf(lo) | (f2bf(hi) << 16); }
__device__ __forceinline__ float bf2f(unsigned short b) { return __builtin_bit_cast(float, ((unsigned)b) << 16); }
__device__ __forceinline__ float bflo(unsigned w) { return __builtin_bit_cast(float, w << 16); }
__device__ __forceinline__ float bfhi(unsigned w) { return __builtin_bit_cast(float, w & 0xffff0000u); }
__device__ __forceinline__ float sigmoidf_(float x) { return __builtin_amdgcn_rcpf(1.0f + __expf(-x)); }
__device__ __forceinline__ float gelu_tanh_(float x) { const float t = 1.5957691216f * (x + 0.044715f * x * x * x); return x * __builtin_amdgcn_rcpf(1.0f + __expf(-t)); }
__device__ __forceinline__ unsigned pk4_fp8(float a, float b, float c, float d) { int w = 0; w = __builtin_amdgcn_cvt_pk_fp8_f32(a, b, w, false); w = __builtin_amdgcn_cvt_pk_fp8_f32(c, d, w, true); return (unsigned)w; }
__device__ __forceinline__ float silu_(float x) { return x * __builtin_amdgcn_rcpf(1.0f + __expf(-x)); }

constexpr int D = 1024, NB = 8, SEQ = 2048, CTX = 256;
constexpr int MLAT = NB * SEQ, MCTX = NB * CTX, MTOT = MLAT + MCTX;
constexpr int NHY = 3072, N2 = 8192, NPR = 7168, NIN = 11264;
constexpr int NE = 16, DE = 2816, EROWS = 2304, NGU = 2 * DE;
constexpr int PR_GELU = 0, PR_REC = 1024, PR_BG = 2048, PR_P = 3072, PR_GATE = 4096;
constexpr int LCH = 64, NCHUNK = MTOT / LCH;

__device__ __forceinline__ int xcd_remap(int wgid, int nwg) { const int q = nwg / 8, r = nwg % 8, xcd = wgid % 8, off = wgid / 8; return (xcd < r ? xcd * (q + 1) : r * (q + 1) + (xcd - r) * q) + off; }

struct RectOrder {
    int nM1, nN1, n1, nM2, nN2, n2, pm2, pn2, G, c;
    __device__ void init(int nM1_, int nN1_, int nM2_, int nN2_, int pm2_, int pn2_, int G_, int c_) { nM1 = nM1_; nN1 = nN1_; n1 = nM1 * nN1; nM2 = nM2_; nN2 = nN2_; n2 = nM2 * nN2; pm2 = pm2_; pn2 = pn2_; G = G_; c = c_; }
    __device__ bool next(int i, pg8::Unit& u) const {
        const int L = i * G + c;
        if (L < n1) { const int wgid = xcd_remap(L, n1); const int nig = 8 * nN1, gid = wgid / nig, fm = gid * 8, gsz = (nM1 - fm) < 8 ? (nM1 - fm) : 8;
            u.pm = fm + ((wgid % nig) % gsz); u.pn = (wgid % nig) / gsz; return true; }
        const int L2 = L - n1; if (L2 >= n2) return false;
        u.pm = pm2 + L2 % nM2; u.pn = pn2 + L2 / nM2; return true;
    }
    __device__ __forceinline__ void a_ready(const pg8::Unit&) const {}
    __device__ __forceinline__ void done(const pg8::Unit&) const {}
};
struct GroupOrder {
    int mt, mstride, nt, nwg, G, c;
    __device__ void init(int nE, int mt_, int mstride_, int nt_, int G_, int c_) { mt = mt_; mstride = mstride_; nt = nt_; nwg = nE * mt * nt; G = G_; c = c_; }
    __device__ bool next(int i, pg8::Unit& u) const {
        const int L = i * G + c; if (L >= nwg) return false;
        const int wgid = xcd_remap(L, nwg); const int per = mt * nt, e = wgid / per, r = wgid % per;
        u.pm = e * mstride + r % mt; u.pn = e * nt + r / mt; return true;
    }
    __device__ __forceinline__ void a_ready(const pg8::Unit&) const {}
    __device__ __forceinline__ void done(const pg8::Unit&) const {}
};


struct TripleOrder {
    int nM, ntile, mstride, G, c;
    __device__ void init(int nM_, int mstride_, int G_, int c_) { nM = nM_; ntile = nM_ * 4; mstride = mstride_; G = G_; c = c_; }
    __device__ bool next(int u, pg8::Unit& un) const {
        const int t = u / 3, i = u - 3 * t, L = t * G + c; if (L >= ntile) return false;
        const int wgid = xcd_remap(L, ntile); const int nig = 8 * 4, gid = wgid / nig, fm = gid * 8, gsz = (nM - fm) < 8 ? (nM - fm) : 8;
        un.pm = i * mstride + fm + ((wgid % nig) % gsz); un.pn = i * 4 + (wgid % nig) / gsz; return true;
    }
    __device__ __forceinline__ void a_ready(const pg8::Unit&) const {}
    __device__ __forceinline__ void done(const pg8::Unit&) const {}
};

#define EPI_ROW(u, ai, m) ((u).pm * 256 + wr * 64 + fr + (ai) * 128 + (m) * 16)
struct EpiPlainBf16 {
    static constexpr bool PERM = true, AFTER_DRAIN = false, CHAIN = false; __device__ __forceinline__ bool keep(const pg8::Unit&) const { return false; }
    bf16* O; int ldc;
    __device__ __forceinline__ void operator()(const f32x4 (&acc)[2][2][4][2], const pg8::Unit& u, int wr, int wc, int fr, int fq) const {
        const int col0 = u.pn * 256 + wc * 32 + 8 * fq;
#pragma unroll
        for (int ai = 0; ai < 2; ++ai)
#pragma unroll
            for (int m = 0; m < 4; ++m) { bf16* rowp = O + (size_t)EPI_ROW(u, ai, m) * ldc + col0;
#pragma unroll
                for (int bj = 0; bj < 2; ++bj) { const f32x4 v0 = acc[ai][bj][m][0], v1 = acc[ai][bj][m][1];
                    v4u w; w.x = pg8::cvt_pk_bf16(v0[0], v0[1]); w.y = pg8::cvt_pk_bf16(v0[2], v0[3]); w.z = pg8::cvt_pk_bf16(v1[0], v1[1]); w.w = pg8::cvt_pk_bf16(v1[2], v1[3]);
                    *(v4u*)(rowp + bj * 128) = w; } }
    }
};
struct EpiInProj {
    static constexpr bool PERM = true, AFTER_DRAIN = false, CHAIN = false; __device__ __forceinline__ bool keep(const pg8::Unit&) const { return false; }
    bf16* PR;
    __device__ __forceinline__ void operator()(const f32x4 (&acc)[2][2][4][2], const pg8::Unit& u, int wr, int wc, int fr, int fq) const {
        const int pn = u.pn;
        if (pn >= 12 && pn < 20) {
            const int col = PR_P + (pn - 12) * 128 + wc * 32 + 8 * fq;
#pragma unroll
            for (int ai = 0; ai < 2; ++ai)
#pragma unroll
                for (int m = 0; m < 4; ++m) { const f32x4 v0 = acc[ai][0][m][0] * acc[ai][1][m][0], v1 = acc[ai][0][m][1] * acc[ai][1][m][1];
                    v4u w; w.x = pg8::cvt_pk_bf16(v0[0], v0[1]); w.y = pg8::cvt_pk_bf16(v0[2], v0[3]); w.z = pg8::cvt_pk_bf16(v1[0], v1[1]); w.w = pg8::cvt_pk_bf16(v1[2], v1[3]);
                    *(v4u*)(PR + (size_t)EPI_ROW(u, ai, m) * NPR + col) = w; }
        } else {
            const int mode = pn < 4 ? 1 : (pn < 12 ? 0 : 2);
            const int col0 = (pn < 12 ? pn * 256 : PR_GATE + (pn - 20) * 256) + wc * 32 + 8 * fq;
#pragma unroll
            for (int ai = 0; ai < 2; ++ai)
#pragma unroll
                for (int m = 0; m < 4; ++m) { bf16* rowp = PR + (size_t)EPI_ROW(u, ai, m) * NPR + col0;
#pragma unroll
                    for (int bj = 0; bj < 2; ++bj) { f32x4 v0 = acc[ai][bj][m][0], v1 = acc[ai][bj][m][1];
                        if (mode == 1) {
#pragma unroll
                            for (int j = 0; j < 4; ++j) { v0[j] = gelu_tanh_(v0[j]); v1[j] = gelu_tanh_(v1[j]); } }
                        else if (mode == 2) {
#pragma unroll
                            for (int j = 0; j < 4; ++j) { v0[j] = sigmoidf_(v0[j]); v1[j] = sigmoidf_(v1[j]); } }
                        v4u w; w.x = pg8::cvt_pk_bf16(v0[0], v0[1]); w.y = pg8::cvt_pk_bf16(v0[2], v0[3]); w.z = pg8::cvt_pk_bf16(v1[0], v1[1]); w.w = pg8::cvt_pk_bf16(v1[2], v1[3]);
                        *(v4u*)(rowp + bj * 128) = w; } }
        }
    }
};
template <int VAR> struct EpiGate {
    static constexpr bool PERM = true, AFTER_DRAIN = false, CHAIN = false; __device__ __forceinline__ bool keep(const pg8::Unit&) const { return false; }
    const bf16* gates; float* M32; bf16* MB;
    __device__ __forceinline__ void operator()(const f32x4 (&acc)[2][2][4][2], const pg8::Unit& u, int wr, int wc, int fr, int fq) const {
        const int col0 = u.pn * 256 + wc * 32 + 8 * fq;
#pragma unroll
        for (int ai = 0; ai < 2; ++ai)
#pragma unroll
            for (int m = 0; m < 4; ++m) { const size_t row = (size_t)EPI_ROW(u, ai, m);
#pragma unroll
                for (int bj = 0; bj < 2; ++bj) { const int col = col0 + bj * 128;
                    const v4u g = *(const v4u*)(gates + row * NPR + col);
                    f32x4 v0 = acc[ai][bj][m][0], v1 = acc[ai][bj][m][1];
                    v0[0] *= bflo(g.x); v0[1] *= bfhi(g.x); v0[2] *= bflo(g.y); v0[3] *= bfhi(g.y); v1[0] *= bflo(g.z); v1[1] *= bfhi(g.z); v1[2] *= bflo(g.w); v1[3] *= bfhi(g.w);
                    float* mp = M32 + row * D + col;
                    if (VAR >= 1) { v0 += *(const f32x4*)mp; v1 += *(const f32x4*)(mp + 4); }
                    if (VAR <= 1) { *(f32x4*)mp = v0; *(f32x4*)(mp + 4) = v1; }
                    else { v4u w; w.x = pg8::cvt_pk_bf16(v0[0], v0[1]); w.y = pg8::cvt_pk_bf16(v0[2], v0[3]); w.z = pg8::cvt_pk_bf16(v1[0], v1[1]); w.w = pg8::cvt_pk_bf16(v1[2], v1[3]);
                        *(v4u*)(MB + row * D + col) = w; } } }
    }
};

struct EpiGate3 {
    static constexpr bool PERM = true, AFTER_DRAIN = false, CHAIN = true;
    const bf16* gates; bf16* MB; int mstride;
    __device__ __forceinline__ bool keep(const pg8::Unit& u) const { return (u.pn >> 2) < 2; }
    __device__ __forceinline__ void operator()(f32x4 (&acc)[2][2][4][2], const pg8::Unit& u0, int wr, int wc, int fr, int fq) const {
        const int i = u0.pn >> 2; pg8::Unit u; u.pm = u0.pm - i * mstride; u.pn = u0.pn & 3;
        const int col0 = u.pn * 256 + wc * 32 + 8 * fq; const bf16* gt = gates + i * 1024;
#pragma unroll
        for (int ai = 0; ai < 2; ++ai) {
            v4u G[4][2], Gn[4][2];
#pragma unroll
            for (int m = 0; m < 4; ++m) { const size_t row = (size_t)EPI_ROW(u, ai, m);
#pragma unroll
                for (int bj = 0; bj < 2; ++bj) { const bf16* gp = gt + row * NPR + col0 + bj * 128; G[m][bj] = *(const v4u*)gp;
                    Gn[m][bj] = *(const v4u*)(gp + (i < 2 ? 1024 : 0)); } }
#pragma unroll
            for (int m = 0; m < 4; ++m) { const size_t row = (size_t)EPI_ROW(u, ai, m);
#pragma unroll
                for (int bj = 0; bj < 2; ++bj) { const int col = col0 + bj * 128;
                    const v4u g = G[m][bj];
                    float s[8] = {bflo(g.x), bfhi(g.x), bflo(g.y), bfhi(g.y), bflo(g.z), bfhi(g.z), bflo(g.w), bfhi(g.w)};
                    if (i >= 1) {
#pragma unroll
                        for (int j = 0; j < 8; ++j) s[j] = fmaxf(s[j], 1e-18f); }
                    if (i < 2) { const v4u gn = Gn[m][bj];
                        const float d[8] = {bflo(gn.x), bfhi(gn.x), bflo(gn.y), bfhi(gn.y), bflo(gn.z), bfhi(gn.z), bflo(gn.w), bfhi(gn.w)};
#pragma unroll
                        for (int j = 0; j < 8; ++j) s[j] = s[j] * __builtin_amdgcn_rcpf(fmaxf(d[j], 1e-18f)); }
                    f32x4 v0 = acc[ai][bj][m][0], v1 = acc[ai][bj][m][1];
                    v0[0] *= s[0]; v0[1] *= s[1]; v0[2] *= s[2]; v0[3] *= s[3]; v1[0] *= s[4]; v1[1] *= s[5]; v1[2] *= s[6]; v1[3] *= s[7];
                    if (i < 2) { acc[ai][bj][m][0] = v0; acc[ai][bj][m][1] = v1; }
                    else { v4u w; w.x = pg8::cvt_pk_bf16(v0[0], v0[1]); w.y = pg8::cvt_pk_bf16(v0[2], v0[3]); w.z = pg8::cvt_pk_bf16(v1[0], v1[1]); w.w = pg8::cvt_pk_bf16(v1[2], v1[3]);
                        *(v4u*)(MB + row * D + col) = w; } } }
        }
    }
};
struct EpiResid {
    static constexpr bool PERM = false, AFTER_DRAIN = false, CHAIN = false; __device__ __forceinline__ bool keep(const pg8::Unit&) const { return false; }
    float* X; const float* modg;
    __device__ __forceinline__ void operator()(const f32x4 (&acc)[2][2][4][2], const pg8::Unit& u, int wr, int wc, int fr, int fq) const {
        const int r = u.pm < 64 ? (u.pm >> 3) : 8; const float* mg = modg + (size_t)r * 6144;
        const int col0 = u.pn * 256 + wc * 32 + 4 * fq;
        f32x4 gv[2][2];
#pragma unroll
        for (int bj = 0; bj < 2; ++bj)
#pragma unroll
            for (int n = 0; n < 2; ++n) gv[bj][n] = *(const f32x4*)(mg + col0 + bj * 128 + n * 16);
#pragma unroll
        for (int ai = 0; ai < 2; ++ai) {
            f32x4 xv[4][2][2];
#pragma unroll
            for (int m = 0; m < 4; ++m) { const float* rowp = X + (size_t)EPI_ROW(u, ai, m) * D + col0;
#pragma unroll
                for (int bj = 0; bj < 2; ++bj)
#pragma unroll
                    for (int n = 0; n < 2; ++n) xv[m][bj][n] = *(const f32x4*)(rowp + bj * 128 + n * 16); }
#pragma unroll
            for (int m = 0; m < 4; ++m) { float* rowp = X + (size_t)EPI_ROW(u, ai, m) * D + col0;
#pragma unroll
                for (int bj = 0; bj < 2; ++bj)
#pragma unroll
                    for (int n = 0; n < 2; ++n) *(f32x4*)(rowp + bj * 128 + n * 16) = xv[m][bj][n] + gv[bj][n] * acc[ai][bj][m][n]; }
        }
    }
};
struct EpiSwiglu {
    static constexpr bool PERM = true, AFTER_DRAIN = false, CHAIN = false; __device__ __forceinline__ bool keep(const pg8::Unit&) const { return false; }
    unsigned char* HID;
    __device__ __forceinline__ void operator()(const f32x4 (&acc)[2][2][4][2], const pg8::Unit& u, int wr, int wc, int fr, int fq) const {
        const int jn = u.pn % 22; const int col = jn * 128 + wc * 32 + 8 * fq;
#pragma unroll
        for (int ai = 0; ai < 2; ++ai)
#pragma unroll
            for (int m = 0; m < 4; ++m) { f32x4 v0, v1;
#pragma unroll
                for (int j = 0; j < 4; ++j) { v0[j] = silu_(acc[ai][0][m][0][j]) * acc[ai][1][m][0][j]; v1[j] = silu_(acc[ai][0][m][1][j]) * acc[ai][1][m][1][j]; }
                v2u w; w.x = pk4_fp8(v0[0], v0[1], v0[2], v0[3]); w.y = pk4_fp8(v1[0], v1[1], v1[2], v1[3]);
                *(v2u*)(HID + (size_t)EPI_ROW(u, ai, m) * DE + col) = w; }
    }
};
struct EpiYs {
    static constexpr bool PERM = true, AFTER_DRAIN = false, CHAIN = false; __device__ __forceinline__ bool keep(const pg8::Unit&) const { return false; }
    bf16* YS;
    __device__ __forceinline__ void operator()(const f32x4 (&acc)[2][2][4][2], const pg8::Unit& u, int wr, int wc, int fr, int fq) const {
        const int col0 = (u.pn & 3) * 256 + wc * 32 + 8 * fq;
#pragma unroll
        for (int ai = 0; ai < 2; ++ai)
#pragma unroll
            for (int m = 0; m < 4; ++m) { bf16* rowp = YS + (size_t)EPI_ROW(u, ai, m) * D + col0;
#pragma unroll
                for (int bj = 0; bj < 2; ++bj) { const f32x4 v0 = acc[ai][bj][m][0], v1 = acc[ai][bj][m][1];
                    v4u w; w.x = pg8::cvt_pk_bf16(v0[0], v0[1]); w.y = pg8::cvt_pk_bf16(v0[2], v0[3]); w.z = pg8::cvt_pk_bf16(v1[0], v1[1]); w.w = pg8::cvt_pk_bf16(v1[2], v1[3]);
                    *(v4u*)(rowp + bj * 128) = w; } }
    }
};
#define XB_TMO      128
#define XB_XCNT(j)  (256  + 64 * (j))
#define XB_XSUB(j)  (1280 + 64 * (j))
#define XB_XGEN(j)  (2304 + 64 * (j))
#define XB_TOP      3328
#define XB_TOPGEN   3392
#define XCD_BAR_WORDS 3456
#define XB_SPIN_CAP (1u << 18)

__device__ __forceinline__ unsigned xb_ld(unsigned* p)              { return __hip_atomic_load(p, __ATOMIC_RELAXED, __HIP_MEMORY_SCOPE_AGENT); }
__device__ __forceinline__ unsigned xb_add(unsigned* p, unsigned v) { return __hip_atomic_fetch_add(p, v, __ATOMIC_RELAXED, __HIP_MEMORY_SCOPE_AGENT); }
__device__ __forceinline__ unsigned xb_xcc_id() { return (unsigned)__builtin_amdgcn_s_getreg((3 << 11) | 20) & 0xFu; }
#define XB_SPIN(cond, bar) do { unsigned _sp = 0; while (cond) { __builtin_amdgcn_s_sleep(1); \
    if ((++_sp & 255u) == 0u) { if (xb_ld(&(bar)[XB_TMO])) break; if (_sp > XB_SPIN_CAP) { atomicAdd(&(bar)[XB_TMO], 1u); break; } } } } while (0)

struct XcdBarrier {
    unsigned* bar; unsigned x;
    volatile LAS unsigned* st;
};

__device__ __forceinline__ XcdBarrier xcd_barrier_post(unsigned* bar, volatile LAS unsigned* st) {
    XcdBarrier b; b.bar = bar; b.x = xb_xcc_id(); b.st = st;
    if (threadIdx.x == 0) (void)xb_add(&bar[XB_XCNT(b.x)], 1u);
    return b;
}
__device__ __forceinline__ void xcd_barrier_complete(unsigned* bar, unsigned x, unsigned& nloc, unsigned& nx) {
    const unsigned G = gridDim.x * gridDim.y * gridDim.z;
    unsigned sum, cnt, mine, sp = 0u;
    for (;;) {
        sum = 0u; cnt = 0u; mine = 0u;
#pragma unroll
        for (unsigned j = 0; j < 16; ++j) { const unsigned c = xb_ld(&bar[XB_XCNT(j)]); sum += c; cnt += (c > 0u) ? 1u : 0u; mine = (j == x) ? c : mine; }
        if (sum == G) break;
        __builtin_amdgcn_s_sleep(1);
        if ((++sp & 255u) == 0u) { if (xb_ld(&bar[XB_TMO])) break; if (sp > XB_SPIN_CAP) { atomicAdd(&bar[XB_TMO], 1u); break; } }
    }
    nloc = mine > 0u ? mine : 1u; nx = cnt > 0u ? cnt : 1u;
}

__device__ __forceinline__ void xcd_barrier(const XcdBarrier& b) {
    asm volatile("s_waitcnt vmcnt(0)" ::: "memory");
    __syncthreads();
    if (threadIdx.x == 0) {
        unsigned* bar = b.bar;
        __builtin_amdgcn_s_waitcnt(0);
        unsigned nloc = b.st[0], nx = b.st[1];
        if (nloc == 0u) { xcd_barrier_complete(bar, b.x, nloc, nx); b.st[0] = nloc; b.st[1] = nx; }
        const unsigned old = xb_add(&bar[XB_XSUB(b.x)], 1u);
        const unsigned gen = old / nloc;
        if (old + 1u == (gen + 1u) * nloc) {
            __builtin_amdgcn_fence(__ATOMIC_RELEASE, "agent");
            asm volatile("s_waitcnt vmcnt(0)" ::: "memory");
            const unsigned og = xb_add(&bar[XB_TOP], 1u);
            const unsigned tg = og / nx;
            if (og + 1u == (tg + 1u) * nx) xb_add(&bar[XB_TOPGEN], 1u);
            else XB_SPIN(xb_ld(&bar[XB_TOPGEN]) == tg, bar);
            __builtin_amdgcn_fence(__ATOMIC_ACQUIRE, "agent");
            xb_add(&bar[XB_XGEN(b.x)], 1u);
            asm volatile("s_waitcnt vmcnt(0)" ::: "memory");
        } else {
            XB_SPIN(xb_ld(&bar[XB_XGEN(b.x)]) == gen, bar);
            __builtin_amdgcn_fence(__ATOMIC_ACQUIRE, "agent");
            asm volatile("s_waitcnt vmcnt(0)" ::: "memory");
        }
    }
    __syncthreads();
}
constexpr size_t MiB = 1u << 20;
constexpr size_t al_(size_t x) { return (x + MiB - 1) / MiB * MiB; }
constexpr size_t WS_CTL = 0, CTL_ZERO_BYTES = 1 * MiB;
constexpr size_t WS_MOD  = 1 * MiB;
constexpr size_t WS_SP   = WS_MOD + 512 * 1024;
constexpr size_t WS_WIN  = WS_MOD + 1 * MiB;
constexpr size_t WS_WOUT = WS_WIN + al_(2ull * NIN * D * 2);
constexpr size_t WS_WLRU = WS_WOUT + al_(2ull * 4 * D * D * 2);
constexpr size_t WS_WGU  = WS_WLRU + 1 * MiB;
constexpr size_t WS_WD   = WS_WGU + al_(16ull * NGU * D * 2);
constexpr size_t WS_X    = WS_WD + al_(16ull * D * DE * 2);
constexpr size_t WS_FH2  = WS_X + al_((size_t)MTOT * D * 4);
constexpr size_t WS_KF   = WS_FH2 + 2 * MiB;
constexpr size_t WS_TFC  = WS_KF + al_(2ull * 2 * D * 4096 * 8);
constexpr size_t WS_H    = WS_TFC + al_(4ull * D * CTX * 4);
constexpr size_t WS_R    = WS_H + al_((size_t)MTOT * D * 2);
constexpr size_t WS_HYT  = WS_R;
constexpr size_t WS_PR   = WS_HYT + al_((size_t)NHY * MTOT * 2);
constexpr size_t WS_YAT  = WS_PR + al_((size_t)MTOT * NPR * 2);
constexpr size_t WS_YCAT = WS_YAT + al_((size_t)D * MTOT * 2);
constexpr size_t WS_REND = WS_YCAT + al_(3ull * MTOT * D * 2);
constexpr size_t WS_XS   = WS_R;
constexpr size_t WS_HID  = WS_XS + al_((size_t)NE * EROWS * D * 2);
constexpr size_t WS_YS   = WS_HID + al_((size_t)NE * EROWS * DE * 2);
static_assert(WS_YS + (size_t)NE * EROWS * D * 4 <= WS_REND, "MoE overlay fits");
constexpr size_t WS_M32  = WS_REND;
constexpr size_t WS_MB   = WS_M32 + al_((size_t)MTOT * D * 4);
constexpr size_t WS_AFF  = WS_MB + al_((size_t)MTOT * D * 2);
constexpr size_t WS_SELG = WS_AFF + 2 * MiB;
constexpr size_t WS_INV  = WS_SELG + 1 * MiB;
constexpr size_t WS_AGG  = WS_INV + 2 * MiB;
constexpr size_t WS_LAB  = WS_AGG + al_(2ull * NCHUNK * D * 2 * 4);
constexpr size_t WS_END  = WS_LAB + al_(4ull * MTOT * D * 2);
constexpr int CW_BAR = 4096;
constexpr int LDS_BYTES = 147456, MISC_OFF = 147456 - 256;
constexpr int NPHASE = 23;

struct Args { const float* in[35]; float* out; unsigned char* ws; int ph_lo, ph_hi, li, pad; };
struct Frame { LAS unsigned char* lds; int tid, lane, wave, vcu, G; };

__device__ __forceinline__ float wave_sum(float v) {
#pragma unroll
    for (int o = 1; o < 64; o <<= 1) v += __shfl_xor(v, o);
    return v;
}
__device__ __forceinline__ void tr_item(const float* src, size_t ld, bf16* dst, size_t K, LAS float* scr, int lane) {
    f32x4 v[16];
#pragma unroll
    for (int i = 0; i < 16; ++i) v[i] = *(const f32x4*)(src + (size_t)((lane >> 4) + 4 * i) * ld + (lane & 15) * 4);
#pragma unroll
    for (int i = 0; i < 16; ++i) { LAS float* p = scr + ((lane >> 4) + 4 * i) * 65 + (lane & 15) * 4; p[0] = v[i][0]; p[1] = v[i][1]; p[2] = v[i][2]; p[3] = v[i][3]; }
    LDS_WAIT(); asm volatile("" ::: "memory");
    const int c = lane & 7;
#pragma unroll
    for (int j = 0; j < 8; ++j) { const int n = (lane >> 3) + 8 * j; const LAS float* s = scr + (8 * c) * 65 + n;
        v4u o; o.x = pk2(s[0 * 65], s[1 * 65]); o.y = pk2(s[2 * 65], s[3 * 65]); o.z = pk2(s[4 * 65], s[5 * 65]); o.w = pk2(s[6 * 65], s[7 * 65]);
        *(v4u*)(dst + (size_t)n * K + 8 * c) = o; }
    LDS_WAIT(); asm volatile("" ::: "memory");
}
__device__ __forceinline__ int win_src_col(int n0) {
    if (n0 < 3072) return n0;
    const int m = n0 - 3072;
    if (m < 1024) return 3072 + m;
    if (m < 2048) return 4096 + (m - 1024);
    if (m < 3072) return 5120 + (m - 2048);
    if (m < 5120) { const int q = m - 3072, j = q >> 8, r = q & 255; return r < 128 ? 6144 + 128 * j + r : 7168 + 128 * j + (r - 128); }
    return 8192 + (m - 5120);
}

__device__ __forceinline__ void ph_prologue(const Args& a, const Frame& F) {
    const int gw = F.vcu * 8 + F.wave, NGW = F.G * 8, lane = F.lane;
    float* X = (float*)(a.ws + WS_X);
    for (int t = gw; t < SEQ; t += NGW) {
        const int gr = t >> 6, gc = t & 63; f32x4 pe[4];
#pragma unroll
        for (int j = 0; j < 4; ++j)
#pragma unroll
            for (int i = 0; i < 4; ++i) { const int cc = 4 * lane + 256 * j + i; const float pos = (float)(cc < 512 ? gr : gc); const int c2 = cc & 511, idx = c2 & 255;
                const float om = exp2f((float)idx * (-13.287712379549449f / 256.0f)); const float ang = pos * om; pe[j][i] = c2 < 256 ? sinf(ang) : cosf(ang); }
        for (int b = 0; b < NB; ++b) { const size_t row = (size_t)b * SEQ + t; const f32x4* xr = (const f32x4*)(a.in[0] + row * D) + lane; f32x4* xo = (f32x4*)(X + row * D) + lane;
#pragma unroll
            for (int j = 0; j < 4; ++j) xo[64 * j] = xr[64 * j] + pe[j]; }
    }
    for (int r = gw; r < MCTX; r += NGW) { const f32x4* xr = (const f32x4*)(a.in[2] + (size_t)r * D) + lane; f32x4* xo = (f32x4*)(X + (size_t)(MLAT + r) * D) + lane;
#pragma unroll
        for (int j = 0; j < 4; ++j) xo[64 * j] = xr[64 * j]; }
    {
        LAS float* S = (LAS float*)F.lds;
        LAS float* red = S + 9 * 1024;
        for (int i = F.tid; i < 9 * 1024; i += 512) { const float v = i < 8192 ? a.in[1][i] : a.in[3][i - 8192]; S[i] = v / (1.0f + expf(-v)); }
        __syncthreads();
        float* MOD = (float*)(a.ws + WS_MOD);
        for (int it = F.vcu; it < 2 * 96; it += F.G) {
            const int l = it / 96, cb = it % 96, cj = F.tid & 63, ks = F.tid >> 6;
            const float* w = a.in[4] + (size_t)l * D * 6144 + cb * 64 + cj; float acc[9];
#pragma unroll
            for (int r = 0; r < 9; ++r) acc[r] = 0.f;
            for (int k0 = ks * 128; k0 < ks * 128 + 128; k0 += 32) { float wv[32];
#pragma unroll
                for (int kk = 0; kk < 32; ++kk) wv[kk] = w[(size_t)(k0 + kk) * 6144];
#pragma unroll
                for (int kk = 0; kk < 32; ++kk)
#pragma unroll
                    for (int r = 0; r < 9; ++r) acc[r] += S[r * 1024 + k0 + kk] * wv[kk]; }
#pragma unroll
            for (int r = 0; r < 9; ++r) red[(ks * 9 + r) * 64 + cj] = acc[r];
            __syncthreads();
            for (int o = F.tid; o < 9 * 64; o += 512) { const int r = o >> 6, c2 = o & 63; float s = a.in[5][(size_t)l * 6144 + cb * 64 + c2];
#pragma unroll
                for (int k2 = 0; k2 < 8; ++k2) s += red[(k2 * 9 + r) * 64 + c2];
                MOD[((size_t)l * 9 + r) * 6144 + cb * 64 + c2] = s; }
            __syncthreads();
        }
    }
    {
        LAS float* scr = (LAS float*)(F.lds + F.wave * 16640);
        bf16* WIN = (bf16*)(a.ws + WS_WIN); bf16* WOUT = (bf16*)(a.ws + WS_WOUT);
        constexpr int I_IN = 16 * (NIN / 64), I_OUT = 16 * 16;
        constexpr int NIT = 2 * I_IN + 8 * I_OUT;
        for (int it = gw; it < NIT; it += NGW) {
            if (it < 2 * I_IN) { const int l = it / I_IN, r = it % I_IN, kb = r / (NIN / 64), nb = r % (NIN / 64);
                tr_item(a.in[8] + (size_t)l * D * NIN + (size_t)(64 * kb) * NIN + win_src_col(64 * nb), NIN, WIN + (size_t)l * NIN * D + (size_t)(64 * nb) * D + 64 * kb, D, scr, lane); }
            else { const int r0 = it - 2 * I_IN, mi = r0 / I_OUT, r = r0 % I_OUT, l = mi >> 2, w = mi & 3, kb = r / 16, nb = r % 16;
                tr_item(a.in[26 + w] + (size_t)l * D * D + (size_t)(64 * kb) * D + 64 * nb, D, WOUT + ((size_t)l * 4 + w) * D * D + (size_t)(64 * nb) * D + 64 * kb, D, scr, lane); }
        }
    }
    {
      bf16* WL = (bf16*)(a.ws + WS_WLRU); float* SP = (float*)(a.ws + WS_SP);
      const int gt = F.vcu * 512 + F.tid, NT = F.G * 512;
      for (int i = gt; i < 2 * 16 * 256 * 64; i += NT) { const int k = i & 63, n = (i >> 6) & 255, hd = (i >> 14) & 15, l = i >> 18; const int dir = n >> 7, ax = (n >> 6) & 1, j = n & 63;
          WL[i] = (bf16)f2bf((ax ? a.in[22] : a.in[20])[((((size_t)l * 2 + dir) * 16 + hd) * 64 + k) * 64 + j]); }
      for (int i = gt; i < 4 * D; i += NT) { const float lam = a.in[24][i]; SP[i] = log1pf(expf(-lam)); } }
    __syncthreads();
    {
        LAS float* feats = (LAS float*)F.lds;
        LAS float* h1 = feats + 8 * 36;
        float* FH2 = (float*)(a.ws + WS_FH2);
        for (int it = F.vcu; it < 2 * 288; it += F.G) {
            const int l = it / 288, tb = it % 288, tl = F.tid >> 6, j = F.tid & 63;
            const int tt = tb * 8 + tl; const int L = tt < SEQ ? SEQ : CTX, t = tt < SEQ ? tt : tt - SEQ;
            if (j < 33) { const float wv = (6.283185307179586f / (float)L) * (float)t; float v;
                if (j == 0) v = (float)t / (float)(L - 1);
                else { const int bi = (j - 1) & 15; const float f = 1e-4f + (float)bi * ((15.0f - 1e-4f) / 15.0f); v = j <= 16 ? cosf(f * wv) : -sinf(f * wv); }
                feats[tl * 36 + j] = v; }
            __syncthreads();
            { const float* w1 = a.in[11] + (size_t)l * 33 * 64; float s = a.in[12][l * 64 + j];
              for (int m = 0; m < 33; ++m) s += feats[tl * 36 + m] * w1[m * 64 + j];
              h1[tl * 64 + j] = sinf(a.in[16][l * 64 + j] * s); }
            __syncthreads();
            { const float* w2 = a.in[13] + (size_t)l * 64 * 64; float s = a.in[14][l * 64 + j];
              for (int m = 0; m < 64; ++m) s += h1[tl * 64 + m] * w2[m * 64 + j];
              FH2[((size_t)l * 64 + j) * 2304 + tt] = sinf(a.in[16][l * 64 + j] * s); }
            __syncthreads();
        }
    }
}


#define FFT_HD __device__ __forceinline__
typedef float c2 __attribute__((ext_vector_type(2)));
FFT_HD c2 c2swap(c2 a) { return __builtin_shufflevector(a, a, 1, 0); }
FFT_HD c2 c2mul(c2 a, c2 b) {
    c2 t, d;
    asm("v_pk_mul_f32 %0, %1, %2 op_sel:[0,0] op_sel_hi:[1,0]" : "=&v"(t) : "v"(a), "v"(b));
    asm("v_pk_fma_f32 %0, %1, %2, %3 op_sel:[1,1,0] op_sel_hi:[0,1,1] neg_lo:[0,1,0]" : "=&v"(d) : "v"(a), "v"(b), "v"(t));
    return d;
}
FFT_HD c2 c2mulconj(c2 a, c2 b) {
    c2 t, d;
    asm("v_pk_mul_f32 %0, %1, %2 op_sel:[0,0] op_sel_hi:[1,0] neg_hi:[0,1]" : "=&v"(t) : "v"(a), "v"(b));
    asm("v_pk_fma_f32 %0, %1, %2, %3 op_sel:[1,1,0] op_sel_hi:[0,1,1] neg_lo:[0,1,0] neg_hi:[0,1,0]" : "=&v"(d) : "v"(a), "v"(b), "v"(t));
    return d;
}
FFT_HD c2 c2mulk(c2 a, float br, float bi) { return c2mul(a, (c2){br, bi}); }
FFT_HD c2 c2add_mi(c2 s, c2 t) { c2 d; asm("v_pk_add_f32 %0, %1, %2 op_sel:[0,1] op_sel_hi:[1,0] neg_hi:[0,1]" : "=&v"(d) : "v"(s), "v"(t)); return d; }
FFT_HD c2 c2sub_mi(c2 s, c2 t) { c2 d; asm("v_pk_add_f32 %0, %1, %2 op_sel:[0,1] op_sel_hi:[1,0] neg_lo:[0,1]" : "=&v"(d) : "v"(s), "v"(t)); return d; }
FFT_HD void dft4v(c2& a, c2& b, c2& c, c2& d) {
    const c2 s0 = a + c, s1 = a - c, s2 = b + d, t = b - d;
    a = s0 + s2; c = s0 - s2; b = c2add_mi(s1, t); d = c2sub_mi(s1, t);
}
FFT_HD void dft4v_z(c2& a, c2& b, c2& c, c2& d) {
    const c2 a0 = a, b0 = b; a = a0 + b0; c = a0 - b0; b = c2add_mi(a0, b0); d = c2sub_mi(a0, b0);
}
FFT_HD void dft4v_cr(c2& a, c2& b, c2& c, c2& d) {
    const c2 s0 = c2add_mi(a, c), s1 = c2sub_mi(a, c), s2 = b + d, t = b - d;
    a = s0 + s2; c = s0 - s2; b = c2add_mi(s1, t); d = c2sub_mi(s1, t);
}
#define PERM16(k) ((((k) >> 2) & 3) + 4 * ((k) & 3))
template <bool ZH> FFT_HD void dft16v(c2 (&v)[16]) {
    const float C1 = 0.92387953251128674f, S1 = 0.38268343236508978f, R2 = 0.70710678118654752f;
#pragma unroll
    for (int na = 0; na < 4; ++na) { if (ZH) dft4v_z(v[na], v[na + 4], v[na + 8], v[na + 12]); else dft4v(v[na], v[na + 4], v[na + 8], v[na + 12]); }
    v[5] = c2mulk(v[5], C1, -S1); v[6] = c2mulk(v[6], R2, -R2); v[7] = c2mulk(v[7], S1, -C1);
    v[9] = c2mulk(v[9], R2, -R2);   v[11] = c2mulk(v[11], -R2, -R2);
    v[13] = c2mulk(v[13], S1, -C1); v[14] = c2mulk(v[14], -R2, -R2); v[15] = c2mulk(v[15], -C1, S1);
    dft4v(v[0], v[1], v[2], v[3]); dft4v(v[4], v[5], v[6], v[7]); dft4v_cr(v[8], v[9], v[10], v[11]); dft4v(v[12], v[13], v[14], v[15]);
}

typedef c2 cf2;
__device__ __forceinline__ void fft_twiddles(int tid, LAS cf2* T, c2 (&tw2)[16]) {
    const int tt = tid & 255, n0 = tt & 15, k2 = tt >> 4;
    LAS cf2* scr = T + 256 + tid * 17;
    if (tid < 256) { float s, c; const int m1 = (16 * (tid >> 4) * (tid & 15)) & 4095; sincosf(-6.283185307179586f * (float)m1 * (1.0f / 4096.0f), &s, &c); T[tid] = (cf2){c, s}; }
#pragma unroll 1
    for (int k = 0; k < 16; ++k) { float s, c; const int m2 = (n0 * (k2 + 16 * k)) & 4095; sincosf(-6.283185307179586f * (float)m2 * (1.0f / 4096.0f), &s, &c); scr[k] = (cf2){c, s}; }
    LDS_WAIT(); asm volatile("" ::: "memory");
#pragma unroll
    for (int k = 0; k < 16; ++k) tw2[k] = scr[k];
    __syncthreads();
}
template <bool TABLE2, bool ZH = false> __device__ __forceinline__ void fft4096(c2 (&v)[16], LAS cf2* buf, int tt, const LAS cf2* T, const c2 (&tw2)[16]) {
    dft16v<ZH>(v);
    { const LAS cf2* T1 = T + (tt >> 4) * 16;
#pragma unroll
      for (int k = 0; k < 16; ++k) { c2 a = v[PERM16(k)]; if (k) a = c2mul(a, T1[k]); buf[tt + 272 * k] = a; } }
    __syncthreads();
    const int n0 = tt & 15, k2 = tt >> 4;
#pragma unroll
    for (int n1 = 0; n1 < 16; ++n1) v[n1] = buf[n0 + 16 * n1 + 272 * k2];
    __syncthreads();
    dft16v<false>(v);
    { const LAS cf2* T2 = T + n0 * 16;
#pragma unroll
      for (int k1 = 0; k1 < 16; ++k1) { c2 w = tw2[TABLE2 ? 0 : k1]; if (TABLE2 && k1) w = c2mul(w, T2[k1]); buf[k2 + 16 * k1 + 257 * n0] = c2mul(v[PERM16(k1)], w); } }
    __syncthreads();
#pragma unroll
    for (int m = 0; m < 16; ++m) v[m] = buf[tt + 257 * m];
    __syncthreads();
    dft16v<false>(v);
    { c2 w[16];
#pragma unroll
      for (int k = 0; k < 16; ++k) w[k] = v[PERM16(k)];
#pragma unroll
      for (int k = 0; k < 16; ++k) v[k] = w[k]; }
}

template <int NP> __device__ __forceinline__ void filt_taps4(const float* FH2T, const LAS float* w3s, int p0, float (&d)[NP][4][4]) {
#pragma unroll
    for (int g = 0; g < NP; ++g)
#pragma unroll
        for (int i = 0; i < 4; ++i)
#pragma unroll
            for (int od = 0; od < 4; ++od) d[g][i][od] = 0.f;
#pragma unroll 4
    for (int j = 0; j < 64; ++j) { const f32x4 w = *(const LAS f32x4*)(w3s + j * 4);
#pragma unroll
        for (int g = 0; g < NP; ++g) { const f32x4 h = *(const f32x4*)(FH2T + (size_t)j * 2304 + p0 + 1024 * g);
#pragma unroll
            for (int i = 0; i < 4; ++i)
#pragma unroll
                for (int od = 0; od < 4; ++od) d[g][i][od] += h[i] * w[od]; } }
}
__device__ __forceinline__ void ph_filters(const Args& a, const Frame& F) {
    const int team = F.tid >> 8, tt = F.tid & 255, tw = (F.tid >> 6) & 3;
    LAS cf2* fbuf = (LAS cf2*)F.lds;
    LAS cf2* TW = fbuf + 2 * 4352;
    LAS cf2* zt = TW + 256 + team * 4096;
    LAS float* w3s = (LAS float*)(TW + 256 + 2 * 4096) + team * 256;
    LAS float* red = (LAS float*)(TW + 256 + 2 * 4096) + 512 + team * 16;
    LAS float* cx = (LAS float*)(fbuf + team * 4352);
    c2 tw2[16]; fft_twiddles(F.tid, TW, tw2);
    for (int it = F.vcu; it < 2 * (D / 2); it += F.G) {
        const int l = it / (D / 2), c = 2 * (it % (D / 2)) + team;
        const float* FH2 = (const float*)(a.ws + WS_FH2) + (size_t)l * 64 * 2304;
        __syncthreads();
        { const int od = tt >> 6, j = tt & 63; w3s[j * 4 + od] = a.in[15][((size_t)l * 64 + j) * 4096 + od * 1024 + c]; }
        __syncthreads();
        const float ad = fabsf(-3.0701134573f + (float)c * ((-15.3505672866f + 3.0701134573f) / 1023.0f));
        float s0 = 0.f, s1 = 0.f, c0 = 0.f, c1 = 0.f;
        { float d[2][4][4]; filt_taps4<2>(FH2, w3s, 4 * tt, d);
#pragma unroll
          for (int g = 0; g < 2; ++g)
#pragma unroll
              for (int i = 0; i < 4; ++i) { const int t = 4 * tt + i + 1024 * g; const float win = __expf(-((float)t / (float)(SEQ - 1)) * ad);
                  const float k0 = d[g][i][0] * win, k1 = d[g][i][1] * win, k2 = d[g][i][2] * win, k3 = d[g][i][3] * win;
                  s0 += fabsf(k0) + (t > 0 ? fabsf(k1) : 0.f); s1 += fabsf(k2) + (t > 0 ? fabsf(k3) : 0.f);
                  zt[t] = (cf2){k0, k2}; if (t > 0) zt[4096 - t] = (cf2){k1, k3}; } }
        if (tt == 0) zt[2048] = (cf2){0.f, 0.f};
        if (l == 0 && tt < 64) { float d[1][4][4]; filt_taps4<1>(FH2 + SEQ, w3s, 4 * tt, d);
#pragma unroll
            for (int i = 0; i < 4; ++i) { const int t = 4 * tt + i; const float win = __expf(-((float)t / (float)(CTX - 1)) * ad);
                const float k0 = d[0][i][0] * win, k1 = d[0][i][1] * win, k2 = d[0][i][2] * win, k3 = d[0][i][3] * win;
                cx[t] = k0; cx[256 + t] = k1; cx[512 + t] = k2; cx[768 + t] = k3;
                c0 += fabsf(k0) + (t > 0 ? fabsf(k1) : 0.f); c1 += fabsf(k2) + (t > 0 ? fabsf(k3) : 0.f); } }
        s0 = wave_sum(s0); s1 = wave_sum(s1); c0 = wave_sum(c0); c1 = wave_sum(c1);
        if (F.lane == 0) { red[tw * 4] = s0; red[tw * 4 + 1] = s1; red[tw * 4 + 2] = c0; red[tw * 4 + 3] = c1; }
        __syncthreads();
        const float i0 = 1.0f / ((red[0] + red[4]) + (red[8] + red[12])), i1 = 1.0f / ((red[1] + red[5]) + (red[9] + red[13]));
        if (l == 0) { const float j0 = 1.0f / ((red[2] + red[6]) + (red[10] + red[14])), j1 = 1.0f / ((red[3] + red[7]) + (red[11] + red[15]));
            float* TF = (float*)(a.ws + WS_TFC);
#pragma unroll
            for (int od = 0; od < 4; ++od) TF[((size_t)od * D + c) * CTX + tt] = cx[od * 256 + tt] * (od < 2 ? j0 : j1); }
        c2 v[16];
#pragma unroll
        for (int j = 0; j < 16; ++j) { const cf2 r = zt[tt + 256 * j]; v[j] = (c2){r.x * i0, r.y * i1}; }
        __syncthreads();
        fft4096<true>(v, fbuf + team * 4352, tt, TW, tw2);
#pragma unroll
        for (int j = 0; j < 16; ++j) zt[tt + 256 * j] = v[j];
        __syncthreads();
        { cf2* K0 = (cf2*)(a.ws + WS_KF) + (((size_t)l * 2 + 0) * D + c) * 4096; cf2* K1 = (cf2*)(a.ws + WS_KF) + (((size_t)l * 2 + 1) * D + c) * 4096;
          const float sc = 0.5f / 4096.0f;
#pragma unroll
          for (int j = 0; j < 16; ++j) { const int f = tt + 256 * j; const cf2 zb = zt[(4096 - f) & 4095]; const float ar = v[j].x, ai = v[j].y, br = zb.x, bi = zb.y;
              K0[f] = (cf2){(ar + br) * sc, (ai - bi) * sc}; K1[f] = (cf2){(ai + bi) * sc, -(ar - br) * sc}; } }
    }
}

constexpr int NITW = NE * ((D / 128) * (NGU / 32) + (DE / 128) * (D / 32));
__device__ __forceinline__ void wx_load(const Args& a, int l, int it, int lane, f32x4 (&v)[16], unsigned char*& dst, size_t& K) {
    constexpr int I_GU = (D / 128) * (NGU / 32), I_D = (DE / 128) * (D / 32);
    unsigned char* WGU = a.ws + WS_WGU + (size_t)l * NE * NGU * D; unsigned char* WD = a.ws + WS_WD + (size_t)l * NE * D * DE;
    const float* src; size_t ld;
    if (it < NE * I_GU) { const int e = it / I_GU, r = it % I_GU, kb = r / (NGU / 32), nb = r % (NGU / 32); const int n0 = 32 * nb, jt = n0 >> 8, rr = n0 & 255;
        src = (rr < 128 ? a.in[31] : a.in[32]) + ((size_t)l * NE + e) * D * DE + (size_t)(128 * kb) * DE + 128 * jt + (rr & 127); ld = DE;
        dst = WGU + (size_t)e * NGU * D + (size_t)n0 * D + 128 * kb; K = D; }
    else { const int r0 = it - NE * I_GU, e = r0 / I_D, r = r0 % I_D, kb = r / (D / 32), nb = r % (D / 32);
        src = a.in[33] + ((size_t)l * NE + e) * DE * D + (size_t)(128 * kb) * D + 32 * nb; ld = D;
        dst = WD + (size_t)e * D * DE + (size_t)(32 * nb) * DE + 128 * kb; K = DE; }
    const float* p = src + (size_t)(16 * (lane >> 3)) * ld + (lane & 7) * 4;
#pragma unroll
    for (int i = 0; i < 16; ++i) v[i] = *(const f32x4*)(p + (size_t)i * ld);
}
__device__ __forceinline__ void wx_store(const f32x4 (&v)[16], unsigned char* dst, size_t K, int lane) {
    unsigned char* q = dst + (size_t)(4 * (lane & 7)) * K + 16 * (lane >> 3);
#pragma unroll
    for (int j = 0; j < 4; ++j) { v4u o;
        o.x = pk4_fp8(v[0][j] * 32.f, v[1][j] * 32.f, v[2][j] * 32.f, v[3][j] * 32.f); o.y = pk4_fp8(v[4][j] * 32.f, v[5][j] * 32.f, v[6][j] * 32.f, v[7][j] * 32.f);
        o.z = pk4_fp8(v[8][j] * 32.f, v[9][j] * 32.f, v[10][j] * 32.f, v[11][j] * 32.f); o.w = pk4_fp8(v[12][j] * 32.f, v[13][j] * 32.f, v[14][j] * 32.f, v[15][j] * 32.f);
        *(v4u*)(q + (size_t)j * K) = o; }
}

template <int MODE, bool COMB> __device__ __forceinline__ void ph_norm(const Args& a, const Frame& F, int l) {
    const int gw = F.vcu * 8 + F.wave, NGW = F.G * 8, lane = F.lane;
    float* X = (float*)(a.ws + WS_X); bf16* H = (bf16*)(a.ws + WS_H);
    const float* MOD = (const float*)(a.ws + WS_MOD);
    LAS float* WRt = (LAS float*)F.lds;
    if (MODE == 1) { const float* wr = a.in[30] + (size_t)l * D * NE; for (int i = F.tid; i < D * NE; i += 512) WRt[(i & 15) * 1024 + (i >> 4)] = wr[i]; __syncthreads(); }
    const float* g = MODE == 0 ? a.in[6] + l * D : (MODE == 1 ? a.in[7] + l * D : a.in[34]);
    const int nrows = MODE == 2 ? MLAT : MTOT;
    for (int rowA = gw; rowA < nrows; rowA += 2 * NGW) {
        const int nr = rowA + NGW < nrows ? 2 : 1;
        f32x4 v[2][4]; int myinv[2] = {-1, -1};
#pragma unroll
        for (int h = 0; h < 2; ++h) if (h < nr) { const int row = rowA + h * NGW; const f32x4* xr = (const f32x4*)(X + (size_t)row * D) + lane;
#pragma unroll
            for (int j = 0; j < 4; ++j) v[h][j] = xr[64 * j];
            if (COMB) myinv[h] = ((const int*)(a.ws + WS_INV))[(size_t)row * NE + (lane & 15)]; }
        if (COMB) {
            const int lp = MODE == 2 ? 1 : l - 1;
            const float* SELG = (const float*)(a.ws + WS_SELG); const bf16* YS = (const bf16*)(a.ws + WS_YS);
#pragma unroll
            for (int h = 0; h < 2; ++h) if (h < nr) { const int row = rowA + h * NGW, r = row < MLAT ? (row >> 11) : 8;
                unsigned m = (unsigned)(__ballot(myinv[h] >= 0) & 0xFFFFull);
                f32x4 acc[4];
#pragma unroll
                for (int j = 0; j < 4; ++j) acc[j] = (f32x4){0.f, 0.f, 0.f, 0.f};
                while (m) {
                    int ee[4], ss[4]; float gt[4]; v2u y[4][4];
#pragma unroll
                    for (int k = 0; k < 4; ++k) { ee[k] = m ? __builtin_ctz(m) : -1; if (m) m &= m - 1; ss[k] = ee[k] >= 0 ? __shfl(myinv[h], ee[k] < 0 ? 0 : ee[k]) : 0; }
#pragma unroll
                    for (int k = 0; k < 4; ++k) { const int e = ee[k] < 0 ? 0 : ee[k]; gt[k] = ee[k] >= 0 ? SELG[e * EROWS + ss[k]] : 0.f; const v2u* yr = (const v2u*)(YS + ((size_t)e * EROWS + ss[k]) * D) + lane;
#pragma unroll
                        for (int j = 0; j < 4; ++j) y[k][j] = yr[64 * j]; }
#pragma unroll
                    for (int k = 0; k < 4; ++k)
#pragma unroll
                        for (int j = 0; j < 4; ++j) acc[j] += gt[k] * (f32x4){bflo(y[k][j].x), bfhi(y[k][j].x), bflo(y[k][j].y), bfhi(y[k][j].y)};
                }
                const f32x4* m5 = (const f32x4*)(MOD + ((size_t)lp * 9 + r) * 6144 + 5 * 1024) + lane;
#pragma unroll
                for (int j = 0; j < 4; ++j) v[h][j] += m5[64 * j] * acc[j];
                if (MODE != 2) { f32x4* xw = (f32x4*)(X + (size_t)row * D) + lane;
#pragma unroll
                    for (int j = 0; j < 4; ++j) xw[64 * j] = v[h][j]; } }
        }
#pragma unroll
        for (int h = 0; h < 2; ++h) if (h < nr) { const int row = rowA + h * NGW, r = row < MLAT ? (row >> 11) : 8;
            float ss = 0.f;
#pragma unroll
            for (int j = 0; j < 4; ++j) ss += (v[h][j][0] * v[h][j][0] + v[h][j][1] * v[h][j][1]) + (v[h][j][2] * v[h][j][2] + v[h][j][3] * v[h][j][3]);
            const float rstd = 1.0f / sqrtf(wave_sum(ss) * (1.0f / D) + 1e-6f);
            const f32x4* gp = (const f32x4*)g + lane;
            if (MODE == 2) { f32x4* o = (f32x4*)(a.out + (size_t)row * D) + lane;
#pragma unroll
                for (int j = 0; j < 4; ++j) o[64 * j] = v[h][j] * rstd * gp[64 * j];
            } else {
                const float* mrow = MOD + ((size_t)l * 9 + r) * 6144 + (MODE == 0 ? 0 : 3 * 1024);
                const f32x4* sh = (const f32x4*)mrow + lane; const f32x4* sc = (const f32x4*)(mrow + 1024) + lane;
                v2u* o8 = (v2u*)(H + (size_t)row * D) + lane;
#pragma unroll
                for (int j = 0; j < 4; ++j) { v[h][j] = (v[h][j] * rstd * gp[64 * j]) * (1.0f + sc[64 * j]) + sh[64 * j]; v2u w; w.x = pk2(v[h][j][0], v[h][j][1]); w.y = pk2(v[h][j][2], v[h][j][3]); o8[64 * j] = w; }
                if (MODE == 1) {
                    float p[16];
#pragma unroll
                    for (int e = 0; e < NE; ++e) { float s = 0.f;
#pragma unroll
                        for (int j = 0; j < 4; ++j) { const f32x4 w = *(const LAS f32x4*)(WRt + e * 1024 + 4 * lane + 256 * j); s += (v[h][j][0] * w[0] + v[h][j][1] * w[1]) + (v[h][j][2] * w[2] + v[h][j][3] * w[3]); }
                        p[e] = s; if (e & 1) asm volatile("" ::: "memory"); }
#pragma unroll
                    for (int i = 0; i < 8; ++i) { const bool up = lane & 32; const float keep = up ? p[i + 8] : p[i], send = up ? p[i] : p[i + 8]; p[i] = keep + __shfl_xor(send, 32); }
#pragma unroll
                    for (int i = 0; i < 4; ++i) { const bool up = lane & 16; const float keep = up ? p[i + 4] : p[i], send = up ? p[i] : p[i + 4]; p[i] = keep + __shfl_xor(send, 16); }
#pragma unroll
                    for (int i = 0; i < 2; ++i) { const bool up = lane & 8; const float keep = up ? p[i + 2] : p[i], send = up ? p[i] : p[i + 2]; p[i] = keep + __shfl_xor(send, 8); }
                    { const bool up = lane & 4; const float keep = up ? p[1] : p[0], send = up ? p[0] : p[1]; p[0] = keep + __shfl_xor(send, 4); }
                    float mine = p[0]; mine += __shfl_xor(mine, 1); mine += __shfl_xor(mine, 2);
                    float mx = mine;
#pragma unroll
                    for (int o = 4; o < 64; o <<= 1) mx = fmaxf(mx, __shfl_xor(mx, o));
                    const float pe = expf(mine - mx); float den = pe;
#pragma unroll
                    for (int o = 4; o < 64; o <<= 1) den += __shfl_xor(den, o);
                    if ((lane & 3) == 0) ((float*)(a.ws + WS_AFF))[(size_t)row * NE + (lane >> 2)] = pe / den;
                }
            }
        }
    }
}

__device__ __forceinline__ void ph_rank(const Args& a, const Frame& F, int l) {
    LAS unsigned* part = (LAS unsigned*)F.lds;
    const float* AFF = (const float*)(a.ws + WS_AFF); float* SELG = (float*)(a.ws + WS_SELG); int* INV = (int*)(a.ws + WS_INV);
    const bf16* H = (const bf16*)(a.ws + WS_H); unsigned char* XS = a.ws + WS_XS;
    const int tid = F.tid, lane = F.lane, wave = F.wave;
    const unsigned long long ltmask = (1ull << lane) - 1ull;
    const int nitems = 128 + (l == 0 ? 128 : 0);
    for (int it = F.vcu; it < nitems; it += F.G) {
        const bool isctx = it >= 128; const int r = it & 127, e = r & 15, b = r >> 4;
        const int n = isctx ? CTX : SEQ, cap = isctx ? 32 : 256, row0 = isctx ? MLAT + b * CTX : b * SEQ, slot0 = isctx ? 2048 + b * 32 : b * 256;
        unsigned k[4];
#pragma unroll
        for (int q = 0; q < 4; ++q) { const int j = 4 * tid + q; k[q] = j < n ? __builtin_bit_cast(unsigned, AFF[(size_t)(row0 + j) * NE + e]) : 0u; }
        __syncthreads();
        unsigned prefix = 0u;
#pragma unroll 1
        for (int bit = 28; bit >= 0; bit -= 2) {
            const unsigned c1 = prefix | (1u << bit), c2 = prefix | (2u << bit), c3 = prefix | (3u << bit);
            unsigned n1 = 0, n2 = 0, n3 = 0;
#pragma unroll
            for (int q = 0; q < 4; ++q) { n1 += __popcll(__ballot(k[q] >= c1)); n2 += __popcll(__ballot(k[q] >= c2)); n3 += __popcll(__ballot(k[q] >= c3)); }
            LAS unsigned* pb = part + ((bit >> 1) & 1) * 24;
            if (lane == 0) { pb[wave] = n1; pb[8 + wave] = n2; pb[16 + wave] = n3; }
            __syncthreads();
            const v4u a0 = *(const LAS v4u*)pb, a1 = *(const LAS v4u*)(pb + 4), b0 = *(const LAS v4u*)(pb + 8), b1 = *(const LAS v4u*)(pb + 12), d0 = *(const LAS v4u*)(pb + 16), d1 = *(const LAS v4u*)(pb + 20);
            const unsigned t1 = ((a0.x + a0.y) + (a0.z + a0.w)) + ((a1.x + a1.y) + (a1.z + a1.w)), t2 = ((b0.x + b0.y) + (b0.z + b0.w)) + ((b1.x + b1.y) + (b1.z + b1.w)),
                           t3 = ((d0.x + d0.y) + (d0.z + d0.w)) + ((d1.x + d1.y) + (d1.z + d1.w));
            if ((int)t3 >= cap) prefix = c3; else if ((int)t2 >= cap) prefix = c2; else if ((int)t1 >= cap) prefix = c1;
        }
        const unsigned T = prefix;
        __syncthreads();
        { const unsigned c = __popcll(__ballot(k[0] > T)) + __popcll(__ballot(k[1] > T)) + __popcll(__ballot(k[2] > T)) + __popcll(__ballot(k[3] > T));
          if (lane == 0) part[wave] = c; }
        unsigned long long be[4]; unsigned weq = 0;
#pragma unroll
        for (int q = 0; q < 4; ++q) { be[q] = __ballot(k[q] == T); weq += __popcll(be[q]); }
        if (lane == 0) part[16 + wave] = weq;
        __syncthreads();
        unsigned ngt = 0, eqbase = 0;
#pragma unroll
        for (int w = 0; w < 8; ++w) { ngt += part[w]; if (w < wave) eqbase += part[16 + w]; }
        const int need = cap - (int)ngt;
        unsigned eqrank = eqbase + __popcll(be[0] & ltmask) + __popcll(be[1] & ltmask) + __popcll(be[2] & ltmask) + __popcll(be[3] & ltmask);
        bool sel[4];
#pragma unroll
        for (int q = 0; q < 4; ++q) { const bool eq = k[q] == T; sel[q] = k[q] > T || (eq && (int)eqrank < need); eqrank += eq ? 1u : 0u; }
        __syncthreads();
        unsigned long long bs[4]; unsigned wsel = 0;
#pragma unroll
        for (int q = 0; q < 4; ++q) { bs[q] = __ballot(sel[q]); wsel += __popcll(bs[q]); }
        if (lane == 0) part[wave] = wsel;
        __syncthreads();
        unsigned sbase = 0;
#pragma unroll
        for (int w = 0; w < 8; ++w) if (w < wave) sbase += part[w];
        unsigned srank = sbase + __popcll(bs[0] & ltmask) + __popcll(bs[1] & ltmask) + __popcll(bs[2] & ltmask) + __popcll(bs[3] & ltmask);
        int slot[4];
#pragma unroll
        for (int q = 0; q < 4; ++q) { const int j = 4 * tid + q; slot[q] = -1;
            if (sel[q]) { slot[q] = slot0 + (int)srank; ++srank; SELG[e * EROWS + slot[q]] = __builtin_bit_cast(float, k[q]); }
            if (j < n) INV[(size_t)(row0 + j) * NE + e] = slot[q]; }
        { LAS int* lst = (LAS int*)(part + 64) + wave * 512;
          unsigned wr_ = __popcll(bs[0] & ltmask) + __popcll(bs[1] & ltmask) + __popcll(bs[2] & ltmask) + __popcll(bs[3] & ltmask);
#pragma unroll
          for (int q = 0; q < 4; ++q) if (sel[q]) { lst[2 * wr_] = row0 + 4 * tid + q; lst[2 * wr_ + 1] = slot[q]; ++wr_; }
          LDS_WAIT(); asm volatile("" ::: "memory");
          const int nsel = (int)wsel;
          for (int i0 = 0; i0 < nsel; i0 += 4) { v4u r0[4], r1[4]; int sl[4];
#pragma unroll
              for (int k = 0; k < 4; ++k) { const int i = i0 + k < nsel ? i0 + k : nsel - 1; const int rw = lst[2 * i]; sl[k] = lst[2 * i + 1];
                  const v4u* hp = (const v4u*)(H + (size_t)rw * D) + lane; r0[k] = hp[0]; r1[k] = hp[64]; }
#pragma unroll
              for (int k = 0; k < 4; ++k) { v2u* xp = (v2u*)(XS + ((size_t)e * EROWS + sl[k]) * D) + lane;
                  v2u w0, w1; w0.x = pk4_fp8(bflo(r0[k].x), bfhi(r0[k].x), bflo(r0[k].y), bfhi(r0[k].y)); w0.y = pk4_fp8(bflo(r0[k].z), bfhi(r0[k].z), bflo(r0[k].w), bfhi(r0[k].w));
                  w1.x = pk4_fp8(bflo(r1[k].x), bfhi(r1[k].x), bflo(r1[k].y), bfhi(r1[k].y)); w1.y = pk4_fp8(bflo(r1[k].z), bfhi(r1[k].z), bflo(r1[k].w), bfhi(r1[k].w));
                  xp[0] = w0; xp[64] = w1; } }
        }
        __syncthreads();
    }
}
__device__ __forceinline__ float conv3_at(const bf16* rowp, int t, int L, float w0, float w1, float w2, float bias) {
    const int tm = t > 0 ? t - 1 : 0, tp = t < L - 1 ? t + 1 : L - 1;
    const float vm = bf2f(rowp[tm]), x0 = bf2f(rowp[t]), vp = bf2f(rowp[tp]);
    const float xm = t > 0 ? vm : 0.f, xp = t < L - 1 ? vp : 0.f;
    return w0 * xm + w1 * x0 + w2 * xp + bias;
}
template <int L> __device__ __forceinline__ void hyena_direct_item(const Args& a, const Frame& F, int l, int c) {
    constexpr int NBQ = L == SEQ ? 4 : 8, NPASS = NB / NBQ, TP = L >= 512 ? L / 512 : 1, BP = NBQ * L / 512 / TP;
    constexpr int ROW0 = L == SEQ ? 0 : MLAT;
    LAS float* kk = (LAS float*)F.lds;
    LAS float* ub = kk + 2 * L;
    LAS float* zb = ub + NBQ * L;
    const bf16* HYT = (const bf16*)(a.ws + WS_HYT); bf16* YAT = (bf16*)(a.ws + WS_YAT);
    const float* TF = (const float*)(a.ws + WS_TFC);
    const float* cw = a.in[9] + (size_t)l * 3 * NHY; const float* cb = a.in[10] + (size_t)l * NHY;
    float w[3][3], bs[3];
#pragma unroll
    for (int s = 0; s < 3; ++s) { bs[s] = cb[s * D + c];
#pragma unroll
        for (int k = 0; k < 3; ++k) w[s][k] = cw[k * NHY + s * D + c]; }
    const float hb0 = a.in[17][((size_t)l * 2 + 0) * D + c], hb1 = a.in[17][((size_t)l * 2 + 1) * D + c];
    int tq[TP], bq[BP];
#pragma unroll
    for (int i = 0; i < TP; ++i) tq[i] = L >= 512 ? F.tid + 512 * i : (F.tid & (L - 1));
#pragma unroll
    for (int i = 0; i < BP; ++i) bq[i] = L >= 512 ? i : (F.tid / L) + (512 / L) * i;
    for (int ps = 0; ps < NPASS; ++ps) {
        for (int i = F.tid; i < NBQ * L; i += 512) { const int b = i / L, t = i % L; const bf16* rp = HYT + (size_t)(2 * D + c) * MTOT + ROW0 + (ps * NBQ + b) * L;
            ub[i] = conv3_at(rp, t, L, w[2][0], w[2][1], w[2][2], bs[2]); }
#pragma unroll 1
        for (int o = 0; o < 2; ++o) {
            __syncthreads();
            for (int t = F.tid; t < L; t += 512) { kk[L - 1 + t] = TF[((size_t)(o * 2 + 0) * D + c) * L + t]; if (t > 0) kk[L - 1 - t] = TF[((size_t)(o * 2 + 1) * D + c) * L + t]; }
            __syncthreads();
            const LAS float* src = o == 0 ? ub : zb;
            float acc[TP][BP];
#pragma unroll
            for (int i = 0; i < TP; ++i)
#pragma unroll
                for (int j = 0; j < BP; ++j) acc[i][j] = 0.f;
            for (int s = 0; s < L; ++s) { float kv[TP], uv[BP];
#pragma unroll
                for (int i = 0; i < TP; ++i) kv[i] = kk[tq[i] - s + L - 1];
#pragma unroll
                for (int j = 0; j < BP; ++j) uv[j] = src[bq[j] * L + s];
#pragma unroll
                for (int i = 0; i < TP; ++i)
#pragma unroll
                    for (int j = 0; j < BP; ++j) acc[i][j] += kv[i] * uv[j]; }
            __syncthreads();
#pragma unroll
            for (int i = 0; i < TP; ++i)
#pragma unroll
                for (int j = 0; j < BP; ++j) { const int t = tq[i], b = bq[j]; const int gb = ps * NBQ + b;
                    const bf16* rp = HYT + (size_t)(o * D + c) * MTOT + ROW0 + gb * L;
                    const float xg = o == 0 ? conv3_at(rp, t, L, w[0][0], w[0][1], w[0][2], bs[0]) : conv3_at(rp, t, L, w[1][0], w[1][1], w[1][2], bs[1]);
                    const float uin = src[b * L + t];
                    const float r = xg * (acc[i][j] + uin * (o == 0 ? hb0 : hb1));
                    if (o == 0) zb[b * L + t] = r; else YAT[(size_t)c * MTOT + ROW0 + gb * L + t] = (bf16)f2bf(r); }
        }
        __syncthreads();
    }
}

__device__ __forceinline__ void read8_lds(const LAS unsigned short* row, int tt, float (&o)[8]) {
#pragma unroll
    for (int j = 0; j < 8; ++j) o[j] = bf2f(row[tt + 256 * j]);
}
__device__ __forceinline__ void hy_load_rows(const bf16* HYT, int c, int p, int tt, v4u (&pre)[6], unsigned (&lf)[6], unsigned (&rg)[6]) {
#pragma unroll
    for (int r = 0; r < 6; ++r) { const int f = (r < 2 ? 2 * D : (r < 4 ? 0 : D)) + c, bb = 2 * p + (r & 1); const bf16* rp = HYT + (size_t)f * MTOT + bb * SEQ;
        pre[r] = *(const v4u*)(rp + tt * 8);
        lf[r] = rp[tt > 0 ? 8 * tt - 1 : 0]; rg[r] = rp[tt < 255 ? 8 * tt + 8 : SEQ - 1]; }
}
__device__ __forceinline__ v4u hy_conv_vec(v4u x, unsigned lf, unsigned rg, int tt, float w0, float w1, float w2, float bias) {
    float e[10]; e[0] = tt > 0 ? bf2f((unsigned short)lf) : 0.f; e[1] = bflo(x.x); e[2] = bfhi(x.x); e[3] = bflo(x.y); e[4] = bfhi(x.y); e[5] = bflo(x.z); e[6] = bfhi(x.z); e[7] = bflo(x.w); e[8] = bfhi(x.w);
    e[9] = tt < 255 ? bf2f((unsigned short)rg) : 0.f;
    float y[8];
#pragma unroll
    for (int i = 0; i < 8; ++i) y[i] = w0 * e[i] + w1 * e[i + 1] + w2 * e[i + 2] + bias;
    v4u o; o.x = pg8::cvt_pk_bf16(y[0], y[1]); o.y = pg8::cvt_pk_bf16(y[2], y[3]); o.z = pg8::cvt_pk_bf16(y[4], y[5]); o.w = pg8::cvt_pk_bf16(y[6], y[7]); return o;
}
__device__ __forceinline__ void ph_hyena_fft(const Args& a, const Frame& F, int l) {
    const int team = F.tid >> 8, tt = F.tid & 255;
    LAS cf2* buf = (LAS cf2*)F.lds + team * 4352;
    LAS cf2* tw1 = (LAS cf2*)F.lds + 2 * 4352;
    LAS unsigned short* stage = (LAS unsigned short*)(tw1 + 256) + team * 6 * SEQ;
    c2 tw2[16]; fft_twiddles(F.tid, tw1, tw2);
    const bf16* HYT = (const bf16*)(a.ws + WS_HYT); bf16* YAT = (bf16*)(a.ws + WS_YAT);
    const float* cwb = a.in[9] + (size_t)l * 3 * NHY; const float* cbb = a.in[10] + (size_t)l * NHY;
    v4u pre[6]; unsigned lf[6], rg[6];
    if (F.vcu < D) hy_load_rows(HYT, F.vcu, team, tt, pre, lf, rg);
    for (int c = F.vcu; c < D; c += F.G) {
        const float* cw = cwb + c; const float* cb = cbb + c;
        float w[3][3], bs[3];
#pragma unroll
        for (int s = 0; s < 3; ++s) { bs[s] = cb[s * D];
#pragma unroll
            for (int k = 0; k < 3; ++k) w[s][k] = cw[k * NHY + s * D]; }
        const float hb0 = a.in[17][((size_t)l * 2 + 0) * D + c], hb1 = a.in[17][((size_t)l * 2 + 1) * D + c];
#pragma unroll 1
        for (int pp = 0; pp < 2; ++pp) {
            const int b0 = 2 * (team + 2 * pp), b1 = b0 + 1;
            __syncthreads();
#pragma unroll
            for (int r = 0; r < 6; ++r) { const int s = r < 2 ? 2 : (r < 4 ? 0 : 1);
                *(LAS v4u*)(stage + r * SEQ + tt * 8) = hy_conv_vec(pre[r], lf[r], rg[r], tt, w[s][0], w[s][1], w[s][2], bs[s]); }
            { const int cn = pp == 0 ? c : c + F.G, pn = team + 2 * (pp ^ 1); if (cn < D) hy_load_rows(HYT, cn, pn, tt, pre, lf, rg); }
            __syncthreads();
            float u0[8], u1[8];
            read8_lds(stage + 0 * SEQ, tt, u0); read8_lds(stage + 1 * SEQ, tt, u1);
#pragma unroll 1
            for (int o = 0; o < 2; ++o) {
                cf2 kk[16];
                { const cf2* K = (const cf2*)(a.ws + WS_KF) + (((size_t)l * 2 + o) * D + c) * 4096 + tt;
#pragma unroll
                  for (int k = 0; k < 16; ++k) kk[k] = K[256 * k]; }
                const float hb = o == 0 ? hb0 : hb1;
                c2 v[16];
#pragma unroll
                for (int j = 0; j < 8; ++j) v[j] = (c2){u0[j], u1[j]};
                fft4096<false, true>(v, buf, tt, tw1, tw2);
#pragma unroll
                for (int k = 0; k < 16; ++k) v[k] = c2mulconj(v[k], kk[k]);
                fft4096<false>(v, buf, tt, tw1, tw2);
                float g0[8], g1[8];
                read8_lds(stage + (2 + 2 * o) * SEQ, tt, g0); read8_lds(stage + (3 + 2 * o) * SEQ, tt, g1);
#pragma unroll
                for (int j = 0; j < 8; ++j) { u0[j] = g0[j] * (v[j].x + u0[j] * hb); u1[j] = g1[j] * (-v[j].y + u1[j] * hb); }
            }
            bf16* o0 = YAT + (size_t)c * MTOT + b0 * SEQ + tt; bf16* o1 = YAT + (size_t)c * MTOT + b1 * SEQ + tt;
#pragma unroll
            for (int j = 0; j < 8; ++j) { o0[256 * j] = (bf16)f2bf(u0[j]); o1[256 * j] = (bf16)f2bf(u1[j]); }
        }
    }
    __syncthreads();
}

__device__ __forceinline__ void ph_hyena_ctx(const Args& a, const Frame& F, int l) {
    typedef float f32x2_ __attribute__((ext_vector_type(2)));
    const int team = F.tid >> 8, t = F.tid & 255;
    LAS float* kk = (LAS float*)F.lds + team * 4608;
    LAS float* ub = kk + 512;
    LAS float* zb = ub + 2048;
    const bf16* HYT = (const bf16*)(a.ws + WS_HYT); bf16* YAT = (bf16*)(a.ws + WS_YAT); const float* TF = (const float*)(a.ws + WS_TFC);
    const float* cwb = a.in[9] + (size_t)l * 3 * NHY; const float* cbb = a.in[10] + (size_t)l * NHY;
    for (int it = F.vcu; it < D / 2; it += F.G) {
        const int c = 2 * it + team; const float* cw = cwb + c; const float* cb = cbb + c;
        __syncthreads();
        { const float w0 = cw[2 * D], w1 = cw[NHY + 2 * D], w2 = cw[2 * NHY + 2 * D], bb = cb[2 * D];
          float uu[NB];
#pragma unroll
          for (int b = 0; b < NB; ++b) uu[b] = conv3_at(HYT + (size_t)(2 * D + c) * MTOT + MLAT + b * CTX, t, CTX, w0, w1, w2, bb);
          *(LAS f32x4*)(ub + t * 8) = (f32x4){uu[0], uu[1], uu[2], uu[3]}; *(LAS f32x4*)(ub + t * 8 + 4) = (f32x4){uu[4], uu[5], uu[6], uu[7]}; }
#pragma unroll 1
        for (int o = 0; o < 2; ++o) {
            kk[255 + t] = TF[((size_t)(o * 2 + 0) * D + c) * CTX + t]; if (t > 0) kk[255 - t] = TF[((size_t)(o * 2 + 1) * D + c) * CTX + t];
            const float hb = a.in[17][((size_t)l * 2 + o) * D + c];
            const float w0 = cw[o * D], w1 = cw[NHY + o * D], w2 = cw[2 * NHY + o * D], bb = cb[o * D];
            float xg[NB];
#pragma unroll
            for (int b = 0; b < NB; ++b) xg[b] = conv3_at(HYT + (size_t)(o * D + c) * MTOT + MLAT + b * CTX, t, CTX, w0, w1, w2, bb);
            __syncthreads();
            const LAS float* src = o == 0 ? ub : zb;
            f32x2_ acc[4] = {{0.f, 0.f}, {0.f, 0.f}, {0.f, 0.f}, {0.f, 0.f}};
#pragma unroll 4
            for (int s = 0; s < CTX; ++s) { const float k0 = kk[t + 255 - s]; const f32x2_ kv = {k0, k0};
                const f32x4 ua = *(const LAS f32x4*)(src + s * 8), uc = *(const LAS f32x4*)(src + s * 8 + 4);
                acc[0] += kv * (f32x2_){ua[0], ua[1]}; acc[1] += kv * (f32x2_){ua[2], ua[3]}; acc[2] += kv * (f32x2_){uc[0], uc[1]}; acc[3] += kv * (f32x2_){uc[2], uc[3]}; }
            const f32x4 sa = *(const LAS f32x4*)(src + t * 8), sb = *(const LAS f32x4*)(src + t * 8 + 4);
            float r[NB];
            r[0] = xg[0] * (acc[0][0] + sa[0] * hb); r[1] = xg[1] * (acc[0][1] + sa[1] * hb); r[2] = xg[2] * (acc[1][0] + sa[2] * hb); r[3] = xg[3] * (acc[1][1] + sa[3] * hb);
            r[4] = xg[4] * (acc[2][0] + sb[0] * hb); r[5] = xg[5] * (acc[2][1] + sb[1] * hb); r[6] = xg[6] * (acc[3][0] + sb[2] * hb); r[7] = xg[7] * (acc[3][1] + sb[3] * hb);
            __syncthreads();
            if (o == 0) { *(LAS f32x4*)(zb + t * 8) = (f32x4){r[0], r[1], r[2], r[3]}; *(LAS f32x4*)(zb + t * 8 + 4) = (f32x4){r[4], r[5], r[6], r[7]}; }
            else {
#pragma unroll
                for (int b = 0; b < NB; ++b) YAT[(size_t)c * MTOT + MLAT + b * CTX + t] = (bf16)f2bf(r[b]); }
        }
    }
    __syncthreads();
}

__device__ __forceinline__ void ph_sc(const Args& a, const Frame& F, int l, int nrows) {
    const int gw = F.vcu * 8 + F.wave, NGW = F.G * 8, lane = F.lane;
    const bf16* PR = (const bf16*)(a.ws + WS_PR); bf16* YC = (bf16*)(a.ws + WS_YCAT) + 2ull * MTOT * D;
    const float* cw = a.in[25] + (size_t)l * 3 * D;
    float w[3][16];
#pragma unroll
    for (int k = 0; k < 3; ++k)
#pragma unroll
        for (int j = 0; j < 16; ++j) w[k][j] = cw[k * D + lane * 16 + j];
    for (int row = gw; row < nrows; row += NGW) {
        const int L = row < MLAT ? SEQ : CTX, t = row < MLAT ? (row & (SEQ - 1)) : ((row - MLAT) & (CTX - 1));
        const bf16* pp = PR + (size_t)row * NPR + PR_P + lane * 16;
        v4u z = (v4u){0u, 0u, 0u, 0u};
        v4u m0 = z, m1 = z, n0 = z, n1 = z;
        if (t > 0) { m0 = *(const v4u*)(pp - NPR); m1 = *(const v4u*)(pp - NPR + 8); }
        if (t < L - 1) { n0 = *(const v4u*)(pp + NPR); n1 = *(const v4u*)(pp + NPR + 8); }
        const v4u c0 = *(const v4u*)pp, c1 = *(const v4u*)(pp + 8);
        const bf16* bp = PR + (size_t)row * NPR + PR_BG + lane * 16; const v4u g0 = *(const v4u*)bp, g1 = *(const v4u*)(bp + 8);
        unsigned mm[8] = {m0.x, m0.y, m0.z, m0.w, m1.x, m1.y, m1.z, m1.w}, cc[8] = {c0.x, c0.y, c0.z, c0.w, c1.x, c1.y, c1.z, c1.w}, nn[8] = {n0.x, n0.y, n0.z, n0.w, n1.x, n1.y, n1.z, n1.w}, gg[8] = {g0.x, g0.y, g0.z, g0.w, g1.x, g1.y, g1.z, g1.w};
        unsigned o[8];
#pragma unroll
        for (int j = 0; j < 8; ++j) {
            const float lo = bflo(gg[j]) * (w[0][2 * j] * bflo(mm[j]) + w[1][2 * j] * bflo(cc[j]) + w[2][2 * j] * bflo(nn[j]));
            const float hi = bfhi(gg[j]) * (w[0][2 * j + 1] * bfhi(mm[j]) + w[1][2 * j + 1] * bfhi(cc[j]) + w[2][2 * j + 1] * bfhi(nn[j]));
            o[j] = pk2(lo, hi); }
        v4u* op = (v4u*)(YC + (size_t)row * D + lane * 16); op[0] = (v4u){o[0], o[1], o[2], o[3]}; op[1] = (v4u){o[4], o[5], o[6], o[7]};
    }
}

__device__ __forceinline__ void ph_transpose_ya(const Args& a, const Frame& F, int nrows) {
    const int gw = F.vcu * 8 + F.wave, NGW = F.G * 8, lane = F.lane;
    LAS unsigned short* tl = (LAS unsigned short*)(F.lds + F.wave * 16384);
    const bf16* YAT = (const bf16*)(a.ws + WS_YAT); bf16* YA = (bf16*)(a.ws + WS_YCAT);
    const int nitems = (nrows / 64) * 16;
    for (int it = gw; it < nitems; it += NGW) {
        const int tb = it >> 4, cb = it & 15, tok0 = tb * 64, c0 = cb * 64;
        v4u r[8];
#pragma unroll
        for (int k = 0; k < 8; ++k) r[k] = *(const v4u*)(YAT + (size_t)(c0 + (lane >> 3) + 8 * k) * MTOT + tok0 + (lane & 7) * 8);
#pragma unroll
        for (int k = 0; k < 8; ++k) *(LAS v4u*)(tl + ((lane >> 3) + 8 * k) * 72 + (lane & 7) * 8) = r[k];
        LDS_WAIT(); asm volatile("" ::: "memory");
        unsigned o[32];
#pragma unroll
        for (int j = 0; j < 32; ++j) o[j] = (unsigned)tl[(2 * j) * 72 + lane] | ((unsigned)tl[(2 * j + 1) * 72 + lane] << 16);
        v4u* op = (v4u*)(YA + (size_t)(tok0 + lane) * D + c0);
#pragma unroll
        for (int j = 0; j < 8; ++j) op[j] = (v4u){o[4 * j], o[4 * j + 1], o[4 * j + 2], o[4 * j + 3]};
        LDS_WAIT(); asm volatile("" ::: "memory");
    }
}

__device__ __forceinline__ float neg_expm1_(float x) { return x > -0.02f ? -(x * (1.0f + x * (0.5f + x * 0.16666667f))) : 1.0f - __expf(x); }
template <int PASS> __device__ __forceinline__ void lru_item(const Args& a, const Frame& F, int l, int q, int hd) {
    LAS float* raw = (LAS float*)F.lds;
    LAS float* xc = raw + 67 * 64;
    LAS float* GT = xc + 64 * 65;
    LAS float* SA = GT + 4 * 64 * 65;
    LAS float* CIN = SA + 2 * 4 * 64 * 2;
    LAS unsigned short* xcb = (LAS unsigned short*)(CIN + 128);
    const bf16* PR = (const bf16*)(a.ws + WS_PR);
    const bool isctx = q >= 256; const int b = isctx ? (q - 256) >> 2 : q >> 5, qi = isctx ? (q - 256) & 3 : q & 31;
    const int L = isctx ? CTX : SEQ, seq0 = isctx ? MLAT + b * CTX : b * SEQ, t0 = qi * 64, c0 = hd * 64;
    const int tid = F.tid, lane = F.lane, wave = F.wave;
    const int fr = lane & 15, fq = lane >> 4, gdir = wave >> 2, gax = (wave >> 1) & 1, jb = (wave & 1) * 32;
    float* AGG = (float*)(a.ws + WS_AGG); bf16* LAB = (bf16*)(a.ws + WS_LAB);
    v4u rv[2];
#pragma unroll
    for (int k = 0; k < 2; ++k) { const int i = tid + 512 * k, tr = i >> 3, sg = i & 7, t = t0 - 2 + tr; rv[k] = (v4u){0u, 0u, 0u, 0u};
        if (i < 67 * 8 && t >= 0 && t < L) rv[k] = *(const v4u*)(PR + (unsigned)((seq0 + t) * NPR + PR_REC + c0 + sg * 8)); }
    const int ch = tid & 63;
    const float* cw = a.in[18] + (size_t)l * 4 * D + c0 + ch; const float cw0 = cw[0], cw1 = cw[D], cw2 = cw[2 * D], cw3 = cw[3 * D], cbb = a.in[19][(size_t)l * D + c0 + ch];
    const float* SP = (const float*)(a.ws + WS_SP) + (size_t)l * 2 * D + c0 + 2 * (tid & 31);
    const c2 spm0 = *(const c2*)SP * (c2){-8.0f, -8.0f}, spm1 = *(const c2*)(SP + D) * (c2){-8.0f, -8.0f};
    bf16x8 Bf[2][2]; f32x4 bv[2];
    { const bf16* Wc = (const bf16*)(a.ws + WS_WLRU) + (((size_t)l * 16 + hd) * 256 + 32 * wave) * 64;
#pragma unroll
      for (int nt = 0; nt < 2; ++nt)
#pragma unroll
          for (int ks = 0; ks < 2; ++ks) Bf[nt][ks] = *(const bf16x8*)(Wc + (nt * 16 + fr) * 64 + ks * 32 + fq * 8);
      const float* bias = (gax ? a.in[23] : a.in[21]) + ((size_t)l * 2 + gdir) * D + c0 + jb;
#pragma unroll
      for (int nt = 0; nt < 2; ++nt) bv[nt] = *(const f32x4*)(bias + nt * 16 + 4 * fq); }
    v4u gg = (v4u){0u, 0u, 0u, 0u}; float hcar = 0.f;
    if (PASS == 2) {
        gg = *(const v4u*)(PR + ((size_t)seq0 + t0 + (tid >> 3)) * NPR + PR_GELU + c0 + (tid & 7) * 8);
        if (tid < 128) {
            const int dir = tid >> 6; const float* ag = AGG + ((size_t)dir * NCHUNK) * D * 2 + (size_t)(c0 + ch) * 2;
            const int cbase = 256 + b * 4, lbase = b * 32;
            float ga[35], gb[35];
#pragma unroll
            for (int p = 0; p < 35; ++p) { int chunk; bool valid;
                if (isctx) { chunk = dir == 0 ? cbase + p : cbase + 3 - p; valid = dir == 0 ? p < qi : p < 3 - qi; }
                else if (p < 4) { chunk = dir == 0 ? cbase + p : cbase + 3 - p; valid = true; }
                else { chunk = dir == 0 ? lbase + (p - 4) : lbase + 31 - (p - 4); valid = dir == 0 ? (p - 4) < qi : (p - 4) < 31 - qi; }
                if (p >= 4 && isctx) valid = false;
                ga[p] = 1.f; gb[p] = 0.f;
                if (valid) { const f32x2 g = *(const f32x2*)(ag + (size_t)chunk * D * 2); ga[p] = g[0]; gb[p] = g[1]; } }
#pragma unroll
            for (int p = 0; p < 35; ++p) hcar = ga[p] * hcar + gb[p];
        }
    }
    __syncthreads();
#pragma unroll
    for (int k = 0; k < 2; ++k) { const int i = tid + 512 * k; if (i < 67 * 8) { const v4u r = rv[k];
        LAS float* d = raw + (i >> 3) * 64 + (i & 7) * 8; d[0] = bflo(r.x); d[1] = bfhi(r.x); d[2] = bflo(r.y); d[3] = bfhi(r.y); d[4] = bflo(r.z); d[5] = bfhi(r.z); d[6] = bflo(r.w); d[7] = bfhi(r.w); } }
    if (PASS == 2 && tid < 128) CIN[tid] = hcar;
    __syncthreads();
#pragma unroll
    for (int k = 0; k < 8; ++k) { const int tt = (tid >> 6) + 8 * k;
        const float x = cw0 * raw[tt * 64 + ch] + cw1 * raw[(tt + 1) * 64 + ch] + cw2 * raw[(tt + 2) * 64 + ch] + cw3 * raw[(tt + 3) * 64 + ch] + cbb;
        xc[tt * 65 + ch] = x; xcb[tt * 72 + ch] = (unsigned short)f2bf(x); }
    __syncthreads();
    {
      LAS float* gp = GT + (gdir * 2 + gax) * 64 * 65 + jb + 4 * fq;
#pragma unroll
      for (int mt = 0; mt < 4; ++mt) { f32x4 acc[2] = {bv[0], bv[1]};
#pragma unroll
          for (int ks = 0; ks < 2; ++ks) { const bf16x8 Af = *(const LAS bf16x8*)(xcb + (mt * 16 + fr) * 72 + ks * 32 + fq * 8);
#pragma unroll
              for (int nt = 0; nt < 2; ++nt) acc[nt] = __builtin_amdgcn_mfma_f32_16x16x32_bf16(Bf[nt][ks], Af, acc[nt], 0, 0, 0); }
#pragma unroll
          for (int nt = 0; nt < 2; ++nt)
#pragma unroll
              for (int r = 0; r < 4; ++r) gp[(mt * 16 + fr) * 65 + nt * 16 + r] = sigmoidf_(acc[nt][r]); } }
    __syncthreads();
    {
      const int cp = tid & 31;
#pragma unroll
      for (int k = 0; k < 8; ++k) { const int dir = k >> 2, tt = (tid >> 5) + 16 * (k & 3);
          LAS float* pr = GT + (dir * 2) * 64 * 65 + tt * 65 + 2 * cp; LAS float* pi = pr + 64 * 65;
          const c2 r = (c2){pr[0], pr[1]}, iv = (c2){pi[0], pi[1]}, xv = (c2){xc[tt * 65 + 2 * cp], xc[tt * 65 + 2 * cp + 1]};
          const c2 la = r * (dir ? spm1 : spm0);
          const unsigned labp = pg8::cvt_pk_bf16(la.x, la.y);
          const c2 lar = (c2){__builtin_bit_cast(float, labp << 16), __builtin_bit_cast(float, labp & 0xffff0000u)};
          const c2 ex = lar * (c2){1.4426950408889634f, 1.4426950408889634f};
          const c2 av = (c2){__builtin_amdgcn_exp2f(ex.x), __builtin_amdgcn_exp2f(ex.y)}, x2 = lar + lar;
          const c2 one = (c2){1.0f, 1.0f};
          const c2 pol = -(x2 * (one + x2 * ((c2){0.5f, 0.5f} + x2 * (c2){0.16666667f, 0.16666667f}))), sq = one - av * av;
          const c2 om = (c2){x2.x > -0.02f ? pol.x : sq.x, x2.y > -0.02f ? pol.y : sq.y};
          const c2 bv0 = (c2){__builtin_amdgcn_sqrtf(om.x), __builtin_amdgcn_sqrtf(om.y)} * (iv * xv);
          const unsigned bbp = pg8::cvt_pk_bf16(bv0.x, bv0.y);
          pr[0] = av.x; pr[1] = av.y; pi[0] = __builtin_bit_cast(float, bbp << 16); pi[1] = __builtin_bit_cast(float, bbp & 0xffff0000u);
          if (PASS == 1) { unsigned* lp = (unsigned*)(LAB + (unsigned)((dir * 2 * MTOT + seq0 + t0 + tt) * D + c0 + 2 * cp)); lp[0] = labp; lp[(size_t)MTOT * D / 2] = bbp; } } }
    __syncthreads();
    const int sdir = tid >> 8, ssq = (tid >> 6) & 3, sch = tid & 63;
    const int tfirst = sdir == 0 ? 16 * ssq : 63 - 16 * ssq, tstep = sdir == 0 ? 1 : -1;
    LAS float* pa = GT + (sdir * 2) * 64 * 65 + sch; LAS float* pb = pa + 64 * 65;
    { float h = 0.f, ap = 1.f;
#pragma unroll
      for (int s = 0; s < 16; ++s) { const int tt = tfirst + tstep * s; const float av = pa[tt * 65]; h = av * h + pb[tt * 65]; ap *= av; }
      SA[((sdir * 4 + ssq) * 64 + sch) * 2] = ap; SA[((sdir * 4 + ssq) * 64 + sch) * 2 + 1] = h; }
    __syncthreads();
    if (PASS == 1) {
        if (tid < 128) { const int dir = tid >> 6; float h = 0.f, ap = 1.f;
#pragma unroll
            for (int s = 0; s < 4; ++s) { const float sa = SA[((dir * 4 + s) * 64 + ch) * 2], sb = SA[((dir * 4 + s) * 64 + ch) * 2 + 1]; h = sa * h + sb; ap *= sa; }
            *(f32x2*)(AGG + (((size_t)dir * NCHUNK + q) * D + c0 + ch) * 2) = (f32x2){ap, h}; }
    } else {
        float h = CIN[sdir * 64 + sch];
#pragma unroll
        for (int s = 0; s < 3; ++s) if (s < ssq) { const float sa = SA[((sdir * 4 + s) * 64 + sch) * 2], sb = SA[((sdir * 4 + s) * 64 + sch) * 2 + 1]; h = sa * h + sb; }
#pragma unroll
        for (int s = 0; s < 16; ++s) { const int tt = tfirst + tstep * s; h = pa[tt * 65] * h + pb[tt * 65]; pb[tt * 65] = h; }
        __syncthreads();
        bf16* YB = (bf16*)(a.ws + WS_YCAT) + (size_t)MTOT * D;
        { const int tt = tid >> 3, sg = tid & 7; const size_t row = (size_t)seq0 + t0 + tt; const v4u g = gg;
          const LAS float* hf = GT + (0 * 2 + 1) * 64 * 65 + tt * 65 + sg * 8; const LAS float* hb = GT + (1 * 2 + 1) * 64 * 65 + tt * 65 + sg * 8;
          v4u o; o.x = pk2(bflo(g.x) * (hf[0] + hb[0]), bfhi(g.x) * (hf[1] + hb[1])); o.y = pk2(bflo(g.y) * (hf[2] + hb[2]), bfhi(g.y) * (hf[3] + hb[3]));
          o.z = pk2(bflo(g.z) * (hf[4] + hb[4]), bfhi(g.z) * (hf[5] + hb[5])); o.w = pk2(bflo(g.w) * (hf[6] + hb[6]), bfhi(g.w) * (hf[7] + hb[7]));
          *(v4u*)(YB + row * D + c0 + sg * 8) = o; }
    }
}

__device__ __forceinline__ void lru_rows(const bf16* PR, int it, int tid, v4u (&rv)[2]) {
    const int q = it >> 4, hd = it & 15; const bool isctx = q >= 256; const int b = isctx ? (q - 256) >> 2 : q >> 5, qi = isctx ? (q - 256) & 3 : q & 31;
    const int L = isctx ? CTX : SEQ, seq0 = isctx ? MLAT + b * CTX : b * SEQ, t0 = qi * 64, c0 = hd * 64;
#pragma unroll
    for (int k = 0; k < 2; ++k) { const int i = tid + 512 * k, tr = (i >> 3) < 66 ? (i >> 3) : 66, sg = i & 7; int t = t0 - 2 + tr; t = t < 0 ? 0 : (t > L - 1 ? L - 1 : t);
        rv[k] = *(const v4u*)(PR + (unsigned)((seq0 + t) * NPR + PR_REC + c0 + sg * 8)); }
}
__device__ __forceinline__ void ph_lru1(const Args& a, const Frame& F, int l) {
    constexpr int PASS = 1;
    LAS float* raw = (LAS float*)F.lds;
    LAS float* xc = raw + 67 * 64;
    LAS float* GT = xc + 64 * 65;
    LAS float* SA = GT + 4 * 64 * 65;
    LAS float* CIN = SA + 2 * 4 * 64 * 2;
    LAS unsigned short* xcb = (LAS unsigned short*)(CIN + 128);
    const bf16* PR = (const bf16*)(a.ws + WS_PR);
    const int tid = F.tid, lane = F.lane, wave = F.wave, ch = tid & 63;
    const int fr = lane & 15, fq = lane >> 4, gdir = wave >> 2, gax = (wave >> 1) & 1, jb = (wave & 1) * 32;
    float* AGG = (float*)(a.ws + WS_AGG); bf16* LAB = (bf16*)(a.ws + WS_LAB);
    constexpr int NIT = NCHUNK * 16;
    if (F.vcu >= NIT) return;
    const int hd = F.vcu & 15, c0 = hd * 64;
    const float* cw = a.in[18] + (size_t)l * 4 * D + c0 + ch; const float cw0 = cw[0], cw1 = cw[D], cw2 = cw[2 * D], cw3 = cw[3 * D], cbb = a.in[19][(size_t)l * D + c0 + ch];
    const float* SP = (const float*)(a.ws + WS_SP) + (size_t)l * 2 * D + c0 + 2 * (tid & 31);
    const c2 spm0 = *(const c2*)SP * (c2){-8.0f, -8.0f}, spm1 = *(const c2*)(SP + D) * (c2){-8.0f, -8.0f};
    bf16x8 Bf[2][2]; f32x4 bv[2];
    { const bf16* Wc = (const bf16*)(a.ws + WS_WLRU) + (((size_t)l * 16 + hd) * 256 + 32 * wave) * 64;
#pragma unroll
      for (int nt = 0; nt < 2; ++nt)
#pragma unroll
          for (int ks = 0; ks < 2; ++ks) Bf[nt][ks] = *(const bf16x8*)(Wc + (nt * 16 + fr) * 64 + ks * 32 + fq * 8);
      const float* bias = (gax ? a.in[23] : a.in[21]) + ((size_t)l * 2 + gdir) * D + c0 + jb;
#pragma unroll
      for (int nt = 0; nt < 2; ++nt) bv[nt] = *(const f32x4*)(bias + nt * 16 + 4 * fq); }
    v4u rv[2];
    lru_rows(PR, F.vcu, tid, rv);
    for (int it = F.vcu; it < NIT; it += F.G) {
        const int q = it >> 4;
        const bool isctx = q >= 256; const int b = isctx ? (q - 256) >> 2 : q >> 5, qi = isctx ? (q - 256) & 3 : q & 31;
        const int L = isctx ? CTX : SEQ, seq0 = isctx ? MLAT + b * CTX : b * SEQ, t0 = qi * 64;
        __syncthreads();
#pragma unroll
        for (int k = 0; k < 2; ++k) { const int i = tid + 512 * k, t = t0 - 2 + (i >> 3); if (i < 67 * 8) { v4u r = rv[k]; if (t < 0 || t >= L) r = (v4u){0u, 0u, 0u, 0u};
            LAS float* d = raw + (i >> 3) * 64 + (i & 7) * 8; d[0] = bflo(r.x); d[1] = bfhi(r.x); d[2] = bflo(r.y); d[3] = bfhi(r.y); d[4] = bflo(r.z); d[5] = bfhi(r.z); d[6] = bflo(r.w); d[7] = bfhi(r.w); } }
        { const int itn = it + F.G < NIT ? it + F.G : it; lru_rows(PR, itn, tid, rv); }
        __syncthreads();
#pragma unroll
        for (int k = 0; k < 8; ++k) { const int tt = (tid >> 6) + 8 * k;
            const float x = cw0 * raw[tt * 64 + ch] + cw1 * raw[(tt + 1) * 64 + ch] + cw2 * raw[(tt + 2) * 64 + ch] + cw3 * raw[(tt + 3) * 64 + ch] + cbb;
            xc[tt * 65 + ch] = x; xcb[tt * 72 + ch] = (unsigned short)f2bf(x); }
        __syncthreads();
        {
          LAS float* gp = GT + (gdir * 2 + gax) * 64 * 65 + jb + 4 * fq;
#pragma unroll
          for (int mt = 0; mt < 4; ++mt) { f32x4 acc[2] = {bv[0], bv[1]};
#pragma unroll
              for (int ks = 0; ks < 2; ++ks) { const bf16x8 Af = *(const LAS bf16x8*)(xcb + (mt * 16 + fr) * 72 + ks * 32 + fq * 8);
#pragma unroll
                  for (int nt = 0; nt < 2; ++nt) acc[nt] = __builtin_amdgcn_mfma_f32_16x16x32_bf16(Bf[nt][ks], Af, acc[nt], 0, 0, 0); }
#pragma unroll
              for (int nt = 0; nt < 2; ++nt)
#pragma unroll
                  for (int r = 0; r < 4; ++r) gp[(mt * 16 + fr) * 65 + nt * 16 + r] = sigmoidf_(acc[nt][r]); } }
        __syncthreads();
        {
          const int cp = tid & 31;
#pragma unroll
          for (int k = 0; k < 8; ++k) { const int dir = k >> 2, tt = (tid >> 5) + 16 * (k & 3);
              LAS float* pr = GT + (dir * 2) * 64 * 65 + tt * 65 + 2 * cp; LAS float* pi = pr + 64 * 65;
              const c2 r = (c2){pr[0], pr[1]}, iv = (c2){pi[0], pi[1]}, xv = (c2){xc[tt * 65 + 2 * cp], xc[tt * 65 + 2 * cp + 1]};
              const c2 la = r * (dir ? spm1 : spm0);
              const unsigned labp = pg8::cvt_pk_bf16(la.x, la.y);
              const c2 lar = (c2){__builtin_bit_cast(float, labp << 16), __builtin_bit_cast(float, labp & 0xffff0000u)};
              const c2 ex = lar * (c2){1.4426950408889634f, 1.4426950408889634f};
              const c2 av = (c2){__builtin_amdgcn_exp2f(ex.x), __builtin_amdgcn_exp2f(ex.y)}, x2 = lar + lar;
              const c2 one = (c2){1.0f, 1.0f};
              const c2 pol = -(x2 * (one + x2 * ((c2){0.5f, 0.5f} + x2 * (c2){0.16666667f, 0.16666667f}))), sq = one - av * av;
              const c2 om = (c2){x2.x > -0.02f ? pol.x : sq.x, x2.y > -0.02f ? pol.y : sq.y};
              const c2 bv0 = (c2){__builtin_amdgcn_sqrtf(om.x), __builtin_amdgcn_sqrtf(om.y)} * (iv * xv);
              const unsigned bbp = pg8::cvt_pk_bf16(bv0.x, bv0.y);
              pr[0] = av.x; pr[1] = av.y; pi[0] = __builtin_bit_cast(float, bbp << 16); pi[1] = __builtin_bit_cast(float, bbp & 0xffff0000u);
              { unsigned* lp = (unsigned*)(LAB + (unsigned)((dir * 2 * MTOT + seq0 + t0 + tt) * D + c0 + 2 * cp)); lp[0] = labp; lp[(size_t)MTOT * D / 2] = bbp; } } }
        __syncthreads();
        const int sdir = tid >> 8, ssq = (tid >> 6) & 3, sch = tid & 63;
        const int tfirst = sdir == 0 ? 16 * ssq : 63 - 16 * ssq, tstep = sdir == 0 ? 1 : -1;
        LAS float* pa = GT + (sdir * 2) * 64 * 65 + sch; LAS float* pb = pa + 64 * 65;
        { float h = 0.f, ap = 1.f;
#pragma unroll
          for (int s = 0; s < 16; ++s) { const int tt = tfirst + tstep * s; const float av = pa[tt * 65]; h = av * h + pb[tt * 65]; ap *= av; }
          SA[((sdir * 4 + ssq) * 64 + sch) * 2] = ap; SA[((sdir * 4 + ssq) * 64 + sch) * 2 + 1] = h; }
        __syncthreads();

            if (tid < 128) { const int dir = tid >> 6; float h = 0.f, ap = 1.f;
#pragma unroll
                for (int s = 0; s < 4; ++s) { const float sa = SA[((dir * 4 + s) * 64 + ch) * 2], sb = SA[((dir * 4 + s) * 64 + ch) * 2 + 1]; h = sa * h + sb; ap *= sa; }
                *(f32x2*)(AGG + (((size_t)dir * NCHUNK + q) * D + c0 + ch) * 2) = (f32x2){ap, h}; }

    }
}
__device__ __forceinline__ void lru_item_p2(const Args& a, const Frame& F, int l, int q, int hd, int wit) {
    LAS float* GT = (LAS float*)F.lds;
    LAS float* SA = GT + 4 * 64 * 65;
    LAS float* CIN = SA + 2 * 4 * 64 * 2;
    const bf16* PR = (const bf16*)(a.ws + WS_PR); const bf16* LAB = (const bf16*)(a.ws + WS_LAB); const float* AGG = (const float*)(a.ws + WS_AGG);
    const bool isctx = q >= 256; const int b = isctx ? (q - 256) >> 2 : q >> 5, qi = isctx ? (q - 256) & 3 : q & 31;
    const int seq0 = isctx ? MLAT + b * CTX : b * SEQ, t0 = qi * 64, c0 = hd * 64;
    const int tid = F.tid, ch = tid & 63;
    v4u lv[4];
#pragma unroll
    for (int k = 0; k < 4; ++k) { const int tt = (tid >> 3) & 63, sg = tid & 7; lv[k] = *(const v4u*)(LAB + ((size_t)k * MTOT + seq0 + t0 + tt) * D + c0 + sg * 8); }
    const v4u gg = *(const v4u*)(PR + ((size_t)seq0 + t0 + (tid >> 3)) * NPR + PR_GELU + c0 + (tid & 7) * 8);
    float hcar = 0.f;
    if (tid < 128) { const int dir = tid >> 6; const float* ag = AGG + ((size_t)dir * NCHUNK) * D * 2 + (size_t)(c0 + ch) * 2;
        const int cbase = 256 + b * 4, lbase = b * 32;
        float ga[35], gb[35];
#pragma unroll
        for (int p = 0; p < 35; ++p) { int chunk; bool valid;
            if (isctx) { chunk = dir == 0 ? cbase + p : cbase + 3 - p; valid = dir == 0 ? p < qi : p < 3 - qi; }
            else if (p < 4) { chunk = dir == 0 ? cbase + p : cbase + 3 - p; valid = true; }
            else { chunk = dir == 0 ? lbase + (p - 4) : lbase + 31 - (p - 4); valid = dir == 0 ? (p - 4) < qi : (p - 4) < 31 - qi; }
            if (p >= 4 && isctx) valid = false;
            ga[p] = 1.f; gb[p] = 0.f;
            if (valid) { const f32x2 g = *(const f32x2*)(ag + (size_t)chunk * D * 2); ga[p] = g[0]; gb[p] = g[1]; } }
#pragma unroll
        for (int p = 0; p < 35; ++p) hcar = ga[p] * hcar + gb[p]; }
    f32x4 wv[16]; unsigned char* wd = nullptr; size_t wK = 0; const bool have = wit < NITW;
    if (have) wx_load(a, l, wit, F.lane, wv, wd, wK);
    __syncthreads();
    { const int tt = tid >> 3, sg = tid & 7;
#pragma unroll
      for (int k = 0; k < 4; ++k) { LAS float* d = GT + k * 64 * 65 + tt * 65 + sg * 8; const v4u r = lv[k];
          float f[8] = {bflo(r.x), bfhi(r.x), bflo(r.y), bfhi(r.y), bflo(r.z), bfhi(r.z), bflo(r.w), bfhi(r.w)};
#pragma unroll
          for (int j = 0; j < 8; ++j) d[j] = (k & 1) ? f[j] : __expf(f[j]); } }
    if (tid < 128) CIN[tid] = hcar;
    __syncthreads();
    const int sdir = tid >> 8, ssq = (tid >> 6) & 3, sch = tid & 63;
    const int tfirst = sdir == 0 ? 16 * ssq : 63 - 16 * ssq, tstep = sdir == 0 ? 1 : -1;
    LAS float* pa = GT + (sdir * 2) * 64 * 65 + sch; LAS float* pb = pa + 64 * 65;
    float av[16], bw[16];
    { float h = 0.f, ap = 1.f;
#pragma unroll
      for (int s = 0; s < 16; ++s) { const int tt = tfirst + tstep * s; av[s] = pa[tt * 65]; bw[s] = pb[tt * 65]; h = av[s] * h + bw[s]; ap *= av[s]; }
      SA[((sdir * 4 + ssq) * 64 + sch) * 2] = ap; SA[((sdir * 4 + ssq) * 64 + sch) * 2 + 1] = h; }
    __syncthreads();
    { float h = CIN[sdir * 64 + sch];
#pragma unroll
      for (int s = 0; s < 3; ++s) if (s < ssq) { const float sa = SA[((sdir * 4 + s) * 64 + sch) * 2], sb = SA[((sdir * 4 + s) * 64 + sch) * 2 + 1]; h = sa * h + sb; }
#pragma unroll
      for (int s = 0; s < 16; ++s) { const int tt = tfirst + tstep * s; h = av[s] * h + bw[s]; pb[tt * 65] = h; } }
    __syncthreads();
    bf16* YB = (bf16*)(a.ws + WS_YCAT) + (size_t)MTOT * D;
    { const int tt = tid >> 3, sg = tid & 7; const size_t row = (size_t)seq0 + t0 + tt; const v4u g = gg;
      const LAS float* hf = GT + (0 * 2 + 1) * 64 * 65 + tt * 65 + sg * 8; const LAS float* hb = GT + (1 * 2 + 1) * 64 * 65 + tt * 65 + sg * 8;
      v4u o; o.x = pk2(bflo(g.x) * (hf[0] + hb[0]), bfhi(g.x) * (hf[1] + hb[1])); o.y = pk2(bflo(g.y) * (hf[2] + hb[2]), bfhi(g.y) * (hf[3] + hb[3]));
      o.z = pk2(bflo(g.z) * (hf[4] + hb[4]), bfhi(g.z) * (hf[5] + hb[5])); o.w = pk2(bflo(g.w) * (hf[6] + hb[6]), bfhi(g.w) * (hf[7] + hb[7]));
      *(v4u*)(YB + row * D + c0 + sg * 8) = o; }
    if (have) wx_store(wv, wd, wK, F.lane);
}
#ifndef REP_LRU1
#define REP_LRU1 1
#endif
#ifndef REP_HY
#define REP_HY 1
#endif
#ifndef REP_CTX
#define REP_CTX 1
#endif
#ifndef REP_SC
#define REP_SC 1
#endif
#ifndef REP_LRU2
#define REP_LRU2 1
#endif
#ifndef REP_TR
#define REP_TR 1
#endif
#ifndef REP_NORM2
#define REP_NORM2 1
#endif
#ifndef REP_RANK
#define REP_RANK 1
#endif
#ifndef MK_SINGLE
#define MK_SINGLE 1
#endif
__global__ void __launch_bounds__(512, 2) mk_fwd(Args args) {
    extern __shared__ __attribute__((aligned(16))) unsigned char lds[];
    Frame F;
    F.lds = (LAS unsigned char*)lds;
    F.tid = threadIdx.x; F.lane = F.tid & 63; F.wave = __builtin_amdgcn_readfirstlane(F.tid >> 6);
    F.G = gridDim.x; { const int bx = blockIdx.x; F.vcu = (F.G % 8 == 0) ? (bx % 8) * (F.G / 8) + bx / 8 : bx; }
    volatile LAS unsigned* MISC = (volatile LAS unsigned*)(F.lds + MISC_OFF);
    for (int u = F.tid; u < 32; u += 512) MISC[u] = 0u;
    __syncthreads();
    unsigned* ctl = (unsigned*)(args.ws + WS_CTL);
    XcdBarrier bar; bar.bar = ctl + CW_BAR + args.li * XCD_BAR_WORDS; bar.x = 0; bar.st = nullptr;
    if (MK_SINGLE) bar = xcd_barrier_post(ctl + CW_BAR + args.li * XCD_BAR_WORDS, MISC + 8);
    const int lo = args.ph_lo, hi = args.ph_hi;
#define IN(k) (lo <= (k) && (k) < hi)
#define SEAM(k) do { if (MK_SINGLE && IN((k) + 1)) xcd_barrier(bar); } while (0)
    const int bid = (int)blockIdx.x; const int vcu0 = F.vcu, G0 = F.G;
#define LAUNDER() do { int t_ = threadIdx.x; asm volatile("" : "+v"(t_)); F.tid = t_; F.lane = t_ & 63; F.wave = __builtin_amdgcn_readfirstlane(t_ >> 6); int g_ = G0, v_ = vcu0; asm volatile("" : "+s"(g_), "+s"(v_)); F.G = g_; F.vcu = v_; } while (0)
    LAS unsigned char* ring = F.lds;

    if (IN(0)) { LAUNDER(); ph_prologue(args, F); SEAM(0); }
    if (IN(1)) { LAUNDER(); ph_filters(args, F); SEAM(1); }
#pragma unroll 1
    for (int l = 0; l < 2; ++l) {
        const int pb = 2 + 10 * l;
        const int mrows = l == 0 ? MTOT : MLAT;
        bf16* WIN = (bf16*)(args.ws + WS_WIN) + (size_t)l * NIN * D; bf16* WOUT = (bf16*)(args.ws + WS_WOUT) + (size_t)l * 4 * D * D;
        bf16* H = (bf16*)(args.ws + WS_H); bf16* PR = (bf16*)(args.ws + WS_PR); bf16* YCAT = (bf16*)(args.ws + WS_YCAT);
        if (IN(pb + 0)) {
            LAUNDER();
            if (l == 0) ph_norm<0, false>(args, F, l); else ph_norm<0, true>(args, F, l);
            SEAM(pb + 0);
        }
        if (IN(pb + 1)) {
            { pg8::Gemm g{WIN, H, NHY, mrows, D}; RectOrder S; S.init(NHY / 256, mrows / 256, 0, 0, 0, 0, F.G, bid);
              EpiPlainBf16 E{(bf16*)(args.ws + WS_HYT), MTOT};
              pg8::gemm_phase<EpiPlainBf16, RectOrder, true, true>(ring, g, S, E); }
            { pg8::Gemm g{H, WIN + (size_t)NHY * D, MTOT, N2, D}; RectOrder S;
              if (l == 0) S.init(MTOT / 256, N2 / 256, 0, 0, 0, 0, F.G, bid); else S.init(MLAT / 256, N2 / 256, MCTX / 256, 4, MLAT / 256, 4, F.G, bid);
              EpiInProj E{PR};
              pg8::gemm_phase<EpiInProj, RectOrder, true, true>(ring, g, S, E); }
            SEAM(pb + 1);
        }
        if (IN(pb + 2)) {
            LAUNDER();
            for (int rep = 0; rep < REP_LRU1; ++rep) { if ((F.G & 15) == 0) ph_lru1(args, F, l); else for (int it = F.vcu; it < NCHUNK * 16; it += F.G) lru_item<1>(args, F, l, it >> 4, it & 15); }
            __syncthreads();
            LAUNDER();
            for (int rep = 0; rep < REP_HY; ++rep) ph_hyena_fft(args, F, l);
            LAUNDER();
            if (l == 0) for (int rep = 0; rep < REP_CTX; ++rep) ph_hyena_ctx(args, F, l);
            LAUNDER();
            for (int rep = 0; rep < REP_SC; ++rep) ph_sc(args, F, l, mrows);
            SEAM(pb + 2);
        }
        if (IN(pb + 3)) {
            LAUNDER();
            {
              int wit = F.vcu * 8 + F.wave; const int NGW = F.G * 8;
              for (int it = F.vcu; it < (mrows / LCH) * 16; it += F.G) { lru_item_p2(args, F, l, it >> 4, it & 15, wit); wit += NGW; }
              for (; wit < NITW; wit += NGW) { f32x4 wv[16]; unsigned char* wd; size_t wK; wx_load(args, l, wit, F.lane, wv, wd, wK); wx_store(wv, wd, wK, F.lane); } }
            __syncthreads();
            LAUNDER();
            for (int rep = 0; rep < REP_TR; ++rep) ph_transpose_ya(args, F, mrows);
            SEAM(pb + 3);
        }
        if (IN(pb + 4)) {
            bf16* MB = (bf16*)(args.ws + WS_MB);
            TripleOrder S; S.init(mrows / 256, MTOT / 256, F.G, bid);
            pg8::Gemm g{YCAT, WOUT, 3 * MTOT, 3 * D, D}; EpiGate3 E{PR + PR_GATE, MB, MTOT / 256};
            pg8::gemm_phase<EpiGate3, TripleOrder, true, true>(ring, g, S, E);
            SEAM(pb + 4);
        }
        if (IN(pb + 5)) {
            pg8::Gemm g{(bf16*)(args.ws + WS_MB), WOUT + 3ull * D * D, mrows, D, D}; RectOrder S; S.init(mrows / 256, 4, 0, 0, 0, 0, F.G, bid);
            EpiResid E{(float*)(args.ws + WS_X), (const float*)(args.ws + WS_MOD) + (size_t)l * 9 * 6144 + 2 * 1024};
            pg8::gemm_phase<EpiResid, RectOrder, true, true>(ring, g, S, E);
            SEAM(pb + 5);
        }
        if (IN(pb + 6)) { LAUNDER(); for (int rep = 0; rep < REP_NORM2; ++rep) ph_norm<1, false>(args, F, l); SEAM(pb + 6); }
        if (IN(pb + 7)) { LAUNDER(); for (int rep = 0; rep < REP_RANK; ++rep) ph_rank(args, F, l); SEAM(pb + 7); }
        if (IN(pb + 8)) {
            pg8::Gemm g{(bf16*)(args.ws + WS_XS), (bf16*)(args.ws + WS_WGU + (size_t)l * NE * NGU * D), NE * EROWS, NE * NGU, D / 2}; GroupOrder S; S.init(NE, l == 0 ? 9 : 8, 9, 22, F.G, bid);
            EpiSwiglu E{args.ws + WS_HID};
            pg8::gemm_phase<EpiSwiglu, GroupOrder, true, true, true>(ring, g, S, E);
            SEAM(pb + 8);
        }
        if (IN(pb + 9)) {
            pg8::Gemm g{(bf16*)(args.ws + WS_HID), (bf16*)(args.ws + WS_WD + (size_t)l * NE * D * DE), NE * EROWS, NE * D, DE / 2}; GroupOrder S; S.init(NE, l == 0 ? 9 : 8, 9, 4, F.G, bid);
            EpiYs E{(bf16*)(args.ws + WS_YS)};
            pg8::gemm_phase<EpiYs, GroupOrder, true, true, true>(ring, g, S, E);
            SEAM(pb + 9);
        }
    }
    if (IN(22)) { LAUNDER(); ph_norm<2, true>(args, F, 1); }
#undef IN
#undef SEAM
}

extern "C" void kernel_launch(void* const* d_in, const int* in_sizes, int n_in, void* d_out, int out_size, void* d_ws, size_t ws_size, hipStream_t stream) {
    static int grid = 0;
    if (grid == 0) {
        if (n_in != 35 || out_size != MLAT * D || ws_size < WS_END) { fprintf(stderr, "kernel_launch: unexpected shapes (n_in %d, out %d, ws %zu < %zu)\n", n_in, out_size, ws_size, (size_t)WS_END); grid = -1; return; }
        int dev = 0, cus = 0, per_cu = 0;
        if (hipGetDevice(&dev) != hipSuccess || hipDeviceGetAttribute(&cus, hipDeviceAttributeMultiprocessorCount, dev) != hipSuccess) { grid = -1; return; }
        if (hipFuncSetAttribute((const void*)mk_fwd, hipFuncAttributeMaxDynamicSharedMemorySize, LDS_BYTES) != hipSuccess) { fprintf(stderr, "kernel_launch: hipFuncSetAttribute failed\n"); grid = -1; return; }
        if (hipOccupancyMaxActiveBlocksPerMultiprocessor(&per_cu, (const void*)mk_fwd, 512, LDS_BYTES) != hipSuccess || per_cu < 1) fprintf(stderr, "kernel_launch: occupancy query says %d\n", per_cu);
        (void)hipGetLastError();
        grid = cus;
    }
    if (grid < 0) return;
    if (hipMemsetAsync((char*)d_ws + WS_CTL, 0, CTL_ZERO_BYTES, stream) != hipSuccess) return;
    Args a{};
    for (int i = 0; i < 35; ++i) a.in[i] = (const float*)d_in[i];
    a.out = (float*)d_out; a.ws = (unsigned char*)d_ws; a.pad = 0;
#if defined(PROBE_LO)
    a.ph_lo = 0; a.ph_hi = PROBE_HI; a.li = 0; hipLaunchKernelGGL(mk_fwd, dim3(grid), dim3(512), LDS_BYTES, stream, a);
    a.ph_lo = PROBE_LO; a.ph_hi = NPHASE; a.li = 1; hipLaunchKernelGGL(mk_fwd, dim3(grid), dim3(512), LDS_BYTES, stream, a);
#elif MK_SINGLE
    a.ph_lo = 0; a.ph_hi = NPHASE; a.li = 0;
    hipLaunchKernelGGL(mk_fwd, dim3(grid), dim3(512), LDS_BYTES, stream, a);
#else
    for (int p = 0; p < NPHASE; ++p) { a.ph_lo = p; a.ph_hi = p + 1; a.li = 0; hipLaunchKernelGGL(mk_fwd, dim3(grid), dim3(512), LDS_BYTES, stream, a); }
#endif
}
```

```cpp
#include <hip/hip_runtime.h>
#include <cstdio>
#include <cstdint>
namespace pg8 {
#define PG8_LAS __attribute__((address_space(3)))
typedef unsigned short bf16_t;
typedef short bf16x8 __attribute__((ext_vector_type(8)));
typedef float f32x4 __attribute__((ext_vector_type(4)));
typedef unsigned u32x4 __attribute__((ext_vector_type(4)));
constexpr int BM = 256, BK = 64, HALF = 128, HTB = HALF * BK * 2  , STAGE_BYTES = 8 * HTB, NXCD = 8, WGM = 8;

__host__ __device__ __forceinline__ int lds_byte(int r, int c) { const int st = (r >> 4) * 2 + (c >> 5), rr = r & 15, cc = c & 31, ob = rr * 64 + cc * 2; return st * 1024 + (ob ^ (((ob >> 9) & 1) << 5)); }
__host__ __device__ __forceinline__ void stage_rc(int b, int& R, int& C) { const int st = b / 1024, sb = b % 1024, swz = sb ^ (((sb >> 9) & 1) << 5); R = (st >> 1) * 16 + swz / 64; C = (st & 1) * 32 + (swz % 64) / 2; }
__host__ __device__ __forceinline__ int perm32(int rho) { const int n = rho >> 4, i = rho & 15; return 8 * (i >> 2) + 4 * n + (i & 3); }

struct Unit { int pm, pn; };
struct Gemm { const bf16_t* A; const bf16_t* Bt; int M, N, K; };

struct StaticOrder {
    int nM, nN, nwg, G, c;
    __host__ __device__ void init(int M, int N, int G_, int c_) { nM = M / BM; nN = N / BM; nwg = nM * nN; G = G_; c = c_; }
    __host__ __device__ bool next(int i, Unit& u) const {
        const long L = (long)i * G + c; if (L >= nwg) return false;
        int wgid = (int)L; { const int q = nwg / NXCD, r = nwg % NXCD, xcd = wgid % NXCD, off = wgid / NXCD; wgid = (xcd < r ? xcd * (q + 1) : r * (q + 1) + (xcd - r) * q) + off; }
        const int nig = WGM * nN, gid = wgid / nig, fm = gid * WGM, gsz = (nM - fm) < WGM ? (nM - fm) : WGM;
        u.pm = fm + ((wgid % nig) % gsz); u.pn = (wgid % nig) / gsz; return true;
    }
    __device__ __forceinline__ void a_ready(const Unit&) const {}
    __device__ __forceinline__ void done(const Unit&) const {}
};
__device__ __forceinline__ unsigned cvt_pk_bf16(float lo, float hi) { unsigned r; asm volatile("v_cvt_pk_bf16_f32 %0, %1, %2" : "=v"(r) : "v"(lo), "v"(hi)); return r; }
typedef float f32x2 __attribute__((ext_vector_type(2)));
typedef int i32x4_ __attribute__((ext_vector_type(4))); typedef int i32x8_ __attribute__((ext_vector_type(8)));
__device__ __forceinline__ bf16x8 frag_lo(i32x8_ v) { const i32x4_ t = __builtin_shufflevector(v, v, 0, 1, 2, 3); return __builtin_bit_cast(bf16x8, t); }
__device__ __forceinline__ bf16x8 frag_hi(i32x8_ v) { const i32x4_ t = __builtin_shufflevector(v, v, 4, 5, 6, 7); return __builtin_bit_cast(bf16x8, t); }
__device__ __forceinline__ i32x8_ cat8(bf16x8 lo, bf16x8 hi) { const i32x4_ a = __builtin_bit_cast(i32x4_, lo), b = __builtin_bit_cast(i32x4_, hi); return __builtin_shufflevector(a, b, 0, 1, 2, 3, 4, 5, 6, 7); }
template <class Epi, class Sched, bool ALIGN_EPI = false, bool SP2 = false, bool FP8 = false>
__device__ __forceinline__ void gemm_phase(PG8_LAS unsigned char* lds, const Gemm g, const Sched& S, const Epi& E) {
    int tid_ = threadIdx.x; asm volatile("" : "+v"(tid_));
    const int tid = tid_, wid = __builtin_amdgcn_readfirstlane(tid >> 6), lane = tid & 63, wr = wid >> 2, wc = wid & 3, fr = lane & 15, fq = lane >> 4;
    const int K = g.K, nt = K / BK;
    unsigned voffA[2], voffB[2];
#pragma unroll
    for (int i = 0; i < 2; ++i) { int R, C; stage_rc(tid * 16 + i * 8192, R, C); const int Rb = Epi::PERM ? ((R & ~31) + perm32(R & 31)) : R;
        const int ch = C >> 3; const unsigned Cb = FP8 ? (unsigned)(((ch & 3) * 2 + (ch >> 2)) * 16) : (unsigned)C * 2u;
        voffA[i] = (unsigned)(R * K) * 2u + Cb; voffB[i] = (unsigned)(Rb * K) * 2u + Cb; }
    const size_t kstep = (size_t)(BK * 2);
    const size_t hstep = (size_t)HALF * K * 2;
    const size_t tstep = 2 * hstep;
    const unsigned ldsw = (unsigned)wid * 1024u;
    const int aoff = lds_byte(wr * 64 + fr, fq * 8), boff = lds_byte(wc * 32 + fr, fq * 8);
#define PG8_SA(b, h) (((b) * 2 + (h)) * HTB)
#define PG8_SB(b, h) ((4 + (b) * 2 + (h)) * HTB)
#define PG8_STAGE(bufoff, gbase, voff) do { _Pragma("unroll") for (int _i = 0; _i < 2; ++_i) \
        __builtin_amdgcn_global_load_lds((const unsigned*)((const char*)(gbase) + (voff)[_i]), (PG8_LAS unsigned*)(lds + (bufoff) + ldsw + _i * 8192), 16, 0, 0); } while (0)
#define PG8_LDA(dst, b, h) do { _Pragma("unroll") for (int m = 0; m < 4; ++m) { dst[m].lo = *(const PG8_LAS i32x4_*)(lds + PG8_SA(b, h) + aoff + m * 2048); dst[m].hi = *(const PG8_LAS i32x4_*)(lds + PG8_SA(b, h) + aoff + m * 2048 + 1024); } } while (0)
#define PG8_LDB(dst, b, h) do { _Pragma("unroll") for (int n = 0; n < 2; ++n) { dst[n].lo = *(const PG8_LAS i32x4_*)(lds + PG8_SB(b, h) + boff + n * 2048); dst[n].hi = *(const PG8_LAS i32x4_*)(lds + PG8_SB(b, h) + boff + n * 2048 + 1024); } } while (0)
#define PG8_MMA(ai, bj, At, Bt) do { __builtin_amdgcn_s_setprio(1); if constexpr (FP8) { _Pragma("unroll") for (int m = 0; m < 4; ++m) _Pragma("unroll") for (int n = 0; n < 2; ++n) \
        asm volatile("v_mfma_scale_f32_16x16x128_f8f6f4 %0, %1, %2, %0, %3, %4 op_sel_hi:[0,0,0]" : "+v"(acc[ai][bj][m][n]) : "v"(Bt[n]), "v"(At[m]), "v"(sclw), "v"(scla)); } \
        else { _Pragma("unroll") for (int m = 0; m < 4; ++m) _Pragma("unroll") for (int n = 0; n < 2; ++n) { \
        acc[ai][bj][m][n] = __builtin_amdgcn_mfma_f32_16x16x32_bf16(frag_lo(Bt[n]), frag_lo(At[m]), acc[ai][bj][m][n], 0, 0, 0); \
        acc[ai][bj][m][n] = __builtin_amdgcn_mfma_f32_16x16x32_bf16(frag_hi(Bt[n]), frag_hi(At[m]), acc[ai][bj][m][n], 0, 0, 0); } } __builtin_amdgcn_s_setprio(0); } while (0)
#define PG8_WAIT_V(n) asm volatile("s_waitcnt vmcnt(" #n ")" ::: "memory")
#define PG8_WAIT_L(n) asm volatile("s_waitcnt lgkmcnt(" #n ")" ::: "memory")
#define PG8_BAR __builtin_amdgcn_s_barrier()
#define PG8_SCHED __builtin_amdgcn_sched_barrier(0)
    Unit cur, nxt; int ui = 0;
    if (!S.next(0, cur)) return;
    f32x4 acc[2][2][4][2];
#pragma unroll
    for (int a = 0; a < 2; ++a)
#pragma unroll
        for (int b = 0; b < 2; ++b)
#pragma unroll
            for (int m = 0; m < 4; ++m)
#pragma unroll
                for (int n = 0; n < 2; ++n) acc[a][b][m][n] = (f32x4){0.f, 0.f, 0.f, 0.f};
    i32x8_ At[4], B0[2], B1[2];
    int sclw = 0x7a7a7a7a, scla = 0x7f7f7f7f;
    if constexpr (FP8) asm volatile("" : "+v"(sclw), "+v"(scla));
    const char* cA = (const char*)g.A + (size_t)cur.pm * tstep; const char* cB = (const char*)g.Bt + (size_t)cur.pn * tstep;
    S.a_ready(cur);
    if constexpr (SP2) {
        PG8_STAGE(PG8_SB(0, 0), cB, voffB); PG8_STAGE(PG8_SB(0, 1), cB + hstep, voffB); PG8_STAGE(PG8_SA(0, 0), cA, voffA); PG8_STAGE(PG8_SA(0, 1), cA + hstep, voffA);
        if (wr == 1) PG8_BAR;
        PG8_WAIT_V(2); PG8_BAR;
        PG8_STAGE(PG8_SB(1, 0), cB + kstep, voffB); PG8_STAGE(PG8_SA(1, 0), cA + kstep, voffA); PG8_STAGE(PG8_SB(1, 1), cB + hstep + kstep, voffB);
        PG8_WAIT_V(6); PG8_BAR;
    } else {
        PG8_STAGE(PG8_SB(0, 0), cB, voffB); PG8_STAGE(PG8_SA(0, 0), cA, voffA); PG8_STAGE(PG8_SB(0, 1), cB + hstep, voffB); PG8_STAGE(PG8_SA(0, 1), cA + hstep, voffA);
        if (wr == 1) PG8_BAR;
        PG8_WAIT_V(4); PG8_BAR;
        PG8_STAGE(PG8_SB(1, 0), cB + kstep, voffB); PG8_STAGE(PG8_SA(1, 0), cA + kstep, voffA); PG8_STAGE(PG8_SB(1, 1), cB + hstep + kstep, voffB);
        PG8_WAIT_V(6); PG8_BAR;
    }
    for (;;) {
        const bool has_next = S.next(ui + 1, nxt);
        const char* nA = has_next ? (const char*)g.A + (size_t)nxt.pm * tstep : cA; const char* nB = has_next ? (const char*)g.Bt + (size_t)nxt.pn * tstep : cB;
#pragma unroll 1
        for (int t = 0; t < nt; t += 2) {
            const bool last = (t == nt - 2);
            const char* a1 = cA + (size_t)(t + 1) * kstep;
            const char* a2 = last ? nA : cA + (size_t)(t + 2) * kstep; const char* b2 = last ? nB : cB + (size_t)(t + 2) * kstep;
            const char* a3 = a2 + kstep; const char* b3 = b2 + kstep;
            if (last && has_next) S.a_ready(nxt);
            if constexpr (SP2) {
            PG8_LDB(B0, 0, 0); PG8_LDB(B1, 0, 1); PG8_SCHED; PG8_LDA(At, 0, 0); PG8_STAGE(PG8_SA(1, 1), a1 + hstep, voffA);
            PG8_WAIT_V(8); PG8_WAIT_L(0); PG8_BAR; PG8_MMA(0, 0, At, B0); PG8_MMA(0, 1, At, B1); PG8_BAR; PG8_SCHED;
            PG8_LDA(At, 0, 1); PG8_STAGE(PG8_SB(0, 0), b2, voffB); PG8_STAGE(PG8_SB(0, 1), b2 + hstep, voffB); PG8_STAGE(PG8_SA(0, 0), a2, voffA);
            PG8_WAIT_V(8); PG8_WAIT_L(0); PG8_BAR; PG8_MMA(1, 0, At, B0); PG8_MMA(1, 1, At, B1); PG8_BAR; PG8_SCHED;
            PG8_LDB(B0, 1, 0); PG8_LDB(B1, 1, 1); PG8_SCHED; PG8_LDA(At, 1, 0); PG8_STAGE(PG8_SA(0, 1), a2 + hstep, voffA);
            PG8_WAIT_V(8); PG8_WAIT_L(0); PG8_BAR; PG8_MMA(0, 0, At, B0); PG8_MMA(0, 1, At, B1); PG8_BAR; PG8_SCHED;
            PG8_LDA(At, 1, 1); PG8_STAGE(PG8_SB(1, 0), b3, voffB); PG8_STAGE(PG8_SB(1, 1), b3 + hstep, voffB); PG8_STAGE(PG8_SA(1, 0), a3, voffA);
            PG8_WAIT_V(8); PG8_WAIT_L(0); PG8_BAR; PG8_MMA(1, 0, At, B0); PG8_MMA(1, 1, At, B1); PG8_BAR; PG8_SCHED;
            } else {
            PG8_LDB(B0, 0, 0); PG8_SCHED; PG8_LDA(At, 0, 0); PG8_STAGE(PG8_SA(1, 1), a1 + hstep, voffA);
            PG8_WAIT_L(8); PG8_BAR; PG8_WAIT_L(0); PG8_MMA(0, 0, At, B0); PG8_BAR; PG8_SCHED;
            PG8_LDB(B1, 0, 1); PG8_STAGE(PG8_SB(0, 0), b2, voffB);
            PG8_BAR; PG8_WAIT_L(0); PG8_MMA(0, 1, At, B1); PG8_BAR;
            PG8_LDA(At, 0, 1); PG8_STAGE(PG8_SA(0, 0), a2, voffA);
            PG8_BAR; PG8_WAIT_L(0); PG8_MMA(1, 0, At, B0); PG8_BAR; PG8_SCHED;
            PG8_STAGE(PG8_SB(0, 1), b2 + hstep, voffB);
            PG8_WAIT_V(6); PG8_BAR; PG8_MMA(1, 1, At, B1); PG8_BAR;
            PG8_LDB(B0, 1, 0); PG8_SCHED; PG8_LDA(At, 1, 0); PG8_STAGE(PG8_SA(0, 1), a2 + hstep, voffA);
            PG8_WAIT_L(8); PG8_BAR; PG8_WAIT_L(0); PG8_MMA(0, 0, At, B0); PG8_BAR; PG8_SCHED;
            PG8_LDB(B1, 1, 1); PG8_STAGE(PG8_SB(1, 0), b3, voffB);
            PG8_BAR; PG8_WAIT_L(0); PG8_MMA(0, 1, At, B1); PG8_BAR;
            PG8_LDA(At, 1, 1); PG8_STAGE(PG8_SA(1, 0), a3, voffA);
            PG8_BAR; PG8_WAIT_L(0); PG8_MMA(1, 0, At, B0); PG8_BAR; PG8_SCHED;
            PG8_STAGE(PG8_SB(1, 1), b3 + hstep, voffB);
            PG8_WAIT_V(6); PG8_BAR; PG8_MMA(1, 1, At, B1); PG8_BAR;
            }
        }
        if constexpr (ALIGN_EPI) { if (wr == 0) PG8_BAR; }
        if constexpr (FP8) asm volatile("s_nop 15\n\ts_nop 15" ::: "memory");
        if constexpr (!Epi::AFTER_DRAIN) { E(acc, cur, wr, wc, fr, fq); S.done(cur); }
        if (!has_next) break;
        if (!(Epi::CHAIN && E.keep(cur))) {
#pragma unroll
        for (int a = 0; a < 2; ++a)
#pragma unroll
            for (int b = 0; b < 2; ++b)
#pragma unroll
                for (int m = 0; m < 4; ++m)
#pragma unroll
                    for (int n = 0; n < 2; ++n) acc[a][b][m][n] = (f32x4){0.f, 0.f, 0.f, 0.f};
        }
        cur = nxt; cA = nA; cB = nB; ++ui;
        if constexpr (ALIGN_EPI) { if (wr == 1) PG8_BAR; }
    }
    PG8_WAIT_V(0);
    if constexpr (!ALIGN_EPI) { if (wr == 0) PG8_BAR; }
    PG8_BAR;
    if constexpr (Epi::AFTER_DRAIN) { E.fused(acc, cur, wr, wc, fr, fq, lds, wid, lane); S.done(cur); }
#undef PG8_SA
#undef PG8_SB
#undef PG8_STAGE
#undef PG8_LDA
#undef PG8_LDB
#undef PG8_MMA
#undef PG8_WAIT_V
#undef PG8_WAIT_L
#undef PG8_BAR
#undef PG8_SCHED
}
}
#define GAS __attribute__((address_space(1)))
#define LAS __attribute__((address_space(3)))
typedef unsigned short bf16;
typedef unsigned v4u __attribute__((ext_vector_type(4)));
typedef unsigned v2u __attribute__((ext_vector_type(2)));
typedef float f32x4 __attribute__((ext_vector_type(4)));
typedef float f32x2 __attribute__((ext_vector_type(2)));
typedef short bf16x8 __attribute__((ext_vector_type(8)));
typedef GAS unsigned gu32;
#define RLX_AGENT __ATOMIC_RELAXED, __HIP_MEMORY_SCOPE_AGENT
#define LDS_WAIT() asm volatile("s_waitcnt lgkmcnt(0)" ::: "memory")
#define VM_WAIT() asm volatile("s_waitcnt vmcnt(0)" ::: "memory")
__device__ __forceinline__ unsigned f2bf(float f) { unsigned u = __builtin_bit_cast(unsigned, f); return (u + 0x7fffu + ((u >> 16) & 1u)) >> 16; }
__device__ __forceinline__ unsigned pk2(float lo, float hi) { return f2bf(lo) | (f2bf(hi) << 16); }
__device__ __forceinline__ float bf2f(unsigned short b) { return __builtin_bit_cast(float, ((unsigned)b) << 16); }
__device__ __forceinline__ float bflo(unsigned w) { return __builtin_bit_cast(float, w << 16); }
__device__ __forceinline__ float bfhi(unsigned w) { return __builtin_bit_cast(float, w & 0xffff0000u); }
__device__ __forceinline__ float sigmoidf_(float x) { return __builtin_amdgcn_rcpf(1.0f + __expf(-x)); }
__device__ __forceinline__ float gelu_tanh_(float x) { const float t = 1.5957691216f * (x + 0.044715f * x * x * x); return x * __builtin_amdgcn_rcpf(1.0f + __expf(-t)); }
__device__ __forceinline__ unsigned pk4_fp8(float a, float b, float c, float d) { int w = 0; w = __builtin_amdgcn_cvt_pk_fp8_f32(a, b, w, false); w = __builtin_amdgcn_cvt_pk_fp8_f32(c, d, w, true); return (unsigned)w; }
__device__ __forceinline__ float silu_(float x) { return x * __builtin_amdgcn_rcpf(1.0f + __expf(-x)); }

constexpr int D = 1024, NB = 8, SEQ = 2048, CTX = 256;
constexpr int MLAT = NB * SEQ, MCTX = NB * CTX, MTOT = MLAT + MCTX;
constexpr int NHY = 3072, N2 = 8192, NPR = 7168, NIN = 11264;
constexpr int NE = 16, DE = 2816, EROWS = 2304, NGU = 2 * DE;
constexpr int PR_GELU = 0, PR_REC = 1024, PR_BG = 2048, PR_P = 3072, PR_GATE = 4096;
constexpr int LCH = 64, NCHUNK = MTOT / LCH;

__device__ __forceinline__ int xcd_remap(int wgid, int nwg) { const int q = nwg / 8, r = nwg % 8, xcd = wgid % 8, off = wgid / 8; return (xcd < r ? xcd * (q + 1) : r * (q + 1) + (xcd - r) * q) + off; }

struct RectOrder {
    int nM1, nN1, n1, nM2, nN2, n2, pm2, pn2, G, c;
    __device__ void init(int nM1_, int nN1_, int nM2_, int nN2_, int pm2_, int pn2_, int G_, int c_) { nM1 = nM1_; nN1 = nN1_; n1 = nM1 * nN1; nM2 = nM2_; nN2 = nN2_; n2 = nM2 * nN2; pm2 = pm2_; pn2 = pn2_; G = G_; c = c_; }
    __device__ bool next(int i, pg8::Unit& u) const {
        const int L = i * G + c;
        if (L < n1) { const int wgid = xcd_remap(L, n1); const int nig = 8 * nN1, gid = wgid / nig, fm = gid * 8, gsz = (nM1 - fm) < 8 ? (nM1 - fm) : 8;
            u.pm = fm + ((wgid % nig) % gsz); u.pn = (wgid % nig) / gsz; return true; }
        const int L2 = L - n1; if (L2 >= n2) return false;
        u.pm = pm2 + L2 % nM2; u.pn = pn2 + L2 / nM2; return true;
    }
    __device__ __forceinline__ void a_ready(const pg8::Unit&) const {}
    __device__ __forceinline__ void done(const pg8::Unit&) const {}
};
struct GroupOrder {
    int mt, mstride, nt, nwg, G, c;
    __device__ void init(int nE, int mt_, int mstride_, int nt_, int G_, int c_) { mt = mt_; mstride = mstride_; nt = nt_; nwg = nE * mt * nt; G = G_; c = c_; }
    __device__ bool next(int i, pg8::Unit& u) const {
        const int L = i * G + c; if (L >= nwg) return false;
        const int wgid = xcd_remap(L, nwg); const int per = mt * nt, e = wgid / per, r = wgid % per;
        u.pm = e * mstride + r % mt; u.pn = e * nt + r / mt; return true;
    }
    __device__ __forceinline__ void a_ready(const pg8::Unit&) const {}
    __device__ __forceinline__ void done(const pg8::Unit&) const {}
};


struct TripleOrder {
    int nM, ntile, mstride, G, c;
    __device__ void init(int nM_, int mstride_, int G_, int c_) { nM = nM_; ntile = nM_ * 4; mstride = mstride_; G = G_; c = c_; }
    __device__ bool next(int u, pg8::Unit& un) const {
        const int t = u / 3, i = u - 3 * t, L = t * G + c; if (L >= ntile) return false;
        const int wgid = xcd_remap(L, ntile); const int nig = 8 * 4, gid = wgid / nig, fm = gid * 8, gsz = (nM - fm) < 8 ? (nM - fm) : 8;
        un.pm = i * mstride + fm + ((wgid % nig) % gsz); un.pn = i * 4 + (wgid % nig) / gsz; return true;
    }
    __device__ __forceinline__ void a_ready(const pg8::Unit&) const {}
    __device__ __forceinline__ void done(const pg8::Unit&) const {}
};

#define EPI_ROW(u, ai, m) ((u).pm * 256 + wr * 64 + fr + (ai) * 128 + (m) * 16)
struct EpiPlainBf16 {
    static constexpr bool PERM = true, AFTER_DRAIN = false, CHAIN = false; __device__ __forceinline__ bool keep(const pg8::Unit&) const { return false; }
    bf16* O; int ldc;
    __device__ __forceinline__ void operator()(const f32x4 (&acc)[2][2][4][2], const pg8::Unit& u, int wr, int wc, int fr, int fq) const {
        const int col0 = u.pn * 256 + wc * 32 + 8 * fq;
#pragma unroll
        for (int ai = 0; ai < 2; ++ai)
#pragma unroll
            for (int m = 0; m < 4; ++m) { bf16* rowp = O + (size_t)EPI_ROW(u, ai, m) * ldc + col0;
#pragma unroll
                for (int bj = 0; bj < 2; ++bj) { const f32x4 v0 = acc[ai][bj][m][0], v1 = acc[ai][bj][m][1];
                    v4u w; w.x = pg8::cvt_pk_bf16(v0[0], v0[1]); w.y = pg8::cvt_pk_bf16(v0[2], v0[3]); w.z = pg8::cvt_pk_bf16(v1[0], v1[1]); w.w = pg8::cvt_pk_bf16(v1[2], v1[3]);
                    *(v4u*)(rowp + bj * 128) = w; } }
    }
};
struct EpiInProj {
    static constexpr bool PERM = true, AFTER_DRAIN = false, CHAIN = false; __device__ __forceinline__ bool keep(const pg8::Unit&) const { return false; }
    bf16* PR;
    __device__ __forceinline__ void operator()(const f32x4 (&acc)[2][2][4][2], const pg8::Unit& u, int wr, int wc, int fr, int fq) const {
        const int pn = u.pn;
        if (pn >= 12 && pn < 20) {
            const int col = PR_P + (pn - 12) * 128 + wc * 32 + 8 * fq;
#pragma unroll
            for (int ai = 0; ai < 2; ++ai)
#pragma unroll
                for (int m = 0; m < 4; ++m) { const f32x4 v0 = acc[ai][0][m][0] * acc[ai][1][m][0], v1 = acc[ai][0][m][1] * acc[ai][1][m][1];
                    v4u w; w.x = pg8::cvt_pk_bf16(v0[0], v0[1]); w.y = pg8::cvt_pk_bf16(v0[2], v0[3]); w.z = pg8::cvt_pk_bf16(v1[0], v1[1]); w.w = pg8::cvt_pk_bf16(v1[2], v1[3]);
                    *(v4u*)(PR + (size_t)EPI_ROW(u, ai, m) * NPR + col) = w; }
        } else {
            const int mode = pn < 4 ? 1 : (pn < 12 ? 0 : 2);
            const int col0 = (pn < 12 ? pn * 256 : PR_GATE + (pn - 20) * 256) + wc * 32 + 8 * fq;
#pragma unroll
            for (int ai = 0; ai < 2; ++ai)
#pragma unroll
                for (int m = 0; m < 4; ++m) { bf16* rowp = PR + (size_t)EPI_ROW(u, ai, m) * NPR + col0;
#pragma unroll
                    for (int bj = 0; bj < 2; ++bj) { f32x4 v0 = acc[ai][bj][m][0], v1 = acc[ai][bj][m][1];
                        if (mode == 1) {
#pragma unroll
                            for (int j = 0; j < 4; ++j) { v0[j] = gelu_tanh_(v0[j]); v1[j] = gelu_tanh_(v1[j]); } }
                        else if (mode == 2) {
#pragma unroll
                            for (int j = 0; j < 4; ++j) { v0[j] = sigmoidf_(v0[j]); v1[j] = sigmoidf_(v1[j]); } }
                        v4u w; w.x = pg8::cvt_pk_bf16(v0[0], v0[1]); w.y = pg8::cvt_pk_bf16(v0[2], v0[3]); w.z = pg8::cvt_pk_bf16(v1[0], v1[1]); w.w = pg8::cvt_pk_bf16(v1[2], v1[3]);
                        *(v4u*)(rowp + bj * 128) = w; } }
        }
    }
};
template <int VAR> struct EpiGate {
    static constexpr bool PERM = true, AFTER_DRAIN = false, CHAIN = false; __device__ __forceinline__ bool keep(const pg8::Unit&) const { return false; }
    const bf16* gates; float* M32; bf16* MB;
    __device__ __forceinline__ void operator()(const f32x4 (&acc)[2][2][4][2], const pg8::Unit& u, int wr, int wc, int fr, int fq) const {
        const int col0 = u.pn * 256 + wc * 32 + 8 * fq;
#pragma unroll
        for (int ai = 0; ai < 2; ++ai)
#pragma unroll
            for (int m = 0; m < 4; ++m) { const size_t row = (size_t)EPI_ROW(u, ai, m);
#pragma unroll
                for (int bj = 0; bj < 2; ++bj) { const int col = col0 + bj * 128;
                    const v4u g = *(const v4u*)(gates + row * NPR + col);
                    f32x4 v0 = acc[ai][bj][m][0], v1 = acc[ai][bj][m][1];
                    v0[0] *= bflo(g.x); v0[1] *= bfhi(g.x); v0[2] *= bflo(g.y); v0[3] *= bfhi(g.y); v1[0] *= bflo(g.z); v1[1] *= bfhi(g.z); v1[2] *= bflo(g.w); v1[3] *= bfhi(g.w);
                    float* mp = M32 + row * D + col;
                    if (VAR >= 1) { v0 += *(const f32x4*)mp; v1 += *(const f32x4*)(mp + 4); }
                    if (VAR <= 1) { *(f32x4*)mp = v0; *(f32x4*)(mp + 4) = v1; }
                    else { v4u w; w.x = pg8::cvt_pk_bf16(v0[0], v0[1]); w.y = pg8::cvt_pk_bf16(v0[2], v0[3]); w.z = pg8::cvt_pk_bf16(v1[0], v1[1]); w.w = pg8::cvt_pk_bf16(v1[2], v1[3]);
                        *(v4u*)(MB + row * D + col) = w; } } }
    }
};

struct EpiGate3 {
    static constexpr bool PERM = true, AFTER_DRAIN = false, CHAIN = true;
    const bf16* gates; bf16* MB; int mstride;
    __device__ __forceinline__ bool keep(const pg8::Unit& u) const { return (u.pn >> 2) < 2; }
    __device__ __forceinline__ void operator()(f32x4 (&acc)[2][2][4][2], const pg8::Unit& u0, int wr, int wc, int fr, int fq) const {
        const int i = u0.pn >> 2; pg8::Unit u; u.pm = u0.pm - i * mstride; u.pn = u0.pn & 3;
        const int col0 = u.pn * 256 + wc * 32 + 8 * fq; const bf16* gt = gates + i * 1024;
#pragma unroll
        for (int ai = 0; ai < 2; ++ai) {
            v4u G[4][2], Gn[4][2];
#pragma unroll
            for (int m = 0; m < 4; ++m) { const size_t row = (size_t)EPI_ROW(u, ai, m);
#pragma unroll
                for (int bj = 0; bj < 2; ++bj) { const bf16* gp = gt + row * NPR + col0 + bj * 128; G[m][bj] = *(const v4u*)gp;
                    Gn[m][bj] = *(const v4u*)(gp + (i < 2 ? 1024 : 0)); } }
#pragma unroll
            for (int m = 0; m < 4; ++m) { const size_t row = (size_t)EPI_ROW(u, ai, m);
#pragma unroll
                for (int bj = 0; bj < 2; ++bj) { const int col = col0 + bj * 128;
                    const v4u g = G[m][bj];
                    float s[8] = {bflo(g.x), bfhi(g.x), bflo(g.y), bfhi(g.y), bflo(g.z), bfhi(g.z), bflo(g.w), bfhi(g.w)};
                    if (i >= 1) {
#pragma unroll
                        for (int j = 0; j < 8; ++j) s[j] = fmaxf(s[j], 1e-18f); }
                    if (i < 2) { const v4u gn = Gn[m][bj];
                        const float d[8] = {bflo(gn.x), bfhi(gn.x), bflo(gn.y), bfhi(gn.y), bflo(gn.z), bfhi(gn.z), bflo(gn.w), bfhi(gn.w)};
#pragma unroll
                        for (int j = 0; j < 8; ++j) s[j] = s[j] * __builtin_amdgcn_rcpf(fmaxf(d[j], 1e-18f)); }
                    f32x4 v0 = acc[ai][bj][m][0], v1 = acc[ai][bj][m][1];
                    v0[0] *= s[0]; v0[1] *= s[1]; v0[2] *= s[2]; v0[3] *= s[3]; v1[0] *= s[4]; v1[1] *= s[5]; v1[2] *= s[6]; v1[3] *= s[7];
                    if (i < 2) { acc[ai][bj][m][0] = v0; acc[ai][bj][m][1] = v1; }
                    else { v4u w; w.x = pg8::cvt_pk_bf16(v0[0], v0[1]); w.y = pg8::cvt_pk_bf16(v0[2], v0[3]); w.z = pg8::cvt_pk_bf16(v1[0], v1[1]); w.w = pg8::cvt_pk_bf16(v1[2], v1[3]);
                        *(v4u*)(MB + row * D + col) = w; } } }
        }
    }
};
struct EpiResid {
    static constexpr bool PERM = false, AFTER_DRAIN = false, CHAIN = false; __device__ __forceinline__ bool keep(const pg8::Unit&) const { return false; }
    float* X; const float* modg;
    __device__ __forceinline__ void operator()(const f32x4 (&acc)[2][2][4][2], const pg8::Unit& u, int wr, int wc, int fr, int fq) const {
        const int r = u.pm < 64 ? (u.pm >> 3) : 8; const float* mg = modg + (size_t)r * 6144;
        const int col0 = u.pn * 256 + wc * 32 + 4 * fq;
        f32x4 gv[2][2];
#pragma unroll
        for (int bj = 0; bj < 2; ++bj)
#pragma unroll
            for (int n = 0; n < 2; ++n) gv[bj][n] = *(const f32x4*)(mg + col0 + bj * 128 + n * 16);
#pragma unroll
        for (int ai = 0; ai < 2; ++ai) {
            f32x4 xv[4][2][2];
#pragma unroll
            for (int m = 0; m < 4; ++m) { const float* rowp = X + (size_t)EPI_ROW(u, ai, m) * D + col0;
#pragma unroll
                for (int bj = 0; bj < 2; ++bj)
#pragma unroll
                    for (int n = 0; n < 2; ++n) xv[m][bj][n] = *(const f32x4*)(rowp + bj * 128 + n * 16); }
#pragma unroll
            for (int m = 0; m < 4; ++m) { float* rowp = X + (size_t)EPI_ROW(u, ai, m) * D + col0;
#pragma unroll
                for (int bj = 0; bj < 2; ++bj)
#pragma unroll
                    for (int n = 0; n < 2; ++n) *(f32x4*)(rowp + bj * 128 + n * 16) = xv[m][bj][n] + gv[bj][n] * acc[ai][bj][m][n]; }
        }
    }
};
struct EpiSwiglu {
    static constexpr bool PERM = true, AFTER_DRAIN = false, CHAIN = false; __device__ __forceinline__ bool keep(const pg8::Unit&) const { return false; }
    unsigned char* HID;
    __device__ __forceinline__ void operator()(const f32x4 (&acc)[2][2][4][2], const pg8::Unit& u, int wr, int wc, int fr, int fq) const {
        const int jn = u.pn % 22; const int col = jn * 128 + wc * 32 + 8 * fq;
#pragma unroll
        for (int ai = 0; ai < 2; ++ai)
#pragma unroll
            for (int m = 0; m < 4; ++m) { f32x4 v0, v1;
#pragma unroll
                for (int j = 0; j < 4; ++j) { v0[j] = silu_(acc[ai][0][m][0][j]) * acc[ai][1][m][0][j]; v1[j] = silu_(acc[ai][0][m][1][j]) * acc[ai][1][m][1][j]; }
                v2u w; w.x = pk4_fp8(v0[0], v0[1], v0[2], v0[3]); w.y = pk4_fp8(v1[0], v1[1], v1[2], v1[3]);
                *(v2u*)(HID + (size_t)EPI_ROW(u, ai, m) * DE + col) = w; }
    }
};
struct EpiYs {
    static constexpr bool PERM = true, AFTER_DRAIN = false, CHAIN = false; __device__ __forceinline__ bool keep(const pg8::Unit&) const { return false; }
    bf16* YS;
    __device__ __forceinline__ void operator()(const f32x4 (&acc)[2][2][4][2], const pg8::Unit& u, int wr, int wc, int fr, int fq) const {
        const int col0 = (u.pn & 3) * 256 + wc * 32 + 8 * fq;
#pragma unroll
        for (int ai = 0; ai < 2; ++ai)
#pragma unroll
            for (int m = 0; m < 4; ++m) { bf16* rowp = YS + (size_t)EPI_ROW(u, ai, m) * D + col0;
#pragma unroll
                for (int bj = 0; bj < 2; ++bj) { const f32x4 v0 = acc[ai][bj][m][0], v1 = acc[ai][bj][m][1];
                    v4u w; w.x = pg8::cvt_pk_bf16(v0[0], v0[1]); w.y = pg8::cvt_pk_bf16(v0[2], v0[3]); w.z = pg8::cvt_pk_bf16(v1[0], v1[1]); w.w = pg8::cvt_pk_bf16(v1[2], v1[3]);
                    *(v4u*)(rowp + bj * 128) = w; } }
    }
};
#define XB_TMO      128
#define XB_XCNT(j)  (256  + 64 * (j))
#define XB_XSUB(j)  (1280 + 64 * (j))
#define XB_XGEN(j)  (2304 + 64 * (j))
#define XB_TOP      3328
#define XB_TOPGEN   3392
#define XCD_BAR_WORDS 3456
#define XB_SPIN_CAP (1u << 18)

__device__ __forceinline__ unsigned xb_ld(unsigned* p)              { return __hip_atomic_load(p, __ATOMIC_RELAXED, __HIP_MEMORY_SCOPE_AGENT); }
__device__ __forceinline__ unsigned xb_add(unsigned* p, unsigned v) { return __hip_atomic_fetch_add(p, v, __ATOMIC_RELAXED, __HIP_MEMORY_SCOPE_AGENT); }
__device__ __forceinline__ unsigned xb_xcc_id() { return (unsigned)__builtin_amdgcn_s_getreg((3 << 11) | 20) & 0xFu; }
#define XB_SPIN(cond, bar) do { unsigned _sp = 0; while (cond) { __builtin_amdgcn_s_sleep(1); \
    if ((++_sp & 255u) == 0u) { if (xb_ld(&(bar)[XB_TMO])) break; if (_sp > XB_SPIN_CAP) { atomicAdd(&(bar)[XB_TMO], 1u); break; } } } } while (0)

struct XcdBarrier {
    unsigned* bar; unsigned x;
    volatile LAS unsigned* st;
};

__device__ __forceinline__ XcdBarrier xcd_barrier_post(unsigned* bar, volatile LAS unsigned* st) {
    XcdBarrier b; b.bar = bar; b.x = xb_xcc_id(); b.st = st;
    if (threadIdx.x == 0) (void)xb_add(&bar[XB_XCNT(b.x)], 1u);
    return b;
}
__device__ __forceinline__ void xcd_barrier_complete(unsigned* bar, unsigned x, unsigned& nloc, unsigned& nx) {
    const unsigned G = gridDim.x * gridDim.y * gridDim.z;
    unsigned sum, cnt, mine, sp = 0u;
    for (;;) {
        sum = 0u; cnt = 0u; mine = 0u;
#pragma unroll
        for (unsigned j = 0; j < 16; ++j) { const unsigned c = xb_ld(&bar[XB_XCNT(j)]); sum += c; cnt += (c > 0u) ? 1u : 0u; mine = (j == x) ? c : mine; }
        if (sum == G) break;
        __builtin_amdgcn_s_sleep(1);
        if ((++sp & 255u) == 0u) { if (xb_ld(&bar[XB_TMO])) break; if (sp > XB_SPIN_CAP) { atomicAdd(&bar[XB_TMO], 1u); break; } }
    }
    nloc = mine > 0u ? mine : 1u; nx = cnt > 0u ? cnt : 1u;
}

__device__ __forceinline__ void xcd_barrier(const XcdBarrier& b) {
    asm volatile("s_waitcnt vmcnt(0)" ::: "memory");
    __syncthreads();
    if (threadIdx.x == 0) {
        unsigned* bar = b.bar;
        __builtin_amdgcn_s_waitcnt(0);
        unsigned nloc = b.st[0], nx = b.st[1];
        if (nloc == 0u) { xcd_barrier_complete(bar, b.x, nloc, nx); b.st[0] = nloc; b.st[1] = nx; }
        const unsigned old = xb_add(&bar[XB_XSUB(b.x)], 1u);
        const unsigned gen = old / nloc;
        if (old + 1u == (gen + 1u) * nloc) {
            __builtin_amdgcn_fence(__ATOMIC_RELEASE, "agent");
            asm volatile("s_waitcnt vmcnt(0)" ::: "memory");
            const unsigned og = xb_add(&bar[XB_TOP], 1u);
            const unsigned tg = og / nx;
            if (og + 1u == (tg + 1u) * nx) xb_add(&bar[XB_TOPGEN], 1u);
            else XB_SPIN(xb_ld(&bar[XB_TOPGEN]) == tg, bar);
            __builtin_amdgcn_fence(__ATOMIC_ACQUIRE, "agent");
            xb_add(&bar[XB_XGEN(b.x)], 1u);
            asm volatile("s_waitcnt vmcnt(0)" ::: "memory");
        } else {
            XB_SPIN(xb_ld(&bar[XB_XGEN(b.x)]) == gen, bar);
            __builtin_amdgcn_fence(__ATOMIC_ACQUIRE, "agent");
            asm volatile("s_waitcnt vmcnt(0)" ::: "memory");
        }
    }
    __syncthreads();
}
constexpr size_t MiB = 1u << 20;
constexpr size_t al_(size_t x) { return (x + MiB - 1) / MiB * MiB; }
constexpr size_t WS_CTL = 0, CTL_ZERO_BYTES = 1 * MiB;
constexpr size_t WS_MOD  = 1 * MiB;
constexpr size_t WS_SP   = WS_MOD + 512 * 1024;
constexpr size_t WS_WIN  = WS_MOD + 1 * MiB;
constexpr size_t WS_WOUT = WS_WIN + al_(2ull * NIN * D * 2);
constexpr size_t WS_WLRU = WS_WOUT + al_(2ull * 4 * D * D * 2);
constexpr size_t WS_WGU  = WS_WLRU + 1 * MiB;
constexpr size_t WS_WD   = WS_WGU + al_(16ull * NGU * D * 2);
constexpr size_t WS_X    = WS_WD + al_(16ull * D * DE * 2);
constexpr size_t WS_FH2  = WS_X + al_((size_t)MTOT * D * 4);
constexpr size_t WS_KF   = WS_FH2 + 2 * MiB;
constexpr size_t WS_TFC  = WS_KF + al_(2ull * 2 * D * 4096 * 8);
constexpr size_t WS_H    = WS_TFC + al_(4ull * D * CTX * 4);
constexpr size_t WS_R    = WS_H + al_((size_t)MTOT * D * 2);
constexpr size_t WS_HYT  = WS_R;
constexpr size_t WS_PR   = WS_HYT + al_((size_t)NHY * MTOT * 2);
constexpr size_t WS_YAT  = WS_PR + al_((size_t)MTOT * NPR * 2);
constexpr size_t WS_YCAT = WS_YAT + al_((size_t)D * MTOT * 2);
constexpr size_t WS_REND = WS_YCAT + al_(3ull * MTOT * D * 2);
constexpr size_t WS_XS   = WS_R;
constexpr size_t WS_HID  = WS_XS + al_((size_t)NE * EROWS * D * 2);
constexpr size_t WS_YS   = WS_HID + al_((size_t)NE * EROWS * DE * 2);
static_assert(WS_YS + (size_t)NE * EROWS * D * 4 <= WS_REND, "MoE overlay fits");
constexpr size_t WS_M32  = WS_REND;
constexpr size_t WS_MB   = WS_M32 + al_((size_t)MTOT * D * 4);
constexpr size_t WS_AFF  = WS_MB + al_((size_t)MTOT * D * 2);
constexpr size_t WS_SELG = WS_AFF + 2 * MiB;
constexpr size_t WS_INV  = WS_SELG + 1 * MiB;
constexpr size_t WS_AGG  = WS_INV + 2 * MiB;
constexpr size_t WS_LAB  = WS_AGG + al_(2ull * NCHUNK * D * 2 * 4);
constexpr size_t WS_END  = WS_LAB + al_(4ull * MTOT * D * 2);
constexpr int CW_BAR = 4096;
constexpr int LDS_BYTES = 147456, MISC_OFF = 147456 - 256;
constexpr int NPHASE = 23;

struct Args { const float* in[35]; float* out; unsigned char* ws; int ph_lo, ph_hi, li, pad; };
struct Frame { LAS unsigned char* lds; int tid, lane, wave, vcu, G; };

__device__ __forceinline__ float wave_sum(float v) {
#pragma unroll
    for (int o = 1; o < 64; o <<= 1) v += __shfl_xor(v, o);
    return v;
}
__device__ __forceinline__ void tr_item(const float* src, size_t ld, bf16* dst, size_t K, LAS float* scr, int lane) {
    f32x4 v[16];
#pragma unroll
    for (int i = 0; i < 16; ++i) v[i] = *(const f32x4*)(src + (size_t)((lane >> 4) + 4 * i) * ld + (lane & 15) * 4);
#pragma unroll
    for (int i = 0; i < 16; ++i) { LAS float* p = scr + ((lane >> 4) + 4 * i) * 65 + (lane & 15) * 4; p[0] = v[i][0]; p[1] = v[i][1]; p[2] = v[i][2]; p[3] = v[i][3]; }
    LDS_WAIT(); asm volatile("" ::: "memory");
    const int c = lane & 7;
#pragma unroll
    for (int j = 0; j < 8; ++j) { const int n = (lane >> 3) + 8 * j; const LAS float* s = scr + (8 * c) * 65 + n;
        v4u o; o.x = pk2(s[0 * 65], s[1 * 65]); o.y = pk2(s[2 * 65], s[3 * 65]); o.z = pk2(s[4 * 65], s[5 * 65]); o.w = pk2(s[6 * 65], s[7 * 65]);
        *(v4u*)(dst + (size_t)n * K + 8 * c) = o; }
    LDS_WAIT(); asm volatile("" ::: "memory");
}
__device__ __forceinline__ int win_src_col(int n0) {
    if (n0 < 3072) return n0;
    const int m = n0 - 3072;
    if (m < 1024) return 3072 + m;
    if (m < 2048) return 4096 + (m - 1024);
    if (m < 3072) return 5120 + (m - 2048);
    if (m < 5120) { const int q = m - 3072, j = q >> 8, r = q & 255; return r < 128 ? 6144 + 128 * j + r : 7168 + 128 * j + (r - 128); }
    return 8192 + (m - 5120);
}

__device__ __forceinline__ void ph_prologue(const Args& a, const Frame& F) {
    const int gw = F.vcu * 8 + F.wave, NGW = F.G * 8, lane = F.lane;
    float* X = (float*)(a.ws + WS_X);
    for (int t = gw; t < SEQ; t += NGW) {
        f32x4 xv[NB][4];
#pragma unroll
        for (int b = 0; b < NB; ++b) { const f32x4* xr = (const f32x4*)(a.in[0] + ((size_t)b * SEQ + t) * D) + lane;
#pragma unroll
            for (int j = 0; j < 4; ++j) xv[b][j] = xr[64 * j]; }
        const int gr = t >> 6, gc = t & 63; f32x4 pe[4];
#pragma unroll
        for (int j = 0; j < 4; ++j)
#pragma unroll
            for (int i = 0; i < 4; ++i) { const int cc = 4 * lane + 256 * j + i; const float pos = (float)(cc < 512 ? gr : gc); const int c2 = cc & 511, idx = c2 & 255;
                const float om = exp2f((float)idx * (-13.287712379549449f / 256.0f)); const float ang = pos * om; pe[j][i] = c2 < 256 ? sinf(ang) : cosf(ang); }
#pragma unroll
        for (int b = 0; b < NB; ++b) { f32x4* xo = (f32x4*)(X + ((size_t)b * SEQ + t) * D) + lane;
#pragma unroll
            for (int j = 0; j < 4; ++j) xo[64 * j] = xv[b][j] + pe[j]; }
    }
    for (int r = gw; r < MCTX; r += NGW) { const f32x4* xr = (const f32x4*)(a.in[2] + (size_t)r * D) + lane; f32x4* xo = (f32x4*)(X + (size_t)(MLAT + r) * D) + lane;
#pragma unroll
        for (int j = 0; j < 4; ++j) xo[64 * j] = xr[64 * j]; }
    {
        LAS float* S = (LAS float*)F.lds;
        LAS float* red = S + 9 * 1024;
        for (int i = F.tid; i < 9 * 1024; i += 512) { const float v = i < 8192 ? a.in[1][i] : a.in[3][i - 8192]; S[i] = v / (1.0f + expf(-v)); }
        __syncthreads();
        float* MOD = (float*)(a.ws + WS_MOD);
        for (int it = F.vcu; it < 2 * 96; it += F.G) {
            const int l = it / 96, cb = it % 96, cj = F.tid & 63, ks = F.tid >> 6;
            const float* w = a.in[4] + (size_t)l * D * 6144 + cb * 64 + cj; float acc[9];
#pragma unroll
            for (int r = 0; r < 9; ++r) acc[r] = 0.f;
            for (int k0 = ks * 128; k0 < ks * 128 + 128; k0 += 32) { float wv[32];
#pragma unroll
                for (int kk = 0; kk < 32; ++kk) wv[kk] = w[(size_t)(k0 + kk) * 6144];
#pragma unroll
                for (int kk = 0; kk < 32; ++kk)
#pragma unroll
                    for (int r = 0; r < 9; ++r) acc[r] += S[r * 1024 + k0 + kk] * wv[kk]; }
#pragma unroll
            for (int r = 0; r < 9; ++r) red[(ks * 9 + r) * 64 + cj] = acc[r];
            __syncthreads();
            for (int o = F.tid; o < 9 * 64; o += 512) { const int r = o >> 6, c2 = o & 63; float s = a.in[5][(size_t)l * 6144 + cb * 64 + c2];
#pragma unroll
                for (int k2 = 0; k2 < 8; ++k2) s += red[(k2 * 9 + r) * 64 + c2];
                MOD[((size_t)l * 9 + r) * 6144 + cb * 64 + c2] = s; }
            __syncthreads();
        }
    }
    {
        LAS float* scr = (LAS float*)(F.lds + F.wave * 16640);
        bf16* WIN = (bf16*)(a.ws + WS_WIN); bf16* WOUT = (bf16*)(a.ws + WS_WOUT);
        constexpr int I_IN = 16 * (NIN / 64), I_OUT = 16 * 16;
        constexpr int NIT = 2 * I_IN + 8 * I_OUT;
        for (int it = gw; it < NIT; it += NGW) {
            if (it < 2 * I_IN) { const int l = it / I_IN, r = it % I_IN, kb = r / (NIN / 64), nb = r % (NIN / 64);
                tr_item(a.in[8] + (size_t)l * D * NIN + (size_t)(64 * kb) * NIN + win_src_col(64 * nb), NIN, WIN + (size_t)l * NIN * D + (size_t)(64 * nb) * D + 64 * kb, D, scr, lane); }
            else { const int r0 = it - 2 * I_IN, mi = r0 / I_OUT, r = r0 % I_OUT, l = mi >> 2, w = mi & 3, kb = r / 16, nb = r % 16;
                tr_item(a.in[26 + w] + (size_t)l * D * D + (size_t)(64 * kb) * D + 64 * nb, D, WOUT + ((size_t)l * 4 + w) * D * D + (size_t)(64 * nb) * D + 64 * kb, D, scr, lane); }
        }
    }
    {
      bf16* WL = (bf16*)(a.ws + WS_WLRU); float* SP = (float*)(a.ws + WS_SP);
      const int gt = F.vcu * 512 + F.tid, NT = F.G * 512;
      for (int i = gt; i < 2 * 16 * 256 * 64; i += NT) { const int k = i & 63, n = (i >> 6) & 255, hd = (i >> 14) & 15, l = i >> 18; const int dir = n >> 7, ax = (n >> 6) & 1, j = n & 63;
          WL[i] = (bf16)f2bf((ax ? a.in[22] : a.in[20])[((((size_t)l * 2 + dir) * 16 + hd) * 64 + k) * 64 + j]); }
      for (int i = gt; i < 4 * D; i += NT) { const float lam = a.in[24][i]; SP[i] = log1pf(expf(-lam)); } }
    __syncthreads();
    {
        LAS float* feats = (LAS float*)F.lds;
        LAS float* h1 = feats + 8 * 36;
        float* FH2 = (float*)(a.ws + WS_FH2);
        for (int it = F.vcu; it < 2 * 288; it += F.G) {
            const int l = it / 288, tb = it % 288, tl = F.tid >> 6, j = F.tid & 63;
            const int tt = tb * 8 + tl; const int L = tt < SEQ ? SEQ : CTX, t = tt < SEQ ? tt : tt - SEQ;
            if (j < 33) { const float wv = (6.283185307179586f / (float)L) * (float)t; float v;
                if (j == 0) v = (float)t / (float)(L - 1);
                else { const int bi = (j - 1) & 15; const float f = 1e-4f + (float)bi * ((15.0f - 1e-4f) / 15.0f); v = j <= 16 ? cosf(f * wv) : -sinf(f * wv); }
                feats[tl * 36 + j] = v; }
            __syncthreads();
            { const float* w1 = a.in[11] + (size_t)l * 33 * 64; float s = a.in[12][l * 64 + j];
              for (int m = 0; m < 33; ++m) s += feats[tl * 36 + m] * w1[m * 64 + j];
              h1[tl * 64 + j] = sinf(a.in[16][l * 64 + j] * s); }
            __syncthreads();
            { const float* w2 = a.in[13] + (size_t)l * 64 * 64; float s = a.in[14][l * 64 + j];
              for (int m = 0; m < 64; ++m) s += h1[tl * 64 + m] * w2[m * 64 + j];
              FH2[((size_t)l * 64 + j) * 2304 + tt] = sinf(a.in[16][l * 64 + j] * s); }
            __syncthreads();
        }
    }
}


#define FFT_HD __device__ __forceinline__
typedef float c2 __attribute__((ext_vector_type(2)));
FFT_HD c2 c2swap(c2 a) { return __builtin_shufflevector(a, a, 1, 0); }
FFT_HD c2 c2mul(c2 a, c2 b) {
    c2 t, d;
    asm("v_pk_mul_f32 %0, %1, %2 op_sel:[0,0] op_sel_hi:[1,0]" : "=&v"(t) : "v"(a), "v"(b));
    asm("v_pk_fma_f32 %0, %1, %2, %3 op_sel:[1,1,0] op_sel_hi:[0,1,1] neg_lo:[0,1,0]" : "=&v"(d) : "v"(a), "v"(b), "v"(t));
    return d;
}
FFT_HD c2 c2mulconj(c2 a, c2 b) {
    c2 t, d;
    asm("v_pk_mul_f32 %0, %1, %2 op_sel:[0,0] op_sel_hi:[1,0] neg_hi:[0,1]" : "=&v"(t) : "v"(a), "v"(b));
    asm("v_pk_fma_f32 %0, %1, %2, %3 op_sel:[1,1,0] op_sel_hi:[0,1,1] neg_lo:[0,1,0] neg_hi:[0,1,0]" : "=&v"(d) : "v"(a), "v"(b), "v"(t));
    return d;
}
FFT_HD c2 c2mulk(c2 a, float br, float bi) { return c2mul(a, (c2){br, bi}); }
FFT_HD c2 c2add_mi(c2 s, c2 t) { c2 d; asm("v_pk_add_f32 %0, %1, %2 op_sel:[0,1] op_sel_hi:[1,0] neg_hi:[0,1]" : "=&v"(d) : "v"(s), "v"(t)); return d; }
FFT_HD c2 c2sub_mi(c2 s, c2 t) { c2 d; asm("v_pk_add_f32 %0, %1, %2 op_sel:[0,1] op_sel_hi:[1,0] neg_lo:[0,1]" : "=&v"(d) : "v"(s), "v"(t)); return d; }
FFT_HD void dft4v(c2& a, c2& b, c2& c, c2& d) {
    const c2 s0 = a + c, s1 = a - c, s2 = b + d, t = b - d;
    a = s0 + s2; c = s0 - s2; b = c2add_mi(s1, t); d = c2sub_mi(s1, t);
}
FFT_HD void dft4v_z(c2& a, c2& b, c2& c, c2& d) {
    const c2 a0 = a, b0 = b; a = a0 + b0; c = a0 - b0; b = c2add_mi(a0, b0); d = c2sub_mi(a0, b0);
}
FFT_HD void dft4v_cr(c2& a, c2& b, c2& c, c2& d) {
    const c2 s0 = c2add_mi(a, c), s1 = c2sub_mi(a, c), s2 = b + d, t = b - d;
    a = s0 + s2; c = s0 - s2; b = c2add_mi(s1, t); d = c2sub_mi(s1, t);
}
#define PERM16(k) ((((k) >> 2) & 3) + 4 * ((k) & 3))
template <bool ZH> FFT_HD void dft16v(c2 (&v)[16]) {
    const float C1 = 0.92387953251128674f, S1 = 0.38268343236508978f, R2 = 0.70710678118654752f;
#pragma unroll
    for (int na = 0; na < 4; ++na) { if (ZH) dft4v_z(v[na], v[na + 4], v[na + 8], v[na + 12]); else dft4v(v[na], v[na + 4], v[na + 8], v[na + 12]); }
    v[5] = c2mulk(v[5], C1, -S1); v[6] = c2mulk(v[6], R2, -R2); v[7] = c2mulk(v[7], S1, -C1);
    v[9] = c2mulk(v[9], R2, -R2);   v[11] = c2mulk(v[11], -R2, -R2);
    v[13] = c2mulk(v[13], S1, -C1); v[14] = c2mulk(v[14], -R2, -R2); v[15] = c2mulk(v[15], -C1, S1);
    dft4v(v[0], v[1], v[2], v[3]); dft4v(v[4], v[5], v[6], v[7]); dft4v_cr(v[8], v[9], v[10], v[11]); dft4v(v[12], v[13], v[14], v[15]);
}

typedef c2 cf2;
__device__ __forceinline__ void fft_twiddles(int tid, LAS cf2* T, c2 (&tw2)[16]) {
    const int tt = tid & 255, n0 = tt & 15, k2 = tt >> 4;
    LAS cf2* scr = T + 256 + tid * 17;
    if (tid < 256) { float s, c; const int m1 = (16 * (tid >> 4) * (tid & 15)) & 4095; sincosf(-6.283185307179586f * (float)m1 * (1.0f / 4096.0f), &s, &c); T[tid] = (cf2){c, s}; }
#pragma unroll 1
    for (int k = 0; k < 16; ++k) { float s, c; const int m2 = (n0 * (k2 + 16 * k)) & 4095; sincosf(-6.283185307179586f * (float)m2 * (1.0f / 4096.0f), &s, &c); scr[k] = (cf2){c, s}; }
    LDS_WAIT(); asm volatile("" ::: "memory");
#pragma unroll
    for (int k = 0; k < 16; ++k) tw2[k] = scr[k];
    __syncthreads();
}
template <bool TABLE2, bool ZH = false> __device__ __forceinline__ void fft4096(c2 (&v)[16], LAS cf2* buf, int tt, const LAS cf2* T, const c2 (&tw2)[16]) {
    dft16v<ZH>(v);
    { const LAS cf2* T1 = T + (tt >> 4) * 16;
#pragma unroll
      for (int k = 0; k < 16; ++k) { c2 a = v[PERM16(k)]; if (k) a = c2mul(a, T1[k]); buf[tt + 272 * k] = a; } }
    __syncthreads();
    const int n0 = tt & 15, k2 = tt >> 4;
#pragma unroll
    for (int n1 = 0; n1 < 16; ++n1) v[n1] = buf[n0 + 16 * n1 + 272 * k2];
    __syncthreads();
    dft16v<false>(v);
    { const LAS cf2* T2 = T + n0 * 16;
#pragma unroll
      for (int k1 = 0; k1 < 16; ++k1) { c2 w = tw2[TABLE2 ? 0 : k1]; if (TABLE2 && k1) w = c2mul(w, T2[k1]); buf[k2 + 16 * k1 + 257 * n0] = c2mul(v[PERM16(k1)], w); } }
    __syncthreads();
#pragma unroll
    for (int m = 0; m < 16; ++m) v[m] = buf[tt + 257 * m];
    __syncthreads();
    dft16v<false>(v);
    { c2 w[16];
#pragma unroll
      for (int k = 0; k < 16; ++k) w[k] = v[PERM16(k)];
#pragma unroll
      for (int k = 0; k < 16; ++k) v[k] = w[k]; }
}

template <int NP> __device__ __forceinline__ void filt_taps4(const float* FH2T, const LAS float* w3s, int p0, float (&d)[NP][4][4]) {
#pragma unroll
    for (int g = 0; g < NP; ++g)
#pragma unroll
        for (int i = 0; i < 4; ++i)
#pragma unroll
            for (int od = 0; od < 4; ++od) d[g][i][od] = 0.f;
#pragma unroll 4
    for (int j = 0; j < 64; ++j) { const f32x4 w = *(const LAS f32x4*)(w3s + j * 4);
#pragma unroll
        for (int g = 0; g < NP; ++g) { const f32x4 h = *(const f32x4*)(FH2T + (size_t)j * 2304 + p0 + 1024 * g);
#pragma unroll
            for (int i = 0; i < 4; ++i)
#pragma unroll
                for (int od = 0; od < 4; ++od) d[g][i][od] += h[i] * w[od]; } }
}
__device__ __forceinline__ void ph_filters(const Args& a, const Frame& F) {
    const int team = F.tid >> 8, tt = F.tid & 255, tw = (F.tid >> 6) & 3;
    LAS cf2* fbuf = (LAS cf2*)F.lds;
    LAS cf2* TW = fbuf + 2 * 4352;
    LAS cf2* zt = TW + 256 + team * 4096;
    LAS float* w3s = (LAS float*)(TW + 256 + 2 * 4096) + team * 256;
    LAS float* red = (LAS float*)(TW + 256 + 2 * 4096) + 512 + team * 16;
    LAS float* cx = (LAS float*)(fbuf + team * 4352);
    c2 tw2[16]; fft_twiddles(F.tid, TW, tw2);
    for (int it = F.vcu; it < 2 * (D / 2); it += F.G) {
        const int l = it / (D / 2), c = 2 * (it % (D / 2)) + team;
        const float* FH2 = (const float*)(a.ws + WS_FH2) + (size_t)l * 64 * 2304;
        __syncthreads();
        { const int od = tt >> 6, j = tt & 63; w3s[j * 4 + od] = a.in[15][((size_t)l * 64 + j) * 4096 + od * 1024 + c]; }
        __syncthreads();
        const float ad = fabsf(-3.0701134573f + (float)c * ((-15.3505672866f + 3.0701134573f) / 1023.0f));
        float s0 = 0.f, s1 = 0.f, c0 = 0.f, c1 = 0.f;
        { float d[2][4][4]; filt_taps4<2>(FH2, w3s, 4 * tt, d);
#pragma unroll
          for (int g = 0; g < 2; ++g)
#pragma unroll
              for (int i = 0; i < 4; ++i) { const int t = 4 * tt + i + 1024 * g; const float win = __expf(-((float)t / (float)(SEQ - 1)) * ad);
                  const float k0 = d[g][i][0] * win, k1 = d[g][i][1] * win, k2 = d[g][i][2] * win, k3 = d[g][i][3] * win;
                  s0 += fabsf(k0) + (t > 0 ? fabsf(k1) : 0.f); s1 += fabsf(k2) + (t > 0 ? fabsf(k3) : 0.f);
                  zt[t] = (cf2){k0, k2}; if (t > 0) zt[4096 - t] = (cf2){k1, k3}; } }
        if (tt == 0) zt[2048] = (cf2){0.f, 0.f};
        if (l == 0 && tt < 64) { float d[1][4][4]; filt_taps4<1>(FH2 + SEQ, w3s, 4 * tt, d);
#pragma unroll
            for (int i = 0; i < 4; ++i) { const int t = 4 * tt + i; const float win = __expf(-((float)t / (float)(CTX - 1)) * ad);
                const float k0 = d[0][i][0] * win, k1 = d[0][i][1] * win, k2 = d[0][i][2] * win, k3 = d[0][i][3] * win;
                cx[t] = k0; cx[256 + t] = k1; cx[512 + t] = k2; cx[768 + t] = k3;
                c0 += fabsf(k0) + (t > 0 ? fabsf(k1) : 0.f); c1 += fabsf(k2) + (t > 0 ? fabsf(k3) : 0.f); } }
        s0 = wave_sum(s0); s1 = wave_sum(s1); c0 = wave_sum(c0); c1 = wave_sum(c1);
        if (F.lane == 0) { red[tw * 4] = s0; red[tw * 4 + 1] = s1; red[tw * 4 + 2] = c0; red[tw * 4 + 3] = c1; }
        __syncthreads();
        const float i0 = 1.0f / ((red[0] + red[4]) + (red[8] + red[12])), i1 = 1.0f / ((red[1] + red[5]) + (red[9] + red[13]));
        if (l == 0) { const float j0 = 1.0f / ((red[2] + red[6]) + (red[10] + red[14])), j1 = 1.0f / ((red[3] + red[7]) + (red[11] + red[15]));
            float* TF = (float*)(a.ws + WS_TFC);
#pragma unroll
            for (int od = 0; od < 4; ++od) TF[((size_t)od * D + c) * CTX + tt] = cx[od * 256 + tt] * (od < 2 ? j0 : j1); }
        c2 v[16];
#pragma unroll
        for (int j = 0; j < 16; ++j) { const cf2 r = zt[tt + 256 * j]; v[j] = (c2){r.x * i0, r.y * i1}; }
        __syncthreads();
        fft4096<true>(v, fbuf + team * 4352, tt, TW, tw2);
#pragma unroll
        for (int j = 0; j < 16; ++j) zt[tt + 256 * j] = v[j];
        __syncthreads();
        { cf2* K0 = (cf2*)(a.ws + WS_KF) + (((size_t)l * 2 + 0) * D + c) * 4096; cf2* K1 = (cf2*)(a.ws + WS_KF) + (((size_t)l * 2 + 1) * D + c) * 4096;
          const float sc = 0.5f / 4096.0f;
#pragma unroll
          for (int j = 0; j < 16; ++j) { const int f = tt + 256 * j; const cf2 zb = zt[(4096 - f) & 4095]; const float ar = v[j].x, ai = v[j].y, br = zb.x, bi = zb.y;
              K0[f] = (cf2){(ar + br) * sc, (ai - bi) * sc}; K1[f] = (cf2){(ai + bi) * sc, -(ar - br) * sc}; } }
    }
}

constexpr int NITW = NE * ((D / 128) * (NGU / 32) + (DE / 128) * (D / 32));
__device__ __forceinline__ void wx_load(const Args& a, int l, int it, int lane, f32x4 (&v)[16], unsigned char*& dst, size_t& K) {
    constexpr int I_GU = (D / 128) * (NGU / 32), I_D = (DE / 128) * (D / 32);
    unsigned char* WGU = a.ws + WS_WGU + (size_t)l * NE * NGU * D; unsigned char* WD = a.ws + WS_WD + (size_t)l * NE * D * DE;
    const float* src; size_t ld;
    if (it < NE * I_GU) { const int e = it / I_GU, r = it % I_GU, kb = r / (NGU / 32), nb = r % (NGU / 32); const int n0 = 32 * nb, jt = n0 >> 8, rr = n0 & 255;
        src = (rr < 128 ? a.in[31] : a.in[32]) + ((size_t)l * NE + e) * D * DE + (size_t)(128 * kb) * DE + 128 * jt + (rr & 127); ld = DE;
        dst = WGU + (size_t)e * NGU * D + (size_t)n0 * D + 128 * kb; K = D; }
    else { const int r0 = it - NE * I_GU, e = r0 / I_D, r = r0 % I_D, kb = r / (D / 32), nb = r % (D / 32);
        src = a.in[33] + ((size_t)l * NE + e) * DE * D + (size_t)(128 * kb) * D + 32 * nb; ld = D;
        dst = WD + (size_t)e * D * DE + (size_t)(32 * nb) * DE + 128 * kb; K = DE; }
    const float* p = src + (size_t)(16 * (lane >> 3)) * ld + (lane & 7) * 4;
#pragma unroll
    for (int i = 0; i < 16; ++i) v[i] = *(const f32x4*)(p + (size_t)i * ld);
}
__device__ __forceinline__ void wx_store(const f32x4 (&v)[16], unsigned char* dst, size_t K, int lane) {
    unsigned char* q = dst + (size_t)(4 * (lane & 7)) * K + 16 * (lane >> 3);
#pragma unroll
    for (int j = 0; j < 4; ++j) { v4u o;
        o.x = pk4_fp8(v[0][j] * 32.f, v[1][j] * 32.f, v[2][j] * 32.f, v[3][j] * 32.f); o.y = pk4_fp8(v[4][j] * 32.f, v[5][j] * 32.f, v[6][j] * 32.f, v[7][j] * 32.f);
        o.z = pk4_fp8(v[8][j] * 32.f, v[9][j] * 32.f, v[10][j] * 32.f, v[11][j] * 32.f); o.w = pk4_fp8(v[12][j] * 32.f, v[13][j] * 32.f, v[14][j] * 32.f, v[15][j] * 32.f);
        *(v4u*)(q + (size_t)j * K) = o; }
}

template <int MODE, bool COMB> __device__ __forceinline__ void ph_norm(const Args& a, const Frame& F, int l) {
    const int gw = F.vcu * 8 + F.wave, NGW = F.G * 8, lane = F.lane;
    float* X = (float*)(a.ws + WS_X); bf16* H = (bf16*)(a.ws + WS_H);
    const float* MOD = (const float*)(a.ws + WS_MOD);
    LAS float* WRt = (LAS float*)F.lds;
    if (MODE == 1) { const float* wr = a.in[30] + (size_t)l * D * NE; for (int i = F.tid; i < D * NE; i += 512) WRt[(i & 15) * 1024 + (i >> 4)] = wr[i]; __syncthreads(); }
    const float* g = MODE == 0 ? a.in[6] + l * D : (MODE == 1 ? a.in[7] + l * D : a.in[34]);
    const int nrows = MODE == 2 ? MLAT : MTOT;
    for (int rowA = gw; rowA < nrows; rowA += 2 * NGW) {
        const int nr = rowA + NGW < nrows ? 2 : 1;
        f32x4 v[2][4]; int myinv[2] = {-1, -1};
#pragma unroll
        for (int h = 0; h < 2; ++h) if (h < nr) { const int row = rowA + h * NGW; const f32x4* xr = (const f32x4*)(X + (size_t)row * D) + lane;
#pragma unroll
            for (int j = 0; j < 4; ++j) v[h][j] = xr[64 * j];
            if (COMB) myinv[h] = ((const int*)(a.ws + WS_INV))[(size_t)row * NE + (lane & 15)]; }
        if (COMB) {
            const int lp = MODE == 2 ? 1 : l - 1;
            const float* SELG = (const float*)(a.ws + WS_SELG); const bf16* YS = (const bf16*)(a.ws + WS_YS);
#pragma unroll
            for (int h = 0; h < 2; ++h) if (h < nr) { const int row = rowA + h * NGW, r = row < MLAT ? (row >> 11) : 8;
                unsigned m = (unsigned)(__ballot(myinv[h] >= 0) & 0xFFFFull);
                f32x4 acc[4];
#pragma unroll
                for (int j = 0; j < 4; ++j) acc[j] = (f32x4){0.f, 0.f, 0.f, 0.f};
                while (m) {
                    int ee[4], ss[4]; float gt[4]; v2u y[4][4];
#pragma unroll
                    for (int k = 0; k < 4; ++k) { ee[k] = m ? __builtin_ctz(m) : -1; if (m) m &= m - 1; ss[k] = ee[k] >= 0 ? __shfl(myinv[h], ee[k] < 0 ? 0 : ee[k]) : 0; }
#pragma unroll
                    for (int k = 0; k < 4; ++k) { const int e = ee[k] < 0 ? 0 : ee[k]; gt[k] = ee[k] >= 0 ? SELG[e * EROWS + ss[k]] : 0.f; const v2u* yr = (const v2u*)(YS + ((size_t)e * EROWS + ss[k]) * D) + lane;
#pragma unroll
                        for (int j = 0; j < 4; ++j) y[k][j] = yr[64 * j]; }
#pragma unroll
                    for (int k = 0; k < 4; ++k)
#pragma unroll
                        for (int j = 0; j < 4; ++j) acc[j] += gt[k] * (f32x4){bflo(y[k][j].x), bfhi(y[k][j].x), bflo(y[k][j].y), bfhi(y[k][j].y)};
                }
                const f32x4* m5 = (const f32x4*)(MOD + ((size_t)lp * 9 + r) * 6144 + 5 * 1024) + lane;
#pragma unroll
                for (int j = 0; j < 4; ++j) v[h][j] += m5[64 * j] * acc[j];
                if (MODE != 2) { f32x4* xw = (f32x4*)(X + (size_t)row * D) + lane;
#pragma unroll
                    for (int j = 0; j < 4; ++j) xw[64 * j] = v[h][j]; } }
        }
#pragma unroll
        for (int h = 0; h < 2; ++h) if (h < nr) { const int row = rowA + h * NGW, r = row < MLAT ? (row >> 11) : 8;
            float ss = 0.f;
#pragma unroll
            for (int j = 0; j < 4; ++j) ss += (v[h][j][0] * v[h][j][0] + v[h][j][1] * v[h][j][1]) + (v[h][j][2] * v[h][j][2] + v[h][j][3] * v[h][j][3]);
            const float rstd = 1.0f / sqrtf(wave_sum(ss) * (1.0f / D) + 1e-6f);
            const f32x4* gp = (const f32x4*)g + lane;
            if (MODE == 2) { f32x4* o = (f32x4*)(a.out + (size_t)row * D) + lane;
#pragma unroll
                for (int j = 0; j < 4; ++j) o[64 * j] = v[h][j] * rstd * gp[64 * j];
            } else {
                const float* mrow = MOD + ((size_t)l * 9 + r) * 6144 + (MODE == 0 ? 0 : 3 * 1024);
                const f32x4* sh = (const f32x4*)mrow + lane; const f32x4* sc = (const f32x4*)(mrow + 1024) + lane;
                v2u* o8 = (v2u*)(H + (size_t)row * D) + lane;
#pragma unroll
                for (int j = 0; j < 4; ++j) { v[h][j] = (v[h][j] * rstd * gp[64 * j]) * (1.0f + sc[64 * j]) + sh[64 * j]; v2u w; w.x = pk2(v[h][j][0], v[h][j][1]); w.y = pk2(v[h][j][2], v[h][j][3]); o8[64 * j] = w; }
                if (MODE == 1) {
                    float p[16];
#pragma unroll
                    for (int e = 0; e < NE; ++e) { float s = 0.f;
#pragma unroll
                        for (int j = 0; j < 4; ++j) { const f32x4 w = *(const LAS f32x4*)(WRt + e * 1024 + 4 * lane + 256 * j); s += (v[h][j][0] * w[0] + v[h][j][1] * w[1]) + (v[h][j][2] * w[2] + v[h][j][3] * w[3]); }
                        p[e] = s; if (e & 1) asm volatile("" ::: "memory"); }
#pragma unroll
                    for (int i = 0; i < 8; ++i) { const bool up = lane & 32; const float keep = up ? p[i + 8] : p[i], send = up ? p[i] : p[i + 8]; p[i] = keep + __shfl_xor(send, 32); }
#pragma unroll
                    for (int i = 0; i < 4; ++i) { const bool up = lane & 16; const float keep = up ? p[i + 4] : p[i], send = up ? p[i] : p[i + 4]; p[i] = keep + __shfl_xor(send, 16); }
#pragma unroll
                    for (int i = 0; i < 2; ++i) { const bool up = lane & 8; const float keep = up ? p[i + 2] : p[i], send = up ? p[i] : p[i + 2]; p[i] = keep + __shfl_xor(send, 8); }
                    { const bool up = lane & 4; const float keep = up ? p[1] : p[0], send = up ? p[0] : p[1]; p[0] = keep + __shfl_xor(send, 4); }
                    float mine = p[0]; mine += __shfl_xor(mine, 1); mine += __shfl_xor(mine, 2);
                    float mx = mine;
#pragma unroll
                    for (int o = 4; o < 64; o <<= 1) mx = fmaxf(mx, __shfl_xor(mx, o));
                    const float pe = expf(mine - mx); float den = pe;
#pragma unroll
                    for (int o = 4; o < 64; o <<= 1) den += __shfl_xor(den, o);
                    if ((lane & 3) == 0) ((float*)(a.ws + WS_AFF))[(size_t)row * NE + (lane >> 2)] = pe / den;
                }
            }
        }
    }
}

__device__ __forceinline__ void ph_rank(const Args& a, const Frame& F, int l) {
    LAS unsigned* part = (LAS unsigned*)F.lds;
    const float* AFF = (const float*)(a.ws + WS_AFF); float* SELG = (float*)(a.ws + WS_SELG); int* INV = (int*)(a.ws + WS_INV);
    const bf16* H = (const bf16*)(a.ws + WS_H); unsigned char* XS = a.ws + WS_XS;
    const int tid = F.tid, lane = F.lane, wave = F.wave;
    const unsigned long long ltmask = (1ull << lane) - 1ull;
    const int nitems = 128 + (l == 0 ? 128 : 0);
    for (int it = F.vcu; it < nitems; it += F.G) {
        const bool isctx = it >= 128; const int r = it & 127, e = r & 15, b = r >> 4;
        const int n = isctx ? CTX : SEQ, cap = isctx ? 32 : 256, row0 = isctx ? MLAT + b * CTX : b * SEQ, slot0 = isctx ? 2048 + b * 32 : b * 256;
        unsigned k[4];
#pragma unroll
        for (int q = 0; q < 4; ++q) { const int j = 4 * tid + q; k[q] = j < n ? __builtin_bit_cast(unsigned, AFF[(size_t)(row0 + j) * NE + e]) : 0u; }
        __syncthreads();
        unsigned prefix = 0u;
#pragma unroll 1
        for (int bit = 28; bit >= 0; bit -= 2) {
            const unsigned c1 = prefix | (1u << bit), c2 = prefix | (2u << bit), c3 = prefix | (3u << bit);
            unsigned n1 = 0, n2 = 0, n3 = 0;
#pragma unroll
            for (int q = 0; q < 4; ++q) { n1 += __popcll(__ballot(k[q] >= c1)); n2 += __popcll(__ballot(k[q] >= c2)); n3 += __popcll(__ballot(k[q] >= c3)); }
            LAS unsigned* pb = part + ((bit >> 1) & 1) * 24;
            if (lane == 0) { pb[wave] = n1; pb[8 + wave] = n2; pb[16 + wave] = n3; }
            __syncthreads();
            const v4u a0 = *(const LAS v4u*)pb, a1 = *(const LAS v4u*)(pb + 4), b0 = *(const LAS v4u*)(pb + 8), b1 = *(const LAS v4u*)(pb + 12), d0 = *(const LAS v4u*)(pb + 16), d1 = *(const LAS v4u*)(pb + 20);
            const unsigned t1 = ((a0.x + a0.y) + (a0.z + a0.w)) + ((a1.x + a1.y) + (a1.z + a1.w)), t2 = ((b0.x + b0.y) + (b0.z + b0.w)) + ((b1.x + b1.y) + (b1.z + b1.w)),
                           t3 = ((d0.x + d0.y) + (d0.z + d0.w)) + ((d1.x + d1.y) + (d1.z + d1.w));
            if ((int)t3 >= cap) prefix = c3; else if ((int)t2 >= cap) prefix = c2; else if ((int)t1 >= cap) prefix = c1;
        }
        const unsigned T = prefix;
        __syncthreads();
        { const unsigned c = __popcll(__ballot(k[0] > T)) + __popcll(__ballot(k[1] > T)) + __popcll(__ballot(k[2] > T)) + __popcll(__ballot(k[3] > T));
          if (lane == 0) part[wave] = c; }
        unsigned long long be[4]; unsigned weq = 0;
#pragma unroll
        for (int q = 0; q < 4; ++q) { be[q] = __ballot(k[q] == T); weq += __popcll(be[q]); }
        if (lane == 0) part[16 + wave] = weq;
        __syncthreads();
        unsigned ngt = 0, eqbase = 0;
#pragma unroll
        for (int w = 0; w < 8; ++w) { ngt += part[w]; if (w < wave) eqbase += part[16 + w]; }
        const int need = cap - (int)ngt;
        unsigned eqrank = eqbase + __popcll(be[0] & ltmask) + __popcll(be[1] & ltmask) + __popcll(be[2] & ltmask) + __popcll(be[3] & ltmask);
        bool sel[4];
#pragma unroll
        for (int q = 0; q < 4; ++q) { const bool eq = k[q] == T; sel[q] = k[q] > T || (eq && (int)eqrank < need); eqrank += eq ? 1u : 0u; }
        __syncthreads();
        unsigned long long bs[4]; unsigned wsel = 0;
#pragma unroll
        for (int q = 0; q < 4; ++q) { bs[q] = __ballot(sel[q]); wsel += __popcll(bs[q]); }
        if (lane == 0) part[wave] = wsel;
        __syncthreads();
        unsigned sbase = 0;
#pragma unroll
        for (int w = 0; w < 8; ++w) if (w < wave) sbase += part[w];
        unsigned srank = sbase + __popcll(bs[0] & ltmask) + __popcll(bs[1] & ltmask) + __popcll(bs[2] & ltmask) + __popcll(bs[3] & ltmask);
        int slot[4];
#pragma unroll
        for (int q = 0; q < 4; ++q) { const int j = 4 * tid + q; slot[q] = -1;
            if (sel[q]) { slot[q] = slot0 + (int)srank; ++srank; SELG[e * EROWS + slot[q]] = __builtin_bit_cast(float, k[q]); }
            if (j < n) INV[(size_t)(row0 + j) * NE + e] = slot[q]; }
        { LAS int* lst = (LAS int*)(part + 64) + wave * 512;
          unsigned wr_ = __popcll(bs[0] & ltmask) + __popcll(bs[1] & ltmask) + __popcll(bs[2] & ltmask) + __popcll(bs[3] & ltmask);
#pragma unroll
          for (int q = 0; q < 4; ++q) if (sel[q]) { lst[2 * wr_] = row0 + 4 * tid + q; lst[2 * wr_ + 1] = slot[q]; ++wr_; }
          LDS_WAIT(); asm volatile("" ::: "memory");
          const int nsel = (int)wsel;
          for (int i0 = 0; i0 < nsel; i0 += 4) { v4u r0[4], r1[4]; int sl[4];
#pragma unroll
              for (int k = 0; k < 4; ++k) { const int i = i0 + k < nsel ? i0 + k : nsel - 1; const int rw = lst[2 * i]; sl[k] = lst[2 * i + 1];
                  const v4u* hp = (const v4u*)(H + (size_t)rw * D) + lane; r0[k] = hp[0]; r1[k] = hp[64]; }
#pragma unroll
              for (int k = 0; k < 4; ++k) { v2u* xp = (v2u*)(XS + ((size_t)e * EROWS + sl[k]) * D) + lane;
                  v2u w0, w1; w0.x = pk4_fp8(bflo(r0[k].x), bfhi(r0[k].x), bflo(r0[k].y), bfhi(r0[k].y)); w0.y = pk4_fp8(bflo(r0[k].z), bfhi(r0[k].z), bflo(r0[k].w), bfhi(r0[k].w));
                  w1.x = pk4_fp8(bflo(r1[k].x), bfhi(r1[k].x), bflo(r1[k].y), bfhi(r1[k].y)); w1.y = pk4_fp8(bflo(r1[k].z), bfhi(r1[k].z), bflo(r1[k].w), bfhi(r1[k].w));
                  xp[0] = w0; xp[64] = w1; } }
        }
        __syncthreads();
    }
}
__device__ __forceinline__ float conv3_at(const bf16* rowp, int t, int L, float w0, float w1, float w2, float bias) {
    const int tm = t > 0 ? t - 1 : 0, tp = t < L - 1 ? t + 1 : L - 1;
    const float vm = bf2f(rowp[tm]), x0 = bf2f(rowp[t]), vp = bf2f(rowp[tp]);
    const float xm = t > 0 ? vm : 0.f, xp = t < L - 1 ? vp : 0.f;
    return w0 * xm + w1 * x0 + w2 * xp + bias;
}
template <int L> __device__ __forceinline__ void hyena_direct_item(const Args& a, const Frame& F, int l, int c) {
    constexpr int NBQ = L == SEQ ? 4 : 8, NPASS = NB / NBQ, TP = L >= 512 ? L / 512 : 1, BP = NBQ * L / 512 / TP;
    constexpr int ROW0 = L == SEQ ? 0 : MLAT;
    LAS float* kk = (LAS float*)F.lds;
    LAS float* ub = kk + 2 * L;
    LAS float* zb = ub + NBQ * L;
    const bf16* HYT = (const bf16*)(a.ws + WS_HYT); bf16* YAT = (bf16*)(a.ws + WS_YAT);
    const float* TF = (const float*)(a.ws + WS_TFC);
    const float* cw = a.in[9] + (size_t)l * 3 * NHY; const float* cb = a.in[10] + (size_t)l * NHY;
    float w[3][3], bs[3];
#pragma unroll
    for (int s = 0; s < 3; ++s) { bs[s] = cb[s * D + c];
#pragma unroll
        for (int k = 0; k < 3; ++k) w[s][k] = cw[k * NHY + s * D + c]; }
    const float hb0 = a.in[17][((size_t)l * 2 + 0) * D + c], hb1 = a.in[17][((size_t)l * 2 + 1) * D + c];
    int tq[TP], bq[BP];
#pragma unroll
    for (int i = 0; i < TP; ++i) tq[i] = L >= 512 ? F.tid + 512 * i : (F.tid & (L - 1));
#pragma unroll
    for (int i = 0; i < BP; ++i) bq[i] = L >= 512 ? i : (F.tid / L) + (512 / L) * i;
    for (int ps = 0; ps < NPASS; ++ps) {
        for (int i = F.tid; i < NBQ * L; i += 512) { const int b = i / L, t = i % L; const bf16* rp = HYT + (size_t)(2 * D + c) * MTOT + ROW0 + (ps * NBQ + b) * L;
            ub[i] = conv3_at(rp, t, L, w[2][0], w[2][1], w[2][2], bs[2]); }
#pragma unroll 1
        for (int o = 0; o < 2; ++o) {
            __syncthreads();
            for (int t = F.tid; t < L; t += 512) { kk[L - 1 + t] = TF[((size_t)(o * 2 + 0) * D + c) * L + t]; if (t > 0) kk[L - 1 - t] = TF[((size_t)(o * 2 + 1) * D + c) * L + t]; }
            __syncthreads();
            const LAS float* src = o == 0 ? ub : zb;
            float acc[TP][BP];
#pragma unroll
            for (int i = 0; i < TP; ++i)
#pragma unroll
                for (int j = 0; j < BP; ++j) acc[i][j] = 0.f;
            for (int s = 0; s < L; ++s) { float kv[TP], uv[BP];
#pragma unroll
                for (int i = 0; i < TP; ++i) kv[i] = kk[tq[i] - s + L - 1];
#pragma unroll
                for (int j = 0; j < BP; ++j) uv[j] = src[bq[j] * L + s];
#pragma unroll
                for (int i = 0; i < TP; ++i)
#pragma unroll
                    for (int j = 0; j < BP; ++j) acc[i][j] += kv[i] * uv[j]; }
            __syncthreads();
#pragma unroll
            for (int i = 0; i < TP; ++i)
#pragma unroll
                for (int j = 0; j < BP; ++j) { const int t = tq[i], b = bq[j]; const int gb = ps * NBQ + b;
                    const bf16* rp = HYT + (size_t)(o * D + c) * MTOT + ROW0 + gb * L;
                    const float xg = o == 0 ? conv3_at(rp, t, L, w[0][0], w[0][1], w[0][2], bs[0]) : conv3_at(rp, t, L, w[1][0], w[1][1], w[1][2], bs[1]);
                    const float uin = src[b * L + t];
                    const float r = xg * (acc[i][j] + uin * (o == 0 ? hb0 : hb1));
                    if (o == 0) zb[b * L + t] = r; else YAT[(size_t)c * MTOT + ROW0 + gb * L + t] = (bf16)f2bf(r); }
        }
        __syncthreads();
    }
}

__device__ __forceinline__ void read8_lds(const LAS unsigned short* row, int tt, float (&o)[8]) {
#pragma unroll
    for (int j = 0; j < 8; ++j) o[j] = bf2f(row[tt + 256 * j]);
}
__device__ __forceinline__ void hy_load_rows(const bf16* HYT, int c, int p, int tt, v4u (&pre)[6], unsigned (&lf)[6], unsigned (&rg)[6]) {
#pragma unroll
    for (int r = 0; r < 6; ++r) { const int f = (r < 2 ? 2 * D : (r < 4 ? 0 : D)) + c, bb = 2 * p + (r & 1); const bf16* rp = HYT + (size_t)f * MTOT + bb * SEQ;
        pre[r] = *(const v4u*)(rp + tt * 8);
        lf[r] = rp[tt > 0 ? 8 * tt - 1 : 0]; rg[r] = rp[tt < 255 ? 8 * tt + 8 : SEQ - 1]; }
}
__device__ __forceinline__ v4u hy_conv_vec(v4u x, unsigned lf, unsigned rg, int tt, float w0, float w1, float w2, float bias) {
    float e[10]; e[0] = tt > 0 ? bf2f((unsigned short)lf) : 0.f; e[1] = bflo(x.x); e[2] = bfhi(x.x); e[3] = bflo(x.y); e[4] = bfhi(x.y); e[5] = bflo(x.z); e[6] = bfhi(x.z); e[7] = bflo(x.w); e[8] = bfhi(x.w);
    e[9] = tt < 255 ? bf2f((unsigned short)rg) : 0.f;
    float y[8];
#pragma unroll
    for (int i = 0; i < 8; ++i) y[i] = w0 * e[i] + w1 * e[i + 1] + w2 * e[i + 2] + bias;
    v4u o; o.x = pg8::cvt_pk_bf16(y[0], y[1]); o.y = pg8::cvt_pk_bf16(y[2], y[3]); o.z = pg8::cvt_pk_bf16(y[4], y[5]); o.w = pg8::cvt_pk_bf16(y[6], y[7]); return o;
}
__device__ __forceinline__ void ph_hyena_fft(const Args& a, const Frame& F, int l) {
    const int team = F.tid >> 8, tt = F.tid & 255;
    LAS cf2* buf = (LAS cf2*)F.lds + team * 4352;
    LAS cf2* tw1 = (LAS cf2*)F.lds + 2 * 4352;
    LAS unsigned short* stage = (LAS unsigned short*)(tw1 + 256) + team * 6 * SEQ;
    c2 tw2[16]; fft_twiddles(F.tid, tw1, tw2);
    const bf16* HYT = (const bf16*)(a.ws + WS_HYT); bf16* YAT = (bf16*)(a.ws + WS_YAT);
    const float* cwb = a.in[9] + (size_t)l * 3 * NHY; const float* cbb = a.in[10] + (size_t)l * NHY;
    v4u pre[6]; unsigned lf[6], rg[6];
    if (F.vcu < D) hy_load_rows(HYT, F.vcu, team, tt, pre, lf, rg);
    for (int c = F.vcu; c < D; c += F.G) {
        const float* cw = cwb + c; const float* cb = cbb + c;
        float w[3][3], bs[3];
#pragma unroll
        for (int s = 0; s < 3; ++s) { bs[s] = cb[s * D];
#pragma unroll
            for (int k = 0; k < 3; ++k) w[s][k] = cw[k * NHY + s * D]; }
        const float hb0 = a.in[17][((size_t)l * 2 + 0) * D + c], hb1 = a.in[17][((size_t)l * 2 + 1) * D + c];
#pragma unroll 1
        for (int pp = 0; pp < 2; ++pp) {
            const int b0 = 2 * (team + 2 * pp), b1 = b0 + 1;
            __syncthreads();
#pragma unroll
            for (int r = 0; r < 6; ++r) { const int s = r < 2 ? 2 : (r < 4 ? 0 : 1);
                *(LAS v4u*)(stage + r * SEQ + tt * 8) = hy_conv_vec(pre[r], lf[r], rg[r], tt, w[s][0], w[s][1], w[s][2], bs[s]); }
            { const int cn = pp == 0 ? c : c + F.G, pn = team + 2 * (pp ^ 1); if (cn < D) hy_load_rows(HYT, cn, pn, tt, pre, lf, rg); }
            __syncthreads();
            float u0[8], u1[8];
            read8_lds(stage + 0 * SEQ, tt, u0); read8_lds(stage + 1 * SEQ, tt, u1);
#pragma unroll 1
            for (int o = 0; o < 2; ++o) {
                cf2 kk[16];
                { const cf2* K = (const cf2*)(a.ws + WS_KF) + (((size_t)l * 2 + o) * D + c) * 4096 + tt;
#pragma unroll
                  for (int k = 0; k < 16; ++k) kk[k] = K[256 * k]; }
                const float hb = o == 0 ? hb0 : hb1;
                c2 v[16];
#pragma unroll
                for (int j = 0; j < 8; ++j) v[j] = (c2){u0[j], u1[j]};
                fft4096<false, true>(v, buf, tt, tw1, tw2);
#pragma unroll
                for (int k = 0; k < 16; ++k) v[k] = c2mulconj(v[k], kk[k]);
                fft4096<false>(v, buf, tt, tw1, tw2);
                float g0[8], g1[8];
                read8_lds(stage + (2 + 2 * o) * SEQ, tt, g0); read8_lds(stage + (3 + 2 * o) * SEQ, tt, g1);
#pragma unroll
                for (int j = 0; j < 8; ++j) { u0[j] = g0[j] * (v[j].x + u0[j] * hb); u1[j] = g1[j] * (-v[j].y + u1[j] * hb); }
            }
            bf16* o0 = YAT + (size_t)c * MTOT + b0 * SEQ + tt; bf16* o1 = YAT + (size_t)c * MTOT + b1 * SEQ + tt;
#pragma unroll
            for (int j = 0; j < 8; ++j) { o0[256 * j] = (bf16)f2bf(u0[j]); o1[256 * j] = (bf16)f2bf(u1[j]); }
        }
    }
    __syncthreads();
}

__device__ __forceinline__ void ph_hyena_ctx(const Args& a, const Frame& F, int l) {
    typedef float f32x2_ __attribute__((ext_vector_type(2)));
    const int team = F.tid >> 8, t = F.tid & 255;
    LAS float* kk = (LAS float*)F.lds + team * 4608;
    LAS float* ub = kk + 512;
    LAS float* zb = ub + 2048;
    const bf16* HYT = (const bf16*)(a.ws + WS_HYT); bf16* YAT = (bf16*)(a.ws + WS_YAT); const float* TF = (const float*)(a.ws + WS_TFC);
    const float* cwb = a.in[9] + (size_t)l * 3 * NHY; const float* cbb = a.in[10] + (size_t)l * NHY;
    for (int it = F.vcu; it < D / 2; it += F.G) {
        const int c = 2 * it + team; const float* cw = cwb + c; const float* cb = cbb + c;
        __syncthreads();
        { const float w0 = cw[2 * D], w1 = cw[NHY + 2 * D], w2 = cw[2 * NHY + 2 * D], bb = cb[2 * D];
          float uu[NB];
#pragma unroll
          for (int b = 0; b < NB; ++b) uu[b] = conv3_at(HYT + (size_t)(2 * D + c) * MTOT + MLAT + b * CTX, t, CTX, w0, w1, w2, bb);
          *(LAS f32x4*)(ub + t * 8) = (f32x4){uu[0], uu[1], uu[2], uu[3]}; *(LAS f32x4*)(ub + t * 8 + 4) = (f32x4){uu[4], uu[5], uu[6], uu[7]}; }
#pragma unroll 1
        for (int o = 0; o < 2; ++o) {
            kk[255 + t] = TF[((size_t)(o * 2 + 0) * D + c) * CTX + t]; if (t > 0) kk[255 - t] = TF[((size_t)(o * 2 + 1) * D + c) * CTX + t];
            const float hb = a.in[17][((size_t)l * 2 + o) * D + c];
            const float w0 = cw[o * D], w1 = cw[NHY + o * D], w2 = cw[2 * NHY + o * D], bb = cb[o * D];
            float xg[NB];
#pragma unroll
            for (int b = 0; b < NB; ++b) xg[b] = conv3_at(HYT + (size_t)(o * D + c) * MTOT + MLAT + b * CTX, t, CTX, w0, w1, w2, bb);
            __syncthreads();
            const LAS float* src = o == 0 ? ub : zb;
            f32x2_ acc[4] = {{0.f, 0.f}, {0.f, 0.f}, {0.f, 0.f}, {0.f, 0.f}};
#pragma unroll 4
            for (int s = 0; s < CTX; ++s) { const float k0 = kk[t + 255 - s]; const f32x2_ kv = {k0, k0};
                const f32x4 ua = *(const LAS f32x4*)(src + s * 8), uc = *(const LAS f32x4*)(src + s * 8 + 4);
                acc[0] += kv * (f32x2_){ua[0], ua[1]}; acc[1] += kv * (f32x2_){ua[2], ua[3]}; acc[2] += kv * (f32x2_){uc[0], uc[1]}; acc[3] += kv * (f32x2_){uc[2], uc[3]}; }
            const f32x4 sa = *(const LAS f32x4*)(src + t * 8), sb = *(const LAS f32x4*)(src + t * 8 + 4);
            float r[NB];
            r[0] = xg[0] * (acc[0][0] + sa[0] * hb); r[1] = xg[1] * (acc[0][1] + sa[1] * hb); r[2] = xg[2] * (acc[1][0] + sa[2] * hb); r[3] = xg[3] * (acc[1][1] + sa[3] * hb);
            r[4] = xg[4] * (acc[2][0] + sb[0] * hb); r[5] = xg[5] * (acc[2][1] + sb[1] * hb); r[6] = xg[6] * (acc[3][0] + sb[2] * hb); r[7] = xg[7] * (acc[3][1] + sb[3] * hb);
            __syncthreads();
            if (o == 0) { *(LAS f32x4*)(zb + t * 8) = (f32x4){r[0], r[1], r[2], r[3]}; *(LAS f32x4*)(zb + t * 8 + 4) = (f32x4){r[4], r[5], r[6], r[7]}; }
            else {
#pragma unroll
                for (int b = 0; b < NB; ++b) YAT[(size_t)c * MTOT + MLAT + b * CTX + t] = (bf16)f2bf(r[b]); }
        }
    }
    __syncthreads();
}

__device__ __forceinline__ void ph_sc(const Args& a, const Frame& F, int l, int nrows) {
    const int gw = F.vcu * 8 + F.wave, NGW = F.G * 8, lane = F.lane;
    const bf16* PR = (const bf16*)(a.ws + WS_PR); bf16* YC = (bf16*)(a.ws + WS_YCAT) + 2ull * MTOT * D;
    const float* cw = a.in[25] + (size_t)l * 3 * D;
    float w[3][16];
#pragma unroll
    for (int k = 0; k < 3; ++k)
#pragma unroll
        for (int j = 0; j < 16; ++j) w[k][j] = cw[k * D + lane * 16 + j];
    for (int row = gw; row < nrows; row += NGW) {
        const int L = row < MLAT ? SEQ : CTX, t = row < MLAT ? (row & (SEQ - 1)) : ((row - MLAT) & (CTX - 1));
        const bf16* pp = PR + (size_t)row * NPR + PR_P + lane * 16;
        v4u z = (v4u){0u, 0u, 0u, 0u};
        v4u m0 = z, m1 = z, n0 = z, n1 = z;
        if (t > 0) { m0 = *(const v4u*)(pp - NPR); m1 = *(const v4u*)(pp - NPR + 8); }
        if (t < L - 1) { n0 = *(const v4u*)(pp + NPR); n1 = *(const v4u*)(pp + NPR + 8); }
        const v4u c0 = *(const v4u*)pp, c1 = *(const v4u*)(pp + 8);
        const bf16* bp = PR + (size_t)row * NPR + PR_BG + lane * 16; const v4u g0 = *(const v4u*)bp, g1 = *(const v4u*)(bp + 8);
        unsigned mm[8] = {m0.x, m0.y, m0.z, m0.w, m1.x, m1.y, m1.z, m1.w}, cc[8] = {c0.x, c0.y, c0.z, c0.w, c1.x, c1.y, c1.z, c1.w}, nn[8] = {n0.x, n0.y, n0.z, n0.w, n1.x, n1.y, n1.z, n1.w}, gg[8] = {g0.x, g0.y, g0.z, g0.w, g1.x, g1.y, g1.z, g1.w};
        unsigned o[8];
#pragma unroll
        for (int j = 0; j < 8; ++j) {
            const float lo = bflo(gg[j]) * (w[0][2 * j] * bflo(mm[j]) + w[1][2 * j] * bflo(cc[j]) + w[2][2 * j] * bflo(nn[j]));
            const float hi = bfhi(gg[j]) * (w[0][2 * j + 1] * bfhi(mm[j]) + w[1][2 * j + 1] * bfhi(cc[j]) + w[2][2 * j + 1] * bfhi(nn[j]));
            o[j] = pk2(lo, hi); }
        v4u* op = (v4u*)(YC + (size_t)row * D + lane * 16); op[0] = (v4u){o[0], o[1], o[2], o[3]}; op[1] = (v4u){o[4], o[5], o[6], o[7]};
    }
}

__device__ __forceinline__ void ph_transpose_ya(const Args& a, const Frame& F, int nrows) {
    const int gw = F.vcu * 8 + F.wave, NGW = F.G * 8, lane = F.lane;
    LAS unsigned short* tl = (LAS unsigned short*)(F.lds + F.wave * 16384);
    const bf16* YAT = (const bf16*)(a.ws + WS_YAT); bf16* YA = (bf16*)(a.ws + WS_YCAT);
    const int nitems = (nrows / 64) * 16;
    for (int it = gw; it < nitems; it += NGW) {
        const int tb = it >> 4, cb = it & 15, tok0 = tb * 64, c0 = cb * 64;
        v4u r[8];
#pragma unroll
        for (int k = 0; k < 8; ++k) r[k] = *(const v4u*)(YAT + (size_t)(c0 + (lane >> 3) + 8 * k) * MTOT + tok0 + (lane & 7) * 8);
#pragma unroll
        for (int k = 0; k < 8; ++k) *(LAS v4u*)(tl + ((lane >> 3) + 8 * k) * 72 + (lane & 7) * 8) = r[k];
        LDS_WAIT(); asm volatile("" ::: "memory");
        unsigned o[32];
#pragma unroll
        for (int j = 0; j < 32; ++j) o[j] = (unsigned)tl[(2 * j) * 72 + lane] | ((unsigned)tl[(2 * j + 1) * 72 + lane] << 16);
        v4u* op = (v4u*)(YA + (size_t)(tok0 + lane) * D + c0);
#pragma unroll
        for (int j = 0; j < 8; ++j) op[j] = (v4u){o[4 * j], o[4 * j + 1], o[4 * j + 2], o[4 * j + 3]};
        LDS_WAIT(); asm volatile("" ::: "memory");
    }
}

__device__ __forceinline__ float neg_expm1_(float x) { return x > -0.02f ? -(x * (1.0f + x * (0.5f + x * 0.16666667f))) : 1.0f - __expf(x); }
template <int PASS> __device__ __forceinline__ void lru_item(const Args& a, const Frame& F, int l, int q, int hd) {
    LAS float* raw = (LAS float*)F.lds;
    LAS float* xc = raw + 67 * 64;
    LAS float* GT = xc + 64 * 65;
    LAS float* SA = GT + 4 * 64 * 65;
    LAS float* CIN = SA + 2 * 4 * 64 * 2;
    LAS unsigned short* xcb = (LAS unsigned short*)(CIN + 128);
    const bf16* PR = (const bf16*)(a.ws + WS_PR);
    const bool isctx = q >= 256; const int b = isctx ? (q - 256) >> 2 : q >> 5, qi = isctx ? (q - 256) & 3 : q & 31;
    const int L = isctx ? CTX : SEQ, seq0 = isctx ? MLAT + b * CTX : b * SEQ, t0 = qi * 64, c0 = hd * 64;
    const int tid = F.tid, lane = F.lane, wave = F.wave;
    const int fr = lane & 15, fq = lane >> 4, gdir = wave >> 2, gax = (wave >> 1) & 1, jb = (wave & 1) * 32;
    float* AGG = (float*)(a.ws + WS_AGG); bf16* LAB = (bf16*)(a.ws + WS_LAB);
    v4u rv[2];
#pragma unroll
    for (int k = 0; k < 2; ++k) { const int i = tid + 512 * k, tr = i >> 3, sg = i & 7, t = t0 - 2 + tr; rv[k] = (v4u){0u, 0u, 0u, 0u};
        if (i < 67 * 8 && t >= 0 && t < L) rv[k] = *(const v4u*)(PR + (unsigned)((seq0 + t) * NPR + PR_REC + c0 + sg * 8)); }
    const int ch = tid & 63;
    const float* cw = a.in[18] + (size_t)l * 4 * D + c0 + ch; const float cw0 = cw[0], cw1 = cw[D], cw2 = cw[2 * D], cw3 = cw[3 * D], cbb = a.in[19][(size_t)l * D + c0 + ch];
    const float* SP = (const float*)(a.ws + WS_SP) + (size_t)l * 2 * D + c0 + 2 * (tid & 31);
    const c2 spm0 = *(const c2*)SP * (c2){-8.0f, -8.0f}, spm1 = *(const c2*)(SP + D) * (c2){-8.0f, -8.0f};
    bf16x8 Bf[2][2]; f32x4 bv[2];
    { const bf16* Wc = (const bf16*)(a.ws + WS_WLRU) + (((size_t)l * 16 + hd) * 256 + 32 * wave) * 64;
#pragma unroll
      for (int nt = 0; nt < 2; ++nt)
#pragma unroll
          for (int ks = 0; ks < 2; ++ks) Bf[nt][ks] = *(const bf16x8*)(Wc + (nt * 16 + fr) * 64 + ks * 32 + fq * 8);
      const float* bias = (gax ? a.in[23] : a.in[21]) + ((size_t)l * 2 + gdir) * D + c0 + jb;
#pragma unroll
      for (int nt = 0; nt < 2; ++nt) bv[nt] = *(const f32x4*)(bias + nt * 16 + 4 * fq); }
    v4u gg = (v4u){0u, 0u, 0u, 0u}; float hcar = 0.f;
    if (PASS == 2) {
        gg = *(const v4u*)(PR + ((size_t)seq0 + t0 + (tid >> 3)) * NPR + PR_GELU + c0 + (tid & 7) * 8);
        if (tid < 128) {
            const int dir = tid >> 6; const float* ag = AGG + ((size_t)dir * NCHUNK) * D * 2 + (size_t)(c0 + ch) * 2;
            const int cbase = 256 + b * 4, lbase = b * 32;
            float ga[35], gb[35];
#pragma unroll
            for (int p = 0; p < 35; ++p) { int chunk; bool valid;
                if (isctx) { chunk = dir == 0 ? cbase + p : cbase + 3 - p; valid = dir == 0 ? p < qi : p < 3 - qi; }
                else if (p < 4) { chunk = dir == 0 ? cbase + p : cbase + 3 - p; valid = true; }
                else { chunk = dir == 0 ? lbase + (p - 4) : lbase + 31 - (p - 4); valid = dir == 0 ? (p - 4) < qi : (p - 4) < 31 - qi; }
                if (p >= 4 && isctx) valid = false;
                ga[p] = 1.f; gb[p] = 0.f;
                if (valid) { const f32x2 g = *(const f32x2*)(ag + (size_t)chunk * D * 2); ga[p] = g[0]; gb[p] = g[1]; } }
#pragma unroll
            for (int p = 0; p < 35; ++p) hcar = ga[p] * hcar + gb[p];
        }
    }
    __syncthreads();
#pragma unroll
    for (int k = 0; k < 2; ++k) { const int i = tid + 512 * k; if (i < 67 * 8) { const v4u r = rv[k];
        LAS float* d = raw + (i >> 3) * 64 + (i & 7) * 8; d[0] = bflo(r.x); d[1] = bfhi(r.x); d[2] = bflo(r.y); d[3] = bfhi(r.y); d[4] = bflo(r.z); d[5] = bfhi(r.z); d[6] = bflo(r.w); d[7] = bfhi(r.w); } }
    if (PASS == 2 && tid < 128) CIN[tid] = hcar;
    __syncthreads();
#pragma unroll
    for (int k = 0; k < 8; ++k) { const int tt = (tid >> 6) + 8 * k;
        const float x = cw0 * raw[tt * 64 + ch] + cw1 * raw[(tt + 1) * 64 + ch] + cw2 * raw[(tt + 2) * 64 + ch] + cw3 * raw[(tt + 3) * 64 + ch] + cbb;
        xc[tt * 65 + ch] = x; xcb[tt * 72 + ch] = (unsigned short)f2bf(x); }
    __syncthreads();
    {
      LAS float* gp = GT + (gdir * 2 + gax) * 64 * 65 + jb + 4 * fq;
#pragma unroll
      for (int mt = 0; mt < 4; ++mt) { f32x4 acc[2] = {bv[0], bv[1]};
#pragma unroll
          for (int ks = 0; ks < 2; ++ks) { const bf16x8 Af = *(const LAS bf16x8*)(xcb + (mt * 16 + fr) * 72 + ks * 32 + fq * 8);
#pragma unroll
              for (int nt = 0; nt < 2; ++nt) acc[nt] = __builtin_amdgcn_mfma_f32_16x16x32_bf16(Bf[nt][ks], Af, acc[nt], 0, 0, 0); }
#pragma unroll
          for (int nt = 0; nt < 2; ++nt)
#pragma unroll
              for (int r = 0; r < 4; ++r) gp[(mt * 16 + fr) * 65 + nt * 16 + r] = sigmoidf_(acc[nt][r]); } }
    __syncthreads();
    {
      const int cp = tid & 31;
#pragma unroll
      for (int k = 0; k < 8; ++k) { const int dir = k >> 2, tt = (tid >> 5) + 16 * (k & 3);
          LAS float* pr = GT + (dir * 2) * 64 * 65 + tt * 65 + 2 * cp; LAS float* pi = pr + 64 * 65;
          const c2 r = (c2){pr[0], pr[1]}, iv = (c2){pi[0], pi[1]}, xv = (c2){xc[tt * 65 + 2 * cp], xc[tt * 65 + 2 * cp + 1]};
          const c2 la = r * (dir ? spm1 : spm0);
          const unsigned labp = pg8::cvt_pk_bf16(la.x, la.y);
          const c2 lar = (c2){__builtin_bit_cast(float, labp << 16), __builtin_bit_cast(float, labp & 0xffff0000u)};
          const c2 ex = lar * (c2){1.4426950408889634f, 1.4426950408889634f};
          const c2 av = (c2){__builtin_amdgcn_exp2f(ex.x), __builtin_amdgcn_exp2f(ex.y)}, x2 = lar + lar;
          const c2 one = (c2){1.0f, 1.0f};
          const c2 pol = -(x2 * (one + x2 * ((c2){0.5f, 0.5f} + x2 * (c2){0.16666667f, 0.16666667f}))), sq = one - av * av;
          const c2 om = (c2){x2.x > -0.02f ? pol.x : sq.x, x2.y > -0.02f ? pol.y : sq.y};
          const c2 bv0 = (c2){__builtin_amdgcn_sqrtf(om.x), __builtin_amdgcn_sqrtf(om.y)} * (iv * xv);
          const unsigned bbp = pg8::cvt_pk_bf16(bv0.x, bv0.y);
          pr[0] = av.x; pr[1] = av.y; pi[0] = __builtin_bit_cast(float, bbp << 16); pi[1] = __builtin_bit_cast(float, bbp & 0xffff0000u);
          if (PASS == 1) { unsigned* lp = (unsigned*)(LAB + (unsigned)((dir * 2 * MTOT + seq0 + t0 + tt) * D + c0 + 2 * cp)); lp[0] = labp; lp[(size_t)MTOT * D / 2] = bbp; } } }
    __syncthreads();
    const int sdir = tid >> 8, ssq = (tid >> 6) & 3, sch = tid & 63;
    const int tfirst = sdir == 0 ? 16 * ssq : 63 - 16 * ssq, tstep = sdir == 0 ? 1 : -1;
    LAS float* pa = GT + (sdir * 2) * 64 * 65 + sch; LAS float* pb = pa + 64 * 65;
    { float h = 0.f, ap = 1.f;
#pragma unroll
      for (int s = 0; s < 16; ++s) { const int tt = tfirst + tstep * s; const float av = pa[tt * 65]; h = av * h + pb[tt * 65]; ap *= av; }
      SA[((sdir * 4 + ssq) * 64 + sch) * 2] = ap; SA[((sdir * 4 + ssq) * 64 + sch) * 2 + 1] = h; }
    __syncthreads();
    if (PASS == 1) {
        if (tid < 128) { const int dir = tid >> 6; float h = 0.f, ap = 1.f;
#pragma unroll
            for (int s = 0; s < 4; ++s) { const float sa = SA[((dir * 4 + s) * 64 + ch) * 2], sb = SA[((dir * 4 + s) * 64 + ch) * 2 + 1]; h = sa * h + sb; ap *= sa; }
            *(f32x2*)(AGG + (((size_t)dir * NCHUNK + q) * D + c0 + ch) * 2) = (f32x2){ap, h}; }
    } else {
        float h = CIN[sdir * 64 + sch];
#pragma unroll
        for (int s = 0; s < 3; ++s) if (s < ssq) { const float sa = SA[((sdir * 4 + s) * 64 + sch) * 2], sb = SA[((sdir * 4 + s) * 64 + sch) * 2 + 1]; h = sa * h + sb; }
#pragma unroll
        for (int s = 0; s < 16; ++s) { const int tt = tfirst + tstep * s; h = pa[tt * 65] * h + pb[tt * 65]; pb[tt * 65] = h; }
        __syncthreads();
        bf16* YB = (bf16*)(a.ws + WS_YCAT) + (size_t)MTOT * D;
        { const int tt = tid >> 3, sg = tid & 7; const size_t row = (size_t)seq0 + t0 + tt; const v4u g = gg;
          const LAS float* hf = GT + (0 * 2 + 1) * 64 * 65 + tt * 65 + sg * 8; const LAS float* hb = GT + (1 * 2 + 1) * 64 * 65 + tt * 65 + sg * 8;
          v4u o; o.x = pk2(bflo(g.x) * (hf[0] + hb[0]), bfhi(g.x) * (hf[1] + hb[1])); o.y = pk2(bflo(g.y) * (hf[2] + hb[2]), bfhi(g.y) * (hf[3] + hb[3]));
          o.z = pk2(bflo(g.z) * (hf[4] + hb[4]), bfhi(g.z) * (hf[5] + hb[5])); o.w = pk2(bflo(g.w) * (hf[6] + hb[6]), bfhi(g.w) * (hf[7] + hb[7]));
          *(v4u*)(YB + row * D + c0 + sg * 8) = o; }
    }
}

__device__ __forceinline__ void lru_rows(const bf16* PR, int it, int tid, v4u (&rv)[2]) {
    const int q = it >> 4, hd = it & 15; const bool isctx = q >= 256; const int b = isctx ? (q - 256) >> 2 : q >> 5, qi = isctx ? (q - 256) & 3 : q & 31;
    const int L = isctx ? CTX : SEQ, seq0 = isctx ? MLAT + b * CTX : b * SEQ, t0 = qi * 64, c0 = hd * 64;
#pragma unroll
    for (int k = 0; k < 2; ++k) { const int i = tid + 512 * k, tr = (i >> 3) < 66 ? (i >> 3) : 66, sg = i & 7; int t = t0 - 2 + tr; t = t < 0 ? 0 : (t > L - 1 ? L - 1 : t);
        rv[k] = *(const v4u*)(PR + (unsigned)((seq0 + t) * NPR + PR_REC + c0 + sg * 8)); }
}
__device__ __forceinline__ void ph_lru1(const Args& a, const Frame& F, int l) {
    constexpr int PASS = 1;
    LAS float* raw = (LAS float*)F.lds;
    LAS float* xc = raw + 67 * 64;
    LAS float* GT = xc + 64 * 65;
    LAS float* SA = GT + 4 * 64 * 65;
    LAS float* CIN = SA + 2 * 4 * 64 * 2;
    LAS unsigned short* xcb = (LAS unsigned short*)(CIN + 128);
    const bf16* PR = (const bf16*)(a.ws + WS_PR);
    const int tid = F.tid, lane = F.lane, wave = F.wave, ch = tid & 63;
    const int fr = lane & 15, fq = lane >> 4, gdir = wave >> 2, gax = (wave >> 1) & 1, jb = (wave & 1) * 32;
    float* AGG = (float*)(a.ws + WS_AGG); bf16* LAB = (bf16*)(a.ws + WS_LAB);
    constexpr int NIT = NCHUNK * 16;
    if (F.vcu >= NIT) return;
    const int hd = F.vcu & 15, c0 = hd * 64;
    const float* cw = a.in[18] + (size_t)l * 4 * D + c0 + ch; const float cw0 = cw[0], cw1 = cw[D], cw2 = cw[2 * D], cw3 = cw[3 * D], cbb = a.in[19][(size_t)l * D + c0 + ch];
    const float* SP = (const float*)(a.ws + WS_SP) + (size_t)l * 2 * D + c0 + 2 * (tid & 31);
    const c2 spm0 = *(const c2*)SP * (c2){-8.0f, -8.0f}, spm1 = *(const c2*)(SP + D) * (c2){-8.0f, -8.0f};
    bf16x8 Bf[2][2]; f32x4 bv[2];
    { const bf16* Wc = (const bf16*)(a.ws + WS_WLRU) + (((size_t)l * 16 + hd) * 256 + 32 * wave) * 64;
#pragma unroll
      for (int nt = 0; nt < 2; ++nt)
#pragma unroll
          for (int ks = 0; ks < 2; ++ks) Bf[nt][ks] = *(const bf16x8*)(Wc + (nt * 16 + fr) * 64 + ks * 32 + fq * 8);
      const float* bias = (gax ? a.in[23] : a.in[21]) + ((size_t)l * 2 + gdir) * D + c0 + jb;
#pragma unroll
      for (int nt = 0; nt < 2; ++nt) bv[nt] = *(const f32x4*)(bias + nt * 16 + 4 * fq); }
    v4u rv[2];
    lru_rows(PR, F.vcu, tid, rv);
    for (int it = F.vcu; it < NIT; it += F.G) {
        const int q = it >> 4;
        const bool isctx = q >= 256; const int b = isctx ? (q - 256) >> 2 : q >> 5, qi = isctx ? (q - 256) & 3 : q & 31;
        const int L = isctx ? CTX : SEQ, seq0 = isctx ? MLAT + b * CTX : b * SEQ, t0 = qi * 64;
        __syncthreads();
#pragma unroll
        for (int k = 0; k < 2; ++k) { const int i = tid + 512 * k, t = t0 - 2 + (i >> 3); if (i < 67 * 8) { v4u r = rv[k]; if (t < 0 || t >= L) r = (v4u){0u, 0u, 0u, 0u};
            LAS float* d = raw + (i >> 3) * 64 + (i & 7) * 8; d[0] = bflo(r.x); d[1] = bfhi(r.x); d[2] = bflo(r.y); d[3] = bfhi(r.y); d[4] = bflo(r.z); d[5] = bfhi(r.z); d[6] = bflo(r.w); d[7] = bfhi(r.w); } }
        { const int itn = it + F.G < NIT ? it + F.G : it; lru_rows(PR, itn, tid, rv); }
        __syncthreads();
#pragma unroll
        for (int k = 0; k < 8; ++k) { const int tt = (tid >> 6) + 8 * k;
            const float x = cw0 * raw[tt * 64 + ch] + cw1 * raw[(tt + 1) * 64 + ch] + cw2 * raw[(tt + 2) * 64 + ch] + cw3 * raw[(tt + 3) * 64 + ch] + cbb;
            xc[tt * 65 + ch] = x; xcb[tt * 72 + ch] = (unsigned short)f2bf(x); }
        __syncthreads();
        {
          LAS float* gp = GT + (gdir * 2 + gax) * 64 * 65 + jb + 4 * fq;
#pragma unroll
          for (int mt = 0; mt < 4; ++mt) { f32x4 acc[2] = {bv[0], bv[1]};
#pragma unroll
              for (int ks = 0; ks < 2; ++ks) { const bf16x8 Af = *(const LAS bf16x8*)(xcb + (mt * 16 + fr) * 72 + ks * 32 + fq * 8);
#pragma unroll
                  for (int nt = 0; nt < 2; ++nt) acc[nt] = __builtin_amdgcn_mfma_f32_16x16x32_bf16(Bf[nt][ks], Af, acc[nt], 0, 0, 0); }
#pragma unroll
              for (int nt = 0; nt < 2; ++nt)
#pragma unroll
                  for (int r = 0; r < 4; ++r) gp[(mt * 16 + fr) * 65 + nt * 16 + r] = sigmoidf_(acc[nt][r]); } }
        __syncthreads();
        {
          const int cp = tid & 31;
#pragma unroll
          for (int k = 0; k < 8; ++k) { const int dir = k >> 2, tt = (tid >> 5) + 16 * (k & 3);
              LAS float* pr = GT + (dir * 2) * 64 * 65 + tt * 65 + 2 * cp; LAS float* pi = pr + 64 * 65;
              const c2 r = (c2){pr[0], pr[1]}, iv = (c2){pi[0], pi[1]}, xv = (c2){xc[tt * 65 + 2 * cp], xc[tt * 65 + 2 * cp + 1]};
              const c2 la = r * (dir ? spm1 : spm0);
              const unsigned labp = pg8::cvt_pk_bf16(la.x, la.y);
              const c2 lar = (c2){__builtin_bit_cast(float, labp << 16), __builtin_bit_cast(float, labp & 0xffff0000u)};
              const c2 ex = lar * (c2){1.4426950408889634f, 1.4426950408889634f};
              const c2 av = (c2){__builtin_amdgcn_exp2f(ex.x), __builtin_amdgcn_exp2f(ex.y)}, x2 = lar + lar;
              const c2 one = (c2){1.0f, 1.0f};
              const c2 pol = -(x2 * (one + x2 * ((c2){0.5f, 0.5f} + x2 * (c2){0.16666667f, 0.16666667f}))), sq = one - av * av;
              const c2 om = (c2){x2.x > -0.02f ? pol.x : sq.x, x2.y > -0.02f ? pol.y : sq.y};
              const c2 bv0 = (c2){__builtin_amdgcn_sqrtf(om.x), __builtin_amdgcn_sqrtf(om.y)} * (iv * xv);
              const unsigned bbp = pg8::cvt_pk_bf16(bv0.x, bv0.y);
              pr[0] = av.x; pr[1] = av.y; pi[0] = __builtin_bit_cast(float, bbp << 16); pi[1] = __builtin_bit_cast(float, bbp & 0xffff0000u);
              { unsigned* lp = (unsigned*)(LAB + (unsigned)((dir * 2 * MTOT + seq0 + t0 + tt) * D + c0 + 2 * cp)); lp[0] = labp; lp[(size_t)MTOT * D / 2] = bbp; } } }
        __syncthreads();
        const int sdir = tid >> 8, ssq = (tid >> 6) & 3, sch = tid & 63;
        const int tfirst = sdir == 0 ? 16 * ssq : 63 - 16 * ssq, tstep = sdir == 0 ? 1 : -1;
        LAS float* pa = GT + (sdir * 2) * 64 * 65 + sch; LAS float* pb = pa + 64 * 65;
        { float h = 0.f, ap = 1.f;
#pragma unroll
          for (int s = 0; s < 16; ++s) { const int tt = tfirst + tstep * s; const float av = pa[tt * 65]; h = av * h + pb[tt * 65]; ap *= av; }
          SA[((sdir * 4 + ssq) * 64 + sch) * 2] = ap; SA[((sdir * 4 + ssq) * 64 + sch) * 2 + 1] = h; }
        __syncthreads();

            if (tid < 128) { const int dir = tid >> 6; float h = 0.f, ap = 1.f;
#pragma unroll
                for (int s = 0; s < 4; ++s) { const float sa = SA[((dir * 4 + s) * 64 + ch) * 2], sb = SA[((dir * 4 + s) * 64 + ch) * 2 + 1]; h = sa * h + sb; ap *= sa; }
                *(f32x2*)(AGG + (((size_t)dir * NCHUNK + q) * D + c0 + ch) * 2) = (f32x2){ap, h}; }

    }
}
__device__ __forceinline__ void lru_item_p2(const Args& a, const Frame& F, int l, int q, int hd, int wit) {
    LAS float* GT = (LAS float*)F.lds;
    LAS float* SA = GT + 4 * 64 * 65;
    LAS float* CIN = SA + 2 * 4 * 64 * 2;
    const bf16* PR = (const bf16*)(a.ws + WS_PR); const bf16* LAB = (const bf16*)(a.ws + WS_LAB); const float* AGG = (const float*)(a.ws + WS_AGG);
    const bool isctx = q >= 256; const int b = isctx ? (q - 256) >> 2 : q >> 5, qi = isctx ? (q - 256) & 3 : q & 31;
    const int seq0 = isctx ? MLAT + b * CTX : b * SEQ, t0 = qi * 64, c0 = hd * 64;
    const int tid = F.tid, ch = tid & 63;
    v4u lv[4];
#pragma unroll
    for (int k = 0; k < 4; ++k) { const int tt = (tid >> 3) & 63, sg = tid & 7; lv[k] = *(const v4u*)(LAB + ((size_t)k * MTOT + seq0 + t0 + tt) * D + c0 + sg * 8); }
    const v4u gg = *(const v4u*)(PR + ((size_t)seq0 + t0 + (tid >> 3)) * NPR + PR_GELU + c0 + (tid & 7) * 8);
    float hcar = 0.f;
    if (tid < 128) { const int dir = tid >> 6; const float* ag = AGG + ((size_t)dir * NCHUNK) * D * 2 + (size_t)(c0 + ch) * 2;
        const int cbase = 256 + b * 4, lbase = b * 32;
        float ga[35], gb[35];
#pragma unroll
        for (int p = 0; p < 35; ++p) { int chunk; bool valid;
            if (isctx) { chunk = dir == 0 ? cbase + p : cbase + 3 - p; valid = dir == 0 ? p < qi : p < 3 - qi; }
            else if (p < 4) { chunk = dir == 0 ? cbase + p : cbase + 3 - p; valid = true; }
            else { chunk = dir == 0 ? lbase + (p - 4) : lbase + 31 - (p - 4); valid = dir == 0 ? (p - 4) < qi : (p - 4) < 31 - qi; }
            if (p >= 4 && isctx) valid = false;
            ga[p] = 1.f; gb[p] = 0.f;
            if (valid) { const f32x2 g = *(const f32x2*)(ag + (size_t)chunk * D * 2); ga[p] = g[0]; gb[p] = g[1]; } }
#pragma unroll
        for (int p = 0; p < 35; ++p) hcar = ga[p] * hcar + gb[p]; }
    f32x4 wv[16]; unsigned char* wd = nullptr; size_t wK = 0; const bool have = wit < NITW;
    if (have) wx_load(a, l, wit, F.lane, wv, wd, wK);
    __syncthreads();
    { const int tt = tid >> 3, sg = tid & 7;
#pragma unroll
      for (int k = 0; k < 4; ++k) { LAS float* d = GT + k * 64 * 65 + tt * 65 + sg * 8; const v4u r = lv[k];
          float f[8] = {bflo(r.x), bfhi(r.x), bflo(r.y), bfhi(r.y), bflo(r.z), bfhi(r.z), bflo(r.w), bfhi(r.w)};
#pragma unroll
          for (int j = 0; j < 8; ++j) d[j] = (k & 1) ? f[j] : __expf(f[j]); } }
    if (tid < 128) CIN[tid] = hcar;
    __syncthreads();
    const int sdir = tid >> 8, ssq = (tid >> 6) & 3, sch = tid & 63;
    const int tfirst = sdir == 0 ? 16 * ssq : 63 - 16 * ssq, tstep = sdir == 0 ? 1 : -1;
    LAS float* pa = GT + (sdir * 2) * 64 * 65 + sch; LAS float* pb = pa + 64 * 65;
    float av[16], bw[16];
    { float h = 0.f, ap = 1.f;
#pragma unroll
      for (int s = 0; s < 16; ++s) { const int tt = tfirst + tstep * s; av[s] = pa[tt * 65]; bw[s] = pb[tt * 65]; h = av[s] * h + bw[s]; ap *= av[s]; }
      SA[((sdir * 4 + ssq) * 64 + sch) * 2] = ap; SA[((sdir * 4 + ssq) * 64 + sch) * 2 + 1] = h; }
    __syncthreads();
    { float h = CIN[sdir * 64 + sch];
#pragma unroll
      for (int s = 0; s < 3; ++s) if (s < ssq) { const float sa = SA[((sdir * 4 + s) * 64 + sch) * 2], sb = SA[((sdir * 4 + s) * 64 + sch) * 2 + 1]; h = sa * h + sb; }
#pragma unroll
      for (int s = 0; s < 16; ++s) { const int tt = tfirst + tstep * s; h = av[s] * h + bw[s]; pb[tt * 65] = h; } }
    __syncthreads();
    bf16* YB = (bf16*)(a.ws + WS_YCAT) + (size_t)MTOT * D;
    { const int tt = tid >> 3, sg = tid & 7; const size_t row = (size_t)seq0 + t0 + tt; const v4u g = gg;
      const LAS float* hf = GT + (0 * 2 + 1) * 64 * 65 + tt * 65 + sg * 8; const LAS float* hb = GT + (1 * 2 + 1) * 64 * 65 + tt * 65 + sg * 8;
      v4u o; o.x = pk2(bflo(g.x) * (hf[0] + hb[0]), bfhi(g.x) * (hf[1] + hb[1])); o.y = pk2(bflo(g.y) * (hf[2] + hb[2]), bfhi(g.y) * (hf[3] + hb[3]));
      o.z = pk2(bflo(g.z) * (hf[4] + hb[4]), bfhi(g.z) * (hf[5] + hb[5])); o.w = pk2(bflo(g.w) * (hf[6] + hb[6]), bfhi(g.w) * (hf[7] + hb[7]));
      *(v4u*)(YB + row * D + c0 + sg * 8) = o; }
    if (have) wx_store(wv, wd, wK, F.lane);
}
#ifndef REP_LRU1
#define REP_LRU1 1
#endif
#ifndef REP_HY
#define REP_HY 1
#endif
#ifndef REP_CTX
#define REP_CTX 1
#endif
#ifndef REP_SC
#define REP_SC 1
#endif
#ifndef REP_LRU2
#define REP_LRU2 1
#endif
#ifndef REP_TR
#define REP_TR 1
#endif
#ifndef REP_NORM2
#define REP_NORM2 1
#endif
#ifndef REP_RANK
#define REP_RANK 1
#endif
#ifndef MK_SINGLE
#define MK_SINGLE 1
#endif
__global__ void __launch_bounds__(512, 2) mk_fwd(Args args) {
    extern __shared__ __attribute__((aligned(16))) unsigned char lds[];
    Frame F;
    F.lds = (LAS unsigned char*)lds;
    F.tid = threadIdx.x; F.lane = F.tid & 63; F.wave = __builtin_amdgcn_readfirstlane(F.tid >> 6);
    F.G = gridDim.x; { const int bx = blockIdx.x; F.vcu = (F.G % 8 == 0) ? (bx % 8) * (F.G / 8) + bx / 8 : bx; }
    volatile LAS unsigned* MISC = (volatile LAS unsigned*)(F.lds + MISC_OFF);
    for (int u = F.tid; u < 32; u += 512) MISC[u] = 0u;
    __syncthreads();
    unsigned* ctl = (unsigned*)(args.ws + WS_CTL);
    XcdBarrier bar; bar.bar = ctl + CW_BAR + args.li * XCD_BAR_WORDS; bar.x = 0; bar.st = nullptr;
    if (MK_SINGLE) bar = xcd_barrier_post(ctl + CW_BAR + args.li * XCD_BAR_WORDS, MISC + 8);
    const int lo = args.ph_lo, hi = args.ph_hi;
#define IN(k) (lo <= (k) && (k) < hi)
#define SEAM(k) do { if (MK_SINGLE && IN((k) + 1)) xcd_barrier(bar); } while (0)
    const int bid = (int)blockIdx.x; const int vcu0 = F.vcu, G0 = F.G;
#define LAUNDER() do { int t_ = threadIdx.x; asm volatile("" : "+v"(t_)); F.tid = t_; F.lane = t_ & 63; F.wave = __builtin_amdgcn_readfirstlane(t_ >> 6); int g_ = G0, v_ = vcu0; asm volatile("" : "+s"(g_), "+s"(v_)); F.G = g_; F.vcu = v_; } while (0)
    LAS unsigned char* ring = F.lds;

    if (IN(0)) { LAUNDER(); ph_prologue(args, F); SEAM(0); }
    if (IN(1)) { LAUNDER(); ph_filters(args, F); SEAM(1); }
#pragma unroll 1
    for (int l = 0; l < 2; ++l) {
        const int pb = 2 + 10 * l;
        const int mrows = l == 0 ? MTOT : MLAT;
        bf16* WIN = (bf16*)(args.ws + WS_WIN) + (size_t)l * NIN * D; bf16* WOUT = (bf16*)(args.ws + WS_WOUT) + (size_t)l * 4 * D * D;
        bf16* H = (bf16*)(args.ws + WS_H); bf16* PR = (bf16*)(args.ws + WS_PR); bf16* YCAT = (bf16*)(args.ws + WS_YCAT);
        if (IN(pb + 0)) {
            LAUNDER();
            if (l == 0) ph_norm<0, false>(args, F, l); else ph_norm<0, true>(args, F, l);
            SEAM(pb + 0);
        }
        if (IN(pb + 1)) {
            { pg8::Gemm g{WIN, H, NHY, mrows, D}; RectOrder S; S.init(NHY / 256, mrows / 256, 0, 0, 0, 0, F.G, bid);
              EpiPlainBf16 E{(bf16*)(args.ws + WS_HYT), MTOT};
              pg8::gemm_phase<EpiPlainBf16, RectOrder, true, true>(ring, g, S, E); }
            { pg8::Gemm g{H, WIN + (size_t)NHY * D, MTOT, N2, D}; RectOrder S;
              if (l == 0) S.init(MTOT / 256, N2 / 256, 0, 0, 0, 0, F.G, bid); else S.init(MLAT / 256, N2 / 256, MCTX / 256, 4, MLAT / 256, 4, F.G, bid);
              EpiInProj E{PR};
              pg8::gemm_phase<EpiInProj, RectOrder, true, true>(ring, g, S, E); }
            SEAM(pb + 1);
        }
        if (IN(pb + 2)) {
            LAUNDER();
            for (int rep = 0; rep < REP_LRU1; ++rep) { if ((F.G & 15) == 0) ph_lru1(args, F, l); else for (int it = F.vcu; it < NCHUNK * 16; it += F.G) lru_item<1>(args, F, l, it >> 4, it & 15); }
            __syncthreads();
            LAUNDER();
            for (int rep = 0; rep < REP_HY; ++rep) ph_hyena_fft(args, F, l);
            LAUNDER();
            if (l == 0) for (int rep = 0; rep < REP_CTX; ++rep) ph_hyena_ctx(args, F, l);
            LAUNDER();
            for (int rep = 0; rep < REP_SC; ++rep) ph_sc(args, F, l, mrows);
            SEAM(pb + 2);
        }
        if (IN(pb + 3)) {
            LAUNDER();
            {
              int wit = F.vcu * 8 + F.wave; const int NGW = F.G * 8;
              for (int it = F.vcu; it < (mrows / LCH) * 16; it += F.G) { lru_item_p2(args, F, l, it >> 4, it & 15, wit); wit += NGW; }
              for (; wit < NITW; wit += NGW) { f32x4 wv[16]; unsigned char* wd; size_t wK; wx_load(args, l, wit, F.lane, wv, wd, wK); wx_store(wv, wd, wK, F.lane); } }
            __syncthreads();
            LAUNDER();
            for (int rep = 0; rep < REP_TR; ++rep) ph_transpose_ya(args, F, mrows);
            SEAM(pb + 3);
        }
        if (IN(pb + 4)) {
            bf16* MB = (bf16*)(args.ws + WS_MB);
            TripleOrder S; S.init(mrows / 256, MTOT / 256, F.G, bid);
            pg8::Gemm g{YCAT, WOUT, 3 * MTOT, 3 * D, D}; EpiGate3 E{PR + PR_GATE, MB, MTOT / 256};
            pg8::gemm_phase<EpiGate3, TripleOrder, true, true>(ring, g, S, E);
            SEAM(pb + 4);
        }
        if (IN(pb + 5)) {
            pg8::Gemm g{(bf16*)(args.ws + WS_MB), WOUT + 3ull * D * D, mrows, D, D}; RectOrder S; S.init(mrows / 256, 4, 0, 0, 0, 0, F.G, bid);
            EpiResid E{(float*)(args.ws + WS_X), (const float*)(args.ws + WS_MOD) + (size_t)l * 9 * 6144 + 2 * 1024};
            pg8::gemm_phase<EpiResid, RectOrder, true, true>(ring, g, S, E);
            SEAM(pb + 5);
        }
        if (IN(pb + 6)) { LAUNDER(); for (int rep = 0; rep < REP_NORM2; ++rep) ph_norm<1, false>(args, F, l); SEAM(pb + 6); }
        if (IN(pb + 7)) { LAUNDER(); for (int rep = 0; rep < REP_RANK; ++rep) ph_rank(args, F, l); SEAM(pb + 7); }
        if (IN(pb + 8)) {
            pg8::Gemm g{(bf16*)(args.ws + WS_XS), (bf16*)(args.ws + WS_WGU + (size_t)l * NE * NGU * D), NE * EROWS, NE * NGU, D / 2}; GroupOrder S; S.init(NE, l == 0 ? 9 : 8, 9, 22, F.G, bid);
            EpiSwiglu E{args.ws + WS_HID};
            pg8::gemm_phase<EpiSwiglu, GroupOrder, true, true, true>(ring, g, S, E);
            SEAM(pb + 8);
        }
        if (IN(pb + 9)) {
            pg8::Gemm g{(bf16*)(args.ws + WS_HID), (bf16*)(args.ws + WS_WD + (size_t)l * NE * D * DE), NE * EROWS, NE * D, DE / 2}; GroupOrder S; S.init(NE, l == 0 ? 9 : 8, 9, 4, F.G, bid);
            EpiYs E{(bf16*)(args.ws + WS_YS)};
            pg8::gemm_phase<EpiYs, GroupOrder, true, true, true>(ring, g, S, E);
            SEAM(pb + 9);
        }
    }
    if (IN(22)) { LAUNDER(); ph_norm<2, true>(args, F, 1); }
#undef IN
#undef SEAM
}

extern "C" void kernel_launch(void* const* d_in, const int* in_sizes, int n_in, void* d_out, int out_size, void* d_ws, size_t ws_size, hipStream_t stream) {
    static int grid = 0;
    if (grid == 0) {
        if (n_in != 35 || out_size != MLAT * D || ws_size < WS_END) { fprintf(stderr, "kernel_launch: unexpected shapes (n_in %d, out %d, ws %zu < %zu)\n", n_in, out_size, ws_size, (size_t)WS_END); grid = -1; return; }
        int dev = 0, cus = 0, per_cu = 0;
        if (hipGetDevice(&dev) != hipSuccess || hipDeviceGetAttribute(&cus, hipDeviceAttributeMultiprocessorCount, dev) != hipSuccess) { grid = -1; return; }
        if (hipFuncSetAttribute((const void*)mk_fwd, hipFuncAttributeMaxDynamicSharedMemorySize, LDS_BYTES) != hipSuccess) { fprintf(stderr, "kernel_launch: hipFuncSetAttribute failed\n"); grid = -1; return; }
        if (hipOccupancyMaxActiveBlocksPerMultiprocessor(&per_cu, (const void*)mk_fwd, 512, LDS_BYTES) != hipSuccess || per_cu < 1) fprintf(stderr, "kernel_launch: occupancy query says %d\n", per_cu);
        (void)hipGetLastError();
        grid = cus;
    }
    if (grid < 0) return;
    if (hipMemsetAsync((char*)d_ws + WS_CTL, 0, CTL_ZERO_BYTES, stream) != hipSuccess) return;
    Args a{};
    for (int i = 0; i < 35; ++i) a.in[i] = (const float*)d_in[i];
    a.out = (float*)d_out; a.ws = (unsigned char*)d_ws; a.pad = 0;
#if defined(PROBE_LO)
    a.ph_lo = 0; a.ph_hi = PROBE_HI; a.li = 0; hipLaunchKernelGGL(mk_fwd, dim3(grid), dim3(512), LDS_BYTES, stream, a);
    a.ph_lo = PROBE_LO; a.ph_hi = NPHASE; a.li = 1; hipLaunchKernelGGL(mk_fwd, dim3(grid), dim3(512), LDS_BYTES, stream, a);
#elif MK_SINGLE
    a.ph_lo = 0; a.ph_hi = NPHASE; a.li = 0;
    hipLaunchKernelGGL(mk_fwd, dim3(grid), dim3(512), LDS_BYTES, stream, a);
#else
    for (int p = 0; p < NPHASE; ++p) { a.ph_lo = p; a.ph_hi = p + 1; a.li = 0; hipLaunchKernelGGL(mk_fwd, dim3(grid), dim3(512), LDS_BYTES, stream, a); }
#endif
}
```

```cpp
#include <hip/hip_runtime.h>
#include <cstdio>
#include <cstdint>
namespace pg8 {
#define PG8_LAS __attribute__((address_space(3)))
typedef unsigned short bf16_t;
typedef short bf16x8 __attribute__((ext_vector_type(8)));
typedef float f32x4 __attribute__((ext_vector_type(4)));
typedef unsigned u32x4 __attribute__((ext_vector_type(4)));
constexpr int BM = 256, BK = 64, HALF = 128, HTB = HALF * BK * 2  , STAGE_BYTES = 8 * HTB, NXCD = 8, WGM = 8;

__host__ __device__ __forceinline__ int lds_byte(int r, int c) { const int st = (r >> 4) * 2 + (c >> 5), rr = r & 15, cc = c & 31, ob = rr * 64 + cc * 2; return st * 1024 + (ob ^ (((ob >> 9) & 1) << 5)); }
__host__ __device__ __forceinline__ void stage_rc(int b, int& R, int& C) { const int st = b / 1024, sb = b % 1024, swz = sb ^ (((sb >> 9) & 1) << 5); R = (st >> 1) * 16 + swz / 64; C = (st & 1) * 32 + (swz % 64) / 2; }
__host__ __device__ __forceinline__ int perm32(int rho) { const int n = rho >> 4, i = rho & 15; return 8 * (i >> 2) + 4 * n + (i & 3); }

struct Unit { int pm, pn; };
struct Gemm { const bf16_t* A; const bf16_t* Bt; int M, N, K; };

struct StaticOrder {
    int nM, nN, nwg, G, c;
    __host__ __device__ void init(int M, int N, int G_, int c_) { nM = M / BM; nN = N / BM; nwg = nM * nN; G = G_; c = c_; }
    __host__ __device__ bool next(int i, Unit& u) const {
        const long L = (long)i * G + c; if (L >= nwg) return false;
        int wgid = (int)L; { const int q = nwg / NXCD, r = nwg % NXCD, xcd = wgid % NXCD, off = wgid / NXCD; wgid = (xcd < r ? xcd * (q + 1) : r * (q + 1) + (xcd - r) * q) + off; }
        const int nig = WGM * nN, gid = wgid / nig, fm = gid * WGM, gsz = (nM - fm) < WGM ? (nM - fm) : WGM;
        u.pm = fm + ((wgid % nig) % gsz); u.pn = (wgid % nig) / gsz; return true;
    }
    __device__ __forceinline__ void a_ready(const Unit&) const {}
    __device__ __forceinline__ void done(const Unit&) const {}
};
__device__ __forceinline__ unsigned cvt_pk_bf16(float lo, float hi) { unsigned r; asm volatile("v_cvt_pk_bf16_f32 %0, %1, %2" : "=v"(r) : "v"(lo), "v"(hi)); return r; }
typedef float f32x2 __attribute__((ext_vector_type(2)));
typedef int i32x4_ __attribute__((ext_vector_type(4))); typedef int i32x8_ __attribute__((ext_vector_type(8)));
__device__ __forceinline__ bf16x8 frag_lo(i32x8_ v) { const i32x4_ t = __builtin_shufflevector(v, v, 0, 1, 2, 3); return __builtin_bit_cast(bf16x8, t); }
__device__ __forceinline__ bf16x8 frag_hi(i32x8_ v) { const i32x4_ t = __builtin_shufflevector(v, v, 4, 5, 6, 7); return __builtin_bit_cast(bf16x8, t); }
__device__ __forceinline__ i32x8_ cat8(bf16x8 lo, bf16x8 hi) { const i32x4_ a = __builtin_bit_cast(i32x4_, lo), b = __builtin_bit_cast(i32x4_, hi); return __builtin_shufflevector(a, b, 0, 1, 2, 3, 4, 5, 6, 7); }
template <class Epi, class Sched, bool ALIGN_EPI = false, bool SP2 = false, bool FP8 = false>
__device__ __forceinline__ void gemm_phase(PG8_LAS unsigned char* lds, const Gemm g, const Sched& S, const Epi& E) {
    int tid_ = threadIdx.x; asm volatile("" : "+v"(tid_));
    const int tid = tid_, wid = __builtin_amdgcn_readfirstlane(tid >> 6), lane = tid & 63, wr = wid >> 2, wc = wid & 3, fr = lane & 15, fq = lane >> 4;
    const int K = g.K, nt = K / BK;
    unsigned voffA[2], voffB[2];
#pragma unroll
    for (int i = 0; i < 2; ++i) { int R, C; stage_rc(tid * 16 + i * 8192, R, C); const int Rb = Epi::PERM ? ((R & ~31) + perm32(R & 31)) : R;
        const int ch = C >> 3; const unsigned Cb = FP8 ? (unsigned)(((ch & 3) * 2 + (ch >> 2)) * 16) : (unsigned)C * 2u;
        voffA[i] = (unsigned)(R * K) * 2u + Cb; voffB[i] = (unsigned)(Rb * K) * 2u + Cb; }
    const size_t kstep = (size_t)(BK * 2);
    const size_t hstep = (size_t)HALF * K * 2;
    const size_t tstep = 2 * hstep;
    const unsigned ldsw = (unsigned)wid * 1024u;
    const int aoff = lds_byte(wr * 64 + fr, fq * 8), boff = lds_byte(wc * 32 + fr, fq * 8);
#define PG8_SA(b, h) (((b) * 2 + (h)) * HTB)
#define PG8_SB(b, h) ((4 + (b) * 2 + (h)) * HTB)
#define PG8_STAGE(bufoff, gbase, voff) do { _Pragma("unroll") for (int _i = 0; _i < 2; ++_i) \
        __builtin_amdgcn_global_load_lds((const unsigned*)((const char*)(gbase) + (voff)[_i]), (PG8_LAS unsigned*)(lds + (bufoff) + ldsw + _i * 8192), 16, 0, 0); } while (0)
#define PG8_LDA(dst, b, h) do { _Pragma("unroll") for (int m = 0; m < 4; ++m) { dst[m].lo = *(const PG8_LAS i32x4_*)(lds + PG8_SA(b, h) + aoff + m * 2048); dst[m].hi = *(const PG8_LAS i32x4_*)(lds + PG8_SA(b, h) + aoff + m * 2048 + 1024); } } while (0)
#define PG8_LDB(dst, b, h) do { _Pragma("unroll") for (int n = 0; n < 2; ++n) { dst[n].lo = *(const PG8_LAS i32x4_*)(lds + PG8_SB(b, h) + boff + n * 2048); dst[n].hi = *(const PG8_LAS i32x4_*)(lds + PG8_SB(b, h) + boff + n * 2048 + 1024); } } while (0)
#define PG8_MMA(ai, bj, At, Bt) do { __builtin_amdgcn_s_setprio(1); if constexpr (FP8) { _Pragma("unroll") for (int m = 0; m < 4; ++m) _Pragma("unroll") for (int n = 0; n < 2; ++n) \
        asm volatile("v_mfma_scale_f32_16x16x128_f8f6f4 %0, %1, %2, %0, %3, %4 op_sel_hi:[0,0,0]" : "+v"(acc[ai][bj][m][n]) : "v"(Bt[n]), "v"(At[m]), "v"(sclw), "v"(scla)); } \
        else { _Pragma("unroll") for (int m = 0; m < 4; ++m) _Pragma("unroll") for (int n = 0; n < 2; ++n) { \
        acc[ai][bj][m][n] = __builtin_amdgcn_mfma_f32_16x16x32_bf16(frag_lo(Bt[n]), frag_lo(At[m]), acc[ai][bj][m][n], 0, 0, 0); \
        acc[ai][bj][m][n] = __builtin_amdgcn_mfma_f32_16x16x32_bf16(frag_hi(Bt[n]), frag_hi(At[m]), acc[ai][bj][m][n], 0, 0, 0); } } __builtin_amdgcn_s_setprio(0); } while (0)
#define PG8_WAIT_V(n) asm volatile("s_waitcnt vmcnt(" #n ")" ::: "memory")
#define PG8_WAIT_L(n) asm volatile("s_waitcnt lgkmcnt(" #n ")" ::: "memory")
#define PG8_BAR __builtin_amdgcn_s_barrier()
#define PG8_SCHED __builtin_amdgcn_sched_barrier(0)
    Unit cur, nxt; int ui = 0;
    if (!S.next(0, cur)) return;
    f32x4 acc[2][2][4][2];
#pragma unroll
    for (int a = 0; a < 2; ++a)
#pragma unroll
        for (int b = 0; b < 2; ++b)
#pragma unroll
            for (int m = 0; m < 4; ++m)
#pragma unroll
                for (int n = 0; n < 2; ++n) acc[a][b][m][n] = (f32x4){0.f, 0.f, 0.f, 0.f};
    i32x8_ At[4], B0[2], B1[2];
    int sclw = 0x7a7a7a7a, scla = 0x7f7f7f7f;
    if constexpr (FP8) asm volatile("" : "+v"(sclw), "+v"(scla));
    const char* cA = (const char*)g.A + (size_t)cur.pm * tstep; const char* cB = (const char*)g.Bt + (size_t)cur.pn * tstep;
    S.a_ready(cur);
    if constexpr (SP2) {
        PG8_STAGE(PG8_SB(0, 0), cB, voffB); PG8_STAGE(PG8_SB(0, 1), cB + hstep, voffB); PG8_STAGE(PG8_SA(0, 0), cA, voffA); PG8_STAGE(PG8_SA(0, 1), cA + hstep, voffA);
        if (wr == 1) PG8_BAR;
        PG8_WAIT_V(2); PG8_BAR;
        PG8_STAGE(PG8_SB(1, 0), cB + kstep, voffB); PG8_STAGE(PG8_SA(1, 0), cA + kstep, voffA); PG8_STAGE(PG8_SB(1, 1), cB + hstep + kstep, voffB);
        PG8_WAIT_V(6); PG8_BAR;
    } else {
        PG8_STAGE(PG8_SB(0, 0), cB, voffB); PG8_STAGE(PG8_SA(0, 0), cA, voffA); PG8_STAGE(PG8_SB(0, 1), cB + hstep, voffB); PG8_STAGE(PG8_SA(0, 1), cA + hstep, voffA);
        if (wr == 1) PG8_BAR;
        PG8_WAIT_V(4); PG8_BAR;
        PG8_STAGE(PG8_SB(1, 0), cB + kstep, voffB); PG8_STAGE(PG8_SA(1, 0), cA + kstep, voffA); PG8_STAGE(PG8_SB(1, 1), cB + hstep + kstep, voffB);
        PG8_WAIT_V(6); PG8_BAR;
    }
    for (;;) {
        const bool has_next = S.next(ui + 1, nxt);
        const char* nA = has_next ? (const char*)g.A + (size_t)nxt.pm * tstep : cA; const char* nB = has_next ? (const char*)g.Bt + (size_t)nxt.pn * tstep : cB;
#pragma unroll 1
        for (int t = 0; t < nt; t += 2) {
            const bool last = (t == nt - 2);
            const char* a1 = cA + (size_t)(t + 1) * kstep;
            const char* a2 = last ? nA : cA + (size_t)(t + 2) * kstep; const char* b2 = last ? nB : cB + (size_t)(t + 2) * kstep;
            const char* a3 = a2 + kstep; const char* b3 = b2 + kstep;
            if (last && has_next) S.a_ready(nxt);
            if constexpr (SP2) {
            PG8_LDB(B0, 0, 0); PG8_LDB(B1, 0, 1); PG8_SCHED; PG8_LDA(At, 0, 0); PG8_STAGE(PG8_SA(1, 1), a1 + hstep, voffA);
            PG8_WAIT_V(8); PG8_WAIT_L(0); PG8_BAR; PG8_MMA(0, 0, At, B0); PG8_MMA(0, 1, At, B1); PG8_BAR; PG8_SCHED;
            PG8_LDA(At, 0, 1); PG8_STAGE(PG8_SB(0, 0), b2, voffB); PG8_STAGE(PG8_SB(0, 1), b2 + hstep, voffB); PG8_STAGE(PG8_SA(0, 0), a2, voffA);
            PG8_WAIT_V(8); PG8_WAIT_L(0); PG8_BAR; PG8_MMA(1, 0, At, B0); PG8_MMA(1, 1, At, B1); PG8_BAR; PG8_SCHED;
            PG8_LDB(B0, 1, 0); PG8_LDB(B1, 1, 1); PG8_SCHED; PG8_LDA(At, 1, 0); PG8_STAGE(PG8_SA(0, 1), a2 + hstep, voffA);
            PG8_WAIT_V(8); PG8_WAIT_L(0); PG8_BAR; PG8_MMA(0, 0, At, B0); PG8_MMA(0, 1, At, B1); PG8_BAR; PG8_SCHED;
            PG8_LDA(At, 1, 1); PG8_STAGE(PG8_SB(1, 0), b3, voffB); PG8_STAGE(PG8_SB(1, 1), b3 + hstep, voffB); PG8_STAGE(PG8_SA(1, 0), a3, voffA);
            PG8_WAIT_V(8); PG8_WAIT_L(0); PG8_BAR; PG8_MMA(1, 0, At, B0); PG8_MMA(1, 1, At, B1); PG8_BAR; PG8_SCHED;
            } else {
            PG8_LDB(B0, 0, 0); PG8_SCHED; PG8_LDA(At, 0, 0); PG8_STAGE(PG8_SA(1, 1), a1 + hstep, voffA);
            PG8_WAIT_L(8); PG8_BAR; PG8_WAIT_L(0); PG8_MMA(0, 0, At, B0); PG8_BAR; PG8_SCHED;
            PG8_LDB(B1, 0, 1); PG8_STAGE(PG8_SB(0, 0), b2, voffB);
            PG8_BAR; PG8_WAIT_L(0); PG8_MMA(0, 1, At, B1); PG8_BAR;
            PG8_LDA(At, 0, 1); PG8_STAGE(PG8_SA(0, 0), a2, voffA);
            PG8_BAR; PG8_WAIT_L(0); PG8_MMA(1, 0, At, B0); PG8_BAR; PG8_SCHED;
            PG8_STAGE(PG8_SB(0, 1), b2 + hstep, voffB);
            PG8_WAIT_V(6); PG8_BAR; PG8_MMA(1, 1, At, B1); PG8_BAR;
            PG8_LDB(B0, 1, 0); PG8_SCHED; PG8_LDA(At, 1, 0); PG8_STAGE(PG8_SA(0, 1), a2 + hstep, voffA);
            PG8_WAIT_L(8); PG8_BAR; PG8_WAIT_L(0); PG8_MMA(0, 0, At, B0); PG8_BAR; PG8_SCHED;
            PG8_LDB(B1, 1, 1); PG8_STAGE(PG8_SB(1, 0), b3, voffB);
            PG8_BAR; PG8_WAIT_L(0); PG8_MMA(0, 1, At, B1); PG8_BAR;
            PG8_LDA(At, 1, 1); PG8_STAGE(PG8_SA(1, 0), a3, voffA);
            PG8_BAR; PG8_WAIT_L(0); PG8_MMA(1, 0, At, B0); PG8_BAR; PG8_SCHED;
            PG8_STAGE(PG8_SB(1, 1), b3 + hstep, voffB);
            PG8_WAIT_V(6); PG8_BAR; PG8_MMA(1, 1, At, B1); PG8_BAR;
            }
        }
        if constexpr (ALIGN_EPI) { if (wr == 0) PG8_BAR; }
        if constexpr (FP8) asm volatile("s_nop 15\n\ts_nop 15" ::: "memory");
        if constexpr (!Epi::AFTER_DRAIN) { E(acc, cur, wr, wc, fr, fq); S.done(cur); }
        if (!has_next) break;
        if (!(Epi::CHAIN && E.keep(cur))) {
#pragma unroll
        for (int a = 0; a < 2; ++a)
#pragma unroll
            for (int b = 0; b < 2; ++b)
#pragma unroll
                for (int m = 0; m < 4; ++m)
#pragma unroll
                    for (int n = 0; n < 2; ++n) acc[a][b][m][n] = (f32x4){0.f, 0.f, 0.f, 0.f};
        }
        cur = nxt; cA = nA; cB = nB; ++ui;
        if constexpr (ALIGN_EPI) { if (wr == 1) PG8_BAR; }
    }
    PG8_WAIT_V(0);
    if constexpr (!ALIGN_EPI) { if (wr == 0) PG8_BAR; }
    PG8_BAR;
    if constexpr (Epi::AFTER_DRAIN) { E.fused(acc, cur, wr, wc, fr, fq, lds, wid, lane); S.done(cur); }
#undef PG8_SA
#undef PG8_SB
#undef PG8_STAGE
#undef PG8_LDA
#undef PG8_LDB
#undef PG8_MMA
#undef PG8_WAIT_V
#undef PG8_WAIT_L
#undef PG8_BAR
#undef PG8_SCHED
}
}
#define GAS __attribute__((address_space(1)))
#define LAS __attribute__((address_space(3)))
typedef unsigned short bf16;
typedef unsigned v4u __attribute__((ext_vector_type(4)));
typedef unsigned v2u __attribute__((ext_vector_type(2)));
typedef float f32x4 __attribute__((ext_vector_type(4)));
typedef float f32x2 __attribute__((ext_vector_type(2)));
typedef short bf16x8 __attribute__((ext_vector_type(8)));
typedef GAS unsigned gu32;
#define RLX_AGENT __ATOMIC_RELAXED, __HIP_MEMORY_SCOPE_AGENT
#define LDS_WAIT() asm volatile("s_waitcnt lgkmcnt(0)" ::: "memory")
#define VM_WAIT() asm volatile("s_waitcnt vmcnt(0)" ::: "memory")
__device__ __forceinline__ unsigned f2bf(float f) { unsigned u = __builtin_bit_cast(unsigned, f); return (u + 0x7fffu + ((u >> 16) & 1u)) >> 16; }
__device__ __forceinline__ unsigned pk2(float lo, float hi) { return f2bf(lo) | (f2bf(hi) << 16); }
__device__ __forceinline__ float bf2f(unsigned short b) { return __builtin_bit_cast(float, ((unsigned)b) << 16); }
__device__ __forceinline__ float bflo(unsigned w) { return __builtin_bit_cast(float, w << 16); }
__device__ __forceinline__ float bfhi(unsigned w) { return __builtin_bit_cast(float, w & 0xffff0000u); }
__device__ __forceinline__ float sigmoidf_(float x) { return __builtin_amdgcn_rcpf(1.0f + __expf(-x)); }
__device__ __forceinline__ float gelu_tanh_(float x) { const float t = 1.5957691216f * (x + 0.044715f * x * x * x); return x * __builtin_amdgcn_rcpf(1.0f + __expf(-t)); }
__device__ __forceinline__ unsigned pk4_fp8(float a, float b, float c, float d) { int w = 0; w = __builtin_amdgcn_cvt_pk_fp8_f32(a, b, w, false); w = __builtin_amdgcn_cvt_pk_fp8_f32(c, d, w, true); return (unsigned)w; }
__device__ __forceinline__ float silu_(float x) { return x * __builtin_amdgcn_rcpf(1.0f + __expf(-x)); }

constexpr int D = 1024, NB = 8, SEQ = 2048, CTX = 256;
constexpr int MLAT = NB * SEQ, MCTX = NB * CTX, MTOT = MLAT + MCTX;
constexpr int NHY = 3072, N2 = 8192, NPR = 7168, NIN = 11264;
constexpr int NE = 16, DE = 2816, EROWS = 2304, NGU = 2 * DE;
constexpr int PR_GELU = 0, PR_REC = 1024, PR_BG = 2048, PR_P = 3072, PR_GATE = 4096;
constexpr int LCH = 64, NCHUNK = MTOT / LCH;

__device__ __forceinline__ int xcd_remap(int wgid, int nwg) { const int q = nwg / 8, r = nwg % 8, xcd = wgid % 8, off = wgid / 8; return (xcd < r ? xcd * (q + 1) : r * (q + 1) + (xcd - r) * q) + off; }

struct RectOrder {
    int nM1, nN1, n1, nM2, nN2, n2, pm2, pn2, G, c;
    __device__ void init(int nM1_, int nN1_, int nM2_, int nN2_, int pm2_, int pn2_, int G_, int c_) { nM1 = nM1_; nN1 = nN1_; n1 = nM1 * nN1; nM2 = nM2_; nN2 = nN2_; n2 = nM2 * nN2; pm2 = pm2_; pn2 = pn2_; G = G_; c = c_; }
    __device__ bool next(int i, pg8::Unit& u) const {
        const int L = i * G + c;
        if (L < n1) { const int wgid = xcd_remap(L, n1); const int nig = 8 * nN1, gid = wgid / nig, fm = gid * 8, gsz = (nM1 - fm) < 8 ? (nM1 - fm) : 8;
            u.pm = fm + ((wgid % nig) % gsz); u.pn = (wgid % nig) / gsz; return true; }
        const int L2 = L - n1; if (L2 >= n2) return false;
        u.pm = pm2 + L2 % nM2; u.pn = pn2 + L2 / nM2; return true;
    }
    __device__ __forceinline__ void a_ready(const pg8::Unit&) const {}
    __device__ __forceinline__ void done(const pg8::Unit&) const {}
};
struct GroupOrder {
    int mt, mstride, nt, nwg, G, c;
    __device__ void init(int nE, int mt_, int mstride_, int nt_, int G_, int c_) { mt = mt_; mstride = mstride_; nt = nt_; nwg = nE * mt * nt; G = G_; c = c_; }
    __device__ bool next(int i, pg8::Unit& u) const {
        const int L = i * G + c; if (L >= nwg) return false;
        const int wgid = xcd_remap(L, nwg); const int per = mt * nt, e = wgid / per, r = wgid % per;
        u.pm = e * mstride + r % mt; u.pn = e * nt + r / mt; return true;
    }
    __device__ __forceinline__ void a_ready(const pg8::Unit&) const {}
    __device__ __forceinline__ void done(const pg8::Unit&) const {}
};


struct TripleOrder {
    int nM, ntile, mstride, G, c;
    __device__ void init(int nM_, int mstride_, int G_, int c_) { nM = nM_; ntile = nM_ * 4; mstride = mstride_; G = G_; c = c_; }
    __device__ bool next(int u, pg8::Unit& un) const {
        const int t = u / 3, i = u - 3 * t, L = t * G + c; if (L >= ntile) return false;
        const int wgid = xcd_remap(L, ntile); const int nig = 8 * 4, gid = wgid / nig, fm = gid * 8, gsz = (nM - fm) < 8 ? (nM - fm) : 8;
        un.pm = i * mstride + fm + ((wgid % nig) % gsz); un.pn = i * 4 + (wgid % nig) / gsz; return true;
    }
    __device__ __forceinline__ void a_ready(const pg8::Unit&) const {}
    __device__ __forceinline__ void done(const pg8::Unit&) const {}
};

#define EPI_ROW(u, ai, m) ((u).pm * 256 + wr * 64 + fr + (ai) * 128 + (m) * 16)
struct EpiPlainBf16 {
    static constexpr bool PERM = true, AFTER_DRAIN = false, CHAIN = false; __device__ __forceinline__ bool keep(const pg8::Unit&) const { return false; }
    bf16* O; int ldc;
    __device__ __forceinline__ void operator()(const f32x4 (&acc)[2][2][4][2], const pg8::Unit& u, int wr, int wc, int fr, int fq) const {
        const int col0 = u.pn * 256 + wc * 32 + 8 * fq;
#pragma unroll
        for (int ai = 0; ai < 2; ++ai)
#pragma unroll
            for (int m = 0; m < 4; ++m) { bf16* rowp = O + (size_t)EPI_ROW(u, ai, m) * ldc + col0;
#pragma unroll
                for (int bj = 0; bj < 2; ++bj) { const f32x4 v0 = acc[ai][bj][m][0], v1 = acc[ai][bj][m][1];
                    v4u w; w.x = pg8::cvt_pk_bf16(v0[0], v0[1]); w.y = pg8::cvt_pk_bf16(v0[2], v0[3]); w.z = pg8::cvt_pk_bf16(v1[0], v1[1]); w.w = pg8::cvt_pk_bf16(v1[2], v1[3]);
                    *(v4u*)(rowp + bj * 128) = w; } }
    }
};
struct EpiInProj {
    static constexpr bool PERM = true, AFTER_DRAIN = false, CHAIN = false; __device__ __forceinline__ bool keep(const pg8::Unit&) const { return false; }
    bf16* PR;
    __device__ __forceinline__ void operator()(const f32x4 (&acc)[2][2][4][2], const pg8::Unit& u, int wr, int wc, int fr, int fq) const {
        const int pn = u.pn;
        if (pn >= 12 && pn < 20) {
            const int col = PR_P + (pn - 12) * 128 + wc * 32 + 8 * fq;
#pragma unroll
            for (int ai = 0; ai < 2; ++ai)
#pragma unroll
                for (int m = 0; m < 4; ++m) { const f32x4 v0 = acc[ai][0][m][0] * acc[ai][1][m][0], v1 = acc[ai][0][m][1] * acc[ai][1][m][1];
                    v4u w; w.x = pg8::cvt_pk_bf16(v0[0], v0[1]); w.y = pg8::cvt_pk_bf16(v0[2], v0[3]); w.z = pg8::cvt_pk_bf16(v1[0], v1[1]); w.w = pg8::cvt_pk_bf16(v1[2], v1[3]);
                    *(v4u*)(PR + (size_t)EPI_ROW(u, ai, m) * NPR + col) = w; }
        } else {
            const int mode = pn < 4 ? 1 : (pn < 12 ? 0 : 2);
            const int col0 = (pn < 12 ? pn * 256 : PR_GATE + (pn - 20) * 256) + wc * 32 + 8 * fq;
#pragma unroll
            for (int ai = 0; ai < 2; ++ai)
#pragma unroll
                for (int m = 0; m < 4; ++m) { bf16* rowp = PR + (size_t)EPI_ROW(u, ai, m) * NPR + col0;
#pragma unroll
                    for (int bj = 0; bj < 2; ++bj) { f32x4 v0 = acc[ai][bj][m][0], v1 = acc[ai][bj][m][1];
                        if (mode == 1) {
#pragma unroll
                            for (int j = 0; j < 4; ++j) { v0[j] = gelu_tanh_(v0[j]); v1[j] = gelu_tanh_(v1[j]); } }
                        else if (mode == 2) {
#pragma unroll
                            for (int j = 0; j < 4; ++j) { v0[j] = sigmoidf_(v0[j]); v1[j] = sigmoidf_(v1[j]); } }
                        v4u w; w.x = pg8::cvt_pk_bf16(v0[0], v0[1]); w.y = pg8::cvt_pk_bf16(v0[2], v0[3]); w.z = pg8::cvt_pk_bf16(v1[0], v1[1]); w.w = pg8::cvt_pk_bf16(v1[2], v1[3]);
                        *(v4u*)(rowp + bj * 128) = w; } }
        }
    }
};
template <int VAR> struct EpiGate {
    static constexpr bool PERM = true, AFTER_DRAIN = false, CHAIN = false; __device__ __forceinline__ bool keep(const pg8::Unit&) const { return false; }
    const bf16* gates; float* M32; bf16* MB;
    __device__ __forceinline__ void operator()(const f32x4 (&acc)[2][2][4][2], const pg8::Unit& u, int wr, int wc, int fr, int fq) const {
        const int col0 = u.pn * 256 + wc * 32 + 8 * fq;
#pragma unroll
        for (int ai = 0; ai < 2; ++ai)
#pragma unroll
            for (int m = 0; m < 4; ++m) { const size_t row = (size_t)EPI_ROW(u, ai, m);
#pragma unroll
                for (int bj = 0; bj < 2; ++bj) { const int col = col0 + bj * 128;
                    const v4u g = *(const v4u*)(gates + row * NPR + col);
                    f32x4 v0 = acc[ai][bj][m][0], v1 = acc[ai][bj][m][1];
                    v0[0] *= bflo(g.x); v0[1] *= bfhi(g.x); v0[2] *= bflo(g.y); v0[3] *= bfhi(g.y); v1[0] *= bflo(g.z); v1[1] *= bfhi(g.z); v1[2] *= bflo(g.w); v1[3] *= bfhi(g.w);
                    float* mp = M32 + row * D + col;
                    if (VAR >= 1) { v0 += *(const f32x4*)mp; v1 += *(const f32x4*)(mp + 4); }
                    if (VAR <= 1) { *(f32x4*)mp = v0; *(f32x4*)(mp + 4) = v1; }
                    else { v4u w; w.x = pg8::cvt_pk_bf16(v0[0], v0[1]); w.y = pg8::cvt_pk_bf16(v0[2], v0[3]); w.z = pg8::cvt_pk_bf16(v1[0], v1[1]); w.w = pg8::cvt_pk_bf16(v1[2], v1[3]);
                        *(v4u*)(MB + row * D + col) = w; } } }
    }
};

struct EpiGate3 {
    static constexpr bool PERM = true, AFTER_DRAIN = false, CHAIN = true;
    const bf16* gates; bf16* MB; int mstride;
    __device__ __forceinline__ bool keep(const pg8::Unit& u) const { return (u.pn >> 2) < 2; }
    __device__ __forceinline__ void operator()(f32x4 (&acc)[2][2][4][2], const pg8::Unit& u0, int wr, int wc, int fr, int fq) const {
        const int i = u0.pn >> 2; pg8::Unit u; u.pm = u0.pm - i * mstride; u.pn = u0.pn & 3;
        const int col0 = u.pn * 256 + wc * 32 + 8 * fq; const bf16* gt = gates + i * 1024;
#pragma unroll
        for (int ai = 0; ai < 2; ++ai) {
            v4u G[4][2], Gn[4][2];
#pragma unroll
            for (int m = 0; m < 4; ++m) { const size_t row = (size_t)EPI_ROW(u, ai, m);
#pragma unroll
                for (int bj = 0; bj < 2; ++bj) { const bf16* gp = gt + row * NPR + col0 + bj * 128; G[m][bj] = *(const v4u*)gp;
                    Gn[m][bj] = *(const v4u*)(gp + (i < 2 ? 1024 : 0)); } }
#pragma unroll
            for (int m = 0; m < 4; ++m) { const size_t row = (size_t)EPI_ROW(u, ai, m);
#pragma unroll
                for (int bj = 0; bj < 2; ++bj) { const int col = col0 + bj * 128;
                    const v4u g = G[m][bj];
                    float s[8] = {bflo(g.x), bfhi(g.x), bflo(g.y), bfhi(g.y), bflo(g.z), bfhi(g.z), bflo(g.w), bfhi(g.w)};
                    if (i >= 1) {
#pragma unroll
                        for (int j = 0; j < 8; ++j) s[j] = fmaxf(s[j], 1e-18f); }
                    if (i < 2) { const v4u gn = Gn[m][bj];
                        const float d[8] = {bflo(gn.x), bfhi(gn.x), bflo(gn.y), bfhi(gn.y), bflo(gn.z), bfhi(gn.z), bflo(gn.w), bfhi(gn.w)};
#pragma unroll
                        for (int j = 0; j < 8; ++j) s[j] = s[j] * __builtin_amdgcn_rcpf(fmaxf(d[j], 1e-18f)); }
                    f32x4 v0 = acc[ai][bj][m][0], v1 = acc[ai][bj][m][1];
                    v0[0] *= s[0]; v0[1] *= s[1]; v0[2] *= s[2]; v0[3] *= s[3]; v1[0] *= s[4]; v1[1] *= s[5]; v1[2] *= s[6]; v1[3] *= s[7];
                    if (i < 2) { acc[ai][bj][m][0] = v0; acc[ai][bj][m][1] = v1; }
                    else { v4u w; w.x = pg8::cvt_pk_bf16(v0[0], v0[1]); w.y = pg8::cvt_pk_bf16(v0[2], v0[3]); w.z = pg8::cvt_pk_bf16(v1[0], v1[1]); w.w = pg8::cvt_pk_bf16(v1[2], v1[3]);
                        *(v4u*)(MB + row * D + col) = w; } } }
        }
    }
};
struct EpiResid {
    static constexpr bool PERM = false, AFTER_DRAIN = false, CHAIN = false; __device__ __forceinline__ bool keep(const pg8::Unit&) const { return false; }
    float* X; const float* modg;
    __device__ __forceinline__ void operator()(const f32x4 (&acc)[2][2][4][2], const pg8::Unit& u, int wr, int wc, int fr, int fq) const {
        const int r = u.pm < 64 ? (u.pm >> 3) : 8; const float* mg = modg + (size_t)r * 6144;
        const int col0 = u.pn * 256 + wc * 32 + 4 * fq;
        f32x4 gv[2][2];
#pragma unroll
        for (int bj = 0; bj < 2; ++bj)
#pragma unroll
            for (int n = 0; n < 2; ++n) gv[bj][n] = *(const f32x4*)(mg + col0 + bj * 128 + n * 16);
#pragma unroll
        for (int ai = 0; ai < 2; ++ai) {
            f32x4 xv[4][2][2];
#pragma unroll
            for (int m = 0; m < 4; ++m) { const float* rowp = X + (size_t)EPI_ROW(u, ai, m) * D + col0;
#pragma unroll
                for (int bj = 0; bj < 2; ++bj)
#pragma unroll
                    for (int n = 0; n < 2; ++n) xv[m][bj][n] = *(const f32x4*)(rowp + bj * 128 + n * 16); }
#pragma unroll
            for (int m = 0; m < 4; ++m) { float* rowp = X + (size_t)EPI_ROW(u, ai, m) * D + col0;
#pragma unroll
                for (int bj = 0; bj < 2; ++bj)
#pragma unroll
                    for (int n = 0; n < 2; ++n) *(f32x4*)(rowp + bj * 128 + n * 16) = xv[m][bj][n] + gv[bj][n] * acc[ai][bj][m][n]; }
        }
    }
};
struct EpiSwiglu {
    static constexpr bool PERM = true, AFTER_DRAIN = false, CHAIN = false; __device__ __forceinline__ bool keep(const pg8::Unit&) const { return false; }
    unsigned char* HID;
    __device__ __forceinline__ void operator()(const f32x4 (&acc)[2][2][4][2], const pg8::Unit& u, int wr, int wc, int fr, int fq) const {
        const int jn = u.pn % 22; const int col = jn * 128 + wc * 32 + 8 * fq;
#pragma unroll
        for (int ai = 0; ai < 2; ++ai)
#pragma unroll
            for (int m = 0; m < 4; ++m) { f32x4 v0, v1;
#pragma unroll
                for (int j = 0; j < 4; ++j) { v0[j] = silu_(acc[ai][0][m][0][j]) * acc[ai][1][m][0][j]; v1[j] = silu_(acc[ai][0][m][1][j]) * acc[ai][1][m][1][j]; }
                v2u w; w.x = pk4_fp8(v0[0], v0[1], v0[2], v0[3]); w.y = pk4_fp8(v1[0], v1[1], v1[2], v1[3]);
                *(v2u*)(HID + (size_t)EPI_ROW(u, ai, m) * DE + col) = w; }
    }
};
struct EpiYs {
    static constexpr bool PERM = true, AFTER_DRAIN = false, CHAIN = false; __device__ __forceinline__ bool keep(const pg8::Unit&) const { return false; }
    bf16* YS;
    __device__ __forceinline__ void operator()(const f32x4 (&acc)[2][2][4][2], const pg8::Unit& u, int wr, int wc, int fr, int fq) const {
        const int col0 = (u.pn & 3) * 256 + wc * 32 + 8 * fq;
#pragma unroll
        for (int ai = 0; ai < 2; ++ai)
#pragma unroll
            for (int m = 0; m < 4; ++m) { bf16* rowp = YS + (size_t)EPI_ROW(u, ai, m) * D + col0;
#pragma unroll
                for (int bj = 0; bj < 2; ++bj) { const f32x4 v0 = acc[ai][bj][m][0], v1 = acc[ai][bj][m][1];
                    v4u w; w.x = pg8::cvt_pk_bf16(v0[0], v0[1]); w.y = pg8::cvt_pk_bf16(v0[2], v0[3]); w.z = pg8::cvt_pk_bf16(v1[0], v1[1]); w.w = pg8::cvt_pk_bf16(v1[2], v1[3]);
                    *(v4u*)(rowp + bj * 128) = w; } }
    }
};
#define XB_TMO      128
#define XB_XCNT(j)  (256  + 64 * (j))
#define XB_XSUB(j)  (1280 + 64 * (j))
#define XB_XGEN(j)  (2304 + 64 * (j))
#define XB_TOP      3328
#define XB_TOPGEN   3392
#define XCD_BAR_WORDS 3456
#define XB_SPIN_CAP (1u << 18)

__device__ __forceinline__ unsigned xb_ld(unsigned* p)              { return __hip_atomic_load(p, __ATOMIC_RELAXED, __HIP_MEMORY_SCOPE_AGENT); }
__device__ __forceinline__ unsigned xb_add(unsigned* p, unsigned v) { return __hip_atomic_fetch_add(p, v, __ATOMIC_RELAXED, __HIP_MEMORY_SCOPE_AGENT); }
__device__ __forceinline__ unsigned xb_xcc_id() { return (unsigned)__builtin_amdgcn_s_getreg((3 << 11) | 20) & 0xFu; }
#define XB_SPIN(cond, bar) do { unsigned _sp = 0; while (cond) { __builtin_amdgcn_s_sleep(1); \
    if ((++_sp & 255u) == 0u) { if (xb_ld(&(bar)[XB_TMO])) break; if (_sp > XB_SPIN_CAP) { atomicAdd(&(bar)[XB_TMO], 1u); break; } } } } while (0)

struct XcdBarrier {
    unsigned* bar; unsigned x;
    volatile LAS unsigned* st;
};

__device__ __forceinline__ XcdBarrier xcd_barrier_post(unsigned* bar, volatile LAS unsigned* st) {
    XcdBarrier b; b.bar = bar; b.x = xb_xcc_id(); b.st = st;
    if (threadIdx.x == 0) (void)xb_add(&bar[XB_XCNT(b.x)], 1u);
    return b;
}
__device__ __forceinline__ void xcd_barrier_complete(unsigned* bar, unsigned x, unsigned& nloc, unsigned& nx) {
    const unsigned G = gridDim.x * gridDim.y * gridDim.z;
    unsigned sum, cnt, mine, sp = 0u;
    for (;;) {
        sum = 0u; cnt = 0u; mine = 0u;
#pragma unroll
        for (unsigned j = 0; j < 16; ++j) { const unsigned c = xb_ld(&bar[XB_XCNT(j)]); sum += c; cnt += (c > 0u) ? 1u : 0u; mine = (j == x) ? c : mine; }
        if (sum == G) break;
        __builtin_amdgcn_s_sleep(1);
        if ((++sp & 255u) == 0u) { if (xb_ld(&bar[XB_TMO])) break; if (sp > XB_SPIN_CAP) { atomicAdd(&bar[XB_TMO], 1u); break; } }
    }
    nloc = mine > 0u ? mine : 1u; nx = cnt > 0u ? cnt : 1u;
}

__device__ __forceinline__ void xcd_barrier(const XcdBarrier& b) {
    asm volatile("s_waitcnt vmcnt(0)" ::: "memory");
    __syncthreads();
    if (threadIdx.x == 0) {
        unsigned* bar = b.bar;
        __builtin_amdgcn_s_waitcnt(0);
        unsigned nloc = b.st[0], nx = b.st[1];
        if (nloc == 0u) { xcd_barrier_complete(bar, b.x, nloc, nx); b.st[0] = nloc; b.st[1] = nx; }
        const unsigned old = xb_add(&bar[XB_XSUB(b.x)], 1u);
        const unsigned gen = old / nloc;
        if (old + 1u == (gen + 1u) * nloc) {
            __builtin_amdgcn_fence(__ATOMIC_RELEASE, "agent");
            asm volatile("s_waitcnt vmcnt(0)" ::: "memory");
            const unsigned og = xb_add(&bar[XB_TOP], 1u);
            const unsigned tg = og / nx;
            if (og + 1u == (tg + 1u) * nx) xb_add(&bar[XB_TOPGEN], 1u);
            else XB_SPIN(xb_ld(&bar[XB_TOPGEN]) == tg, bar);
            __builtin_amdgcn_fence(__ATOMIC_ACQUIRE, "agent");
            xb_add(&bar[XB_XGEN(b.x)], 1u);
            asm volatile("s_waitcnt vmcnt(0)" ::: "memory");
        } else {
            XB_SPIN(xb_ld(&bar[XB_XGEN(b.x)]) == gen, bar);
            __builtin_amdgcn_fence(__ATOMIC_ACQUIRE, "agent");
            asm volatile("s_waitcnt vmcnt(0)" ::: "memory");
        }
    }
    __syncthreads();
}
constexpr size_t MiB = 1u << 20;
constexpr size_t al_(size_t x) { return (x + MiB - 1) / MiB * MiB; }
constexpr size_t WS_CTL = 0, CTL_ZERO_BYTES = 1 * MiB;
constexpr size_t WS_MOD  = 1 * MiB;
constexpr size_t WS_SP   = WS_MOD + 512 * 1024;
constexpr size_t WS_WIN  = WS_MOD + 1 * MiB;
constexpr size_t WS_WOUT = WS_WIN + al_(2ull * NIN * D * 2);
constexpr size_t WS_WLRU = WS_WOUT + al_(2ull * 4 * D * D * 2);
constexpr size_t WS_WGU  = WS_WLRU + 1 * MiB;
constexpr size_t WS_WD   = WS_WGU + al_(16ull * NGU * D * 2);
constexpr size_t WS_X    = WS_WD + al_(16ull * D * DE * 2);
constexpr size_t WS_FH2  = WS_X + al_((size_t)MTOT * D * 4);
constexpr size_t WS_KF   = WS_FH2 + 2 * MiB;
constexpr size_t WS_TFC  = WS_KF + al_(2ull * 2 * D * 4096 * 8);
constexpr size_t WS_H    = WS_TFC + al_(4ull * D * CTX * 4);
constexpr size_t WS_R    = WS_H + al_((size_t)MTOT * D * 2);
constexpr size_t WS_HYT  = WS_R;
constexpr size_t WS_PR   = WS_HYT + al_((size_t)NHY * MTOT * 2);
constexpr size_t WS_YAT  = WS_PR + al_((size_t)MTOT * NPR * 2);
constexpr size_t WS_YCAT = WS_YAT + al_((size_t)D * MTOT * 2);
constexpr size_t WS_REND = WS_YCAT + al_(3ull * MTOT * D * 2);
constexpr size_t WS_XS   = WS_R;
constexpr size_t WS_HID  = WS_XS + al_((size_t)NE * EROWS * D * 2);
constexpr size_t WS_YS   = WS_HID + al_((size_t)NE * EROWS * DE * 2);
static_assert(WS_YS + (size_t)NE * EROWS * D * 4 <= WS_REND, "MoE overlay fits");
constexpr size_t WS_M32  = WS_REND;
constexpr size_t WS_MB   = WS_M32 + al_((size_t)MTOT * D * 4);
constexpr size_t WS_AFF  = WS_MB + al_((size_t)MTOT * D * 2);
constexpr size_t WS_SELG = WS_AFF + 2 * MiB;
constexpr size_t WS_INV  = WS_SELG + 1 * MiB;
constexpr size_t WS_AGG  = WS_INV + 2 * MiB;
constexpr size_t WS_LAB  = WS_AGG + al_(2ull * NCHUNK * D * 2 * 4);
constexpr size_t WS_END  = WS_LAB + al_(4ull * MTOT * D * 2);
constexpr int CW_BAR = 4096;
constexpr int LDS_BYTES = 147456, MISC_OFF = 147456 - 256;
constexpr int NPHASE = 23;

struct Args { const float* in[35]; float* out; unsigned char* ws; int ph_lo, ph_hi, li, pad; };
struct Frame { LAS unsigned char* lds; int tid, lane, wave, vcu, G; };

__device__ __forceinline__ float wave_sum(float v) {
#pragma unroll
    for (int o = 1; o < 64; o <<= 1) v += __shfl_xor(v, o);
    return v;
}
__device__ __forceinline__ void tr_item(const float* src, size_t ld, bf16* dst, size_t K, LAS float* scr, int lane) {
    f32x4 v[16];
#pragma unroll
    for (int i = 0; i < 16; ++i) v[i] = *(const f32x4*)(src + (size_t)((lane >> 4) + 4 * i) * ld + (lane & 15) * 4);
#pragma unroll
    for (int i = 0; i < 16; ++i) { LAS float* p = scr + ((lane >> 4) + 4 * i) * 65 + (lane & 15) * 4; p[0] = v[i][0]; p[1] = v[i][1]; p[2] = v[i][2]; p[3] = v[i][3]; }
    LDS_WAIT(); asm volatile("" ::: "memory");
    const int c = lane & 7;
#pragma unroll
    for (int j = 0; j < 8; ++j) { const int n = (lane >> 3) + 8 * j; const LAS float* s = scr + (8 * c) * 65 + n;
        v4u o; o.x = pk2(s[0 * 65], s[1 * 65]); o.y = pk2(s[2 * 65], s[3 * 65]); o.z = pk2(s[4 * 65], s[5 * 65]); o.w = pk2(s[6 * 65], s[7 * 65]);
        *(v4u*)(dst + (size_t)n * K + 8 * c) = o; }
    LDS_WAIT(); asm volatile("" ::: "memory");
}
__device__ __forceinline__ int win_src_col(int n0) {
    if (n0 < 3072) return n0;
    const int m = n0 - 3072;
    if (m < 1024) return 3072 + m;
    if (m < 2048) return 4096 + (m - 1024);
    if (m < 3072) return 5120 + (m - 2048);
    if (m < 5120) { const int q = m - 3072, j = q >> 8, r = q & 255; return r < 128 ? 6144 + 128 * j + r : 7168 + 128 * j + (r - 128); }
    return 8192 + (m - 5120);
}

__device__ __forceinline__ void ph_prologue(const Args& a, const Frame& F) {
    const int gw = F.vcu * 8 + F.wave, NGW = F.G * 8, lane = F.lane;
    float* X = (float*)(a.ws + WS_X);
    for (int t = gw; t < SEQ; t += NGW) {
        f32x4 xv[NB][4];
#pragma unroll
        for (int b = 0; b < NB; ++b) { const f32x4* xr = (const f32x4*)(a.in[0] + ((size_t)b * SEQ + t) * D) + lane;
#pragma unroll
            for (int j = 0; j < 4; ++j) xv[b][j] = xr[64 * j]; }
        const int gr = t >> 6, gc = t & 63; f32x4 pe[4];
#pragma unroll
        for (int j = 0; j < 4; ++j)
#pragma unroll
            for (int i = 0; i < 4; ++i) { const int cc = 4 * lane + 256 * j + i; const float pos = (float)(cc < 512 ? gr : gc); const int c2 = cc & 511, idx = c2 & 255;
                const float om = exp2f((float)idx * (-13.287712379549449f / 256.0f)); const float ang = pos * om; pe[j][i] = c2 < 256 ? sinf(ang) : cosf(ang); }
#pragma unroll
        for (int b = 0; b < NB; ++b) { f32x4* xo = (f32x4*)(X + ((size_t)b * SEQ + t) * D) + lane;
#pragma unroll
            for (int j = 0; j < 4; ++j) xo[64 * j] = xv[b][j] + pe[j]; }
    }
    for (int r = gw; r < MCTX; r += NGW) { const f32x4* xr = (const f32x4*)(a.in[2] + (size_t)r * D) + lane; f32x4* xo = (f32x4*)(X + (size_t)(MLAT + r) * D) + lane;
#pragma unroll
        for (int j = 0; j < 4; ++j) xo[64 * j] = xr[64 * j]; }
    {
        LAS float* S = (LAS float*)F.lds;
        LAS float* red = S + 9 * 1024;
        for (int i = F.tid; i < 9 * 1024; i += 512) { const float v = i < 8192 ? a.in[1][i] : a.in[3][i - 8192]; S[i] = v / (1.0f + expf(-v)); }
        __syncthreads();
        float* MOD = (float*)(a.ws + WS_MOD);
        for (int it = F.vcu; it < 2 * 96; it += F.G) {
            const int l = it / 96, cb = it % 96, cj = F.tid & 63, ks = F.tid >> 6;
            const float* w = a.in[4] + (size_t)l * D * 6144 + cb * 64 + cj; float acc[9];
#pragma unroll
            for (int r = 0; r < 9; ++r) acc[r] = 0.f;
            for (int k0 = ks * 128; k0 < ks * 128 + 128; k0 += 32) { float wv[32];
#pragma unroll
                for (int kk = 0; kk < 32; ++kk) wv[kk] = w[(size_t)(k0 + kk) * 6144];
#pragma unroll
                for (int kk = 0; kk < 32; ++kk)
#pragma unroll
                    for (int r = 0; r < 9; ++r) acc[r] += S[r * 1024 + k0 + kk] * wv[kk]; }
#pragma unroll
            for (int r = 0; r < 9; ++r) red[(ks * 9 + r) * 64 + cj] = acc[r];
            __syncthreads();
            for (int o = F.tid; o < 9 * 64; o += 512) { const int r = o >> 6, c2 = o & 63; float s = a.in[5][(size_t)l * 6144 + cb * 64 + c2];
#pragma unroll
                for (int k2 = 0; k2 < 8; ++k2) s += red[(k2 * 9 + r) * 64 + c2];
                MOD[((size_t)l * 9 + r) * 6144 + cb * 64 + c2] = s; }
            __syncthreads();
        }
    }
    {
        LAS float* scr = (LAS float*)(F.lds + F.wave * 16640);
        bf16* WIN = (bf16*)(a.ws + WS_WIN); bf16* WOUT = (bf16*)(a.ws + WS_WOUT);
        constexpr int I_IN = 16 * (NIN / 64), I_OUT = 16 * 16;
        constexpr int NIT = 2 * I_IN + 8 * I_OUT;
        for (int it = gw; it < NIT; it += NGW) {
            if (it < 2 * I_IN) { const int l = it / I_IN, r = it % I_IN, kb = r / (NIN / 64), nb = r % (NIN / 64);
                tr_item(a.in[8] + (size_t)l * D * NIN + (size_t)(64 * kb) * NIN + win_src_col(64 * nb), NIN, WIN + (size_t)l * NIN * D + (size_t)(64 * nb) * D + 64 * kb, D, scr, lane); }
            else { const int r0 = it - 2 * I_IN, mi = r0 / I_OUT, r = r0 % I_OUT, l = mi >> 2, w = mi & 3, kb = r / 16, nb = r % 16;
                tr_item(a.in[26 + w] + (size_t)l * D * D + (size_t)(64 * kb) * D + 64 * nb, D, WOUT + ((size_t)l * 4 + w) * D * D + (size_t)(64 * nb) * D + 64 * kb, D, scr, lane); }
        }
    }
    {
      bf16* WL = (bf16*)(a.ws + WS_WLRU); float* SP = (float*)(a.ws + WS_SP);
      const int gt = F.vcu * 512 + F.tid, NT = F.G * 512;
      for (int i = gt; i < 2 * 16 * 256 * 64; i += NT) { const int k = i & 63, n = (i >> 6) & 255, hd = (i >> 14) & 15, l = i >> 18; const int dir = n >> 7, ax = (n >> 6) & 1, j = n & 63;
          WL[i] = (bf16)f2bf((ax ? a.in[22] : a.in[20])[((((size_t)l * 2 + dir) * 16 + hd) * 64 + k) * 64 + j]); }
      for (int i = gt; i < 4 * D; i += NT) { const float lam = a.in[24][i]; SP[i] = log1pf(expf(-lam)); } }
    __syncthreads();
    {
        LAS float* feats = (LAS float*)F.lds;
        LAS float* h1 = feats + 8 * 36;
        float* FH2 = (float*)(a.ws + WS_FH2);
        for (int it = F.vcu; it < 2 * 288; it += F.G) {
            const int l = it / 288, tb = it % 288, tl = F.tid >> 6, j = F.tid & 63;
            const int tt = tb * 8 + tl; const int L = tt < SEQ ? SEQ : CTX, t = tt < SEQ ? tt : tt - SEQ;
            if (j < 33) { const float wv = (6.283185307179586f / (float)L) * (float)t; float v;
                if (j == 0) v = (float)t / (float)(L - 1);
                else { const int bi = (j - 1) & 15; const float f = 1e-4f + (float)bi * ((15.0f - 1e-4f) / 15.0f); v = j <= 16 ? cosf(f * wv) : -sinf(f * wv); }
                feats[tl * 36 + j] = v; }
            __syncthreads();
            { const float* w1 = a.in[11] + (size_t)l * 33 * 64; float s = a.in[12][l * 64 + j];
              for (int m = 0; m < 33; ++m) s += feats[tl * 36 + m] * w1[m * 64 + j];
              h1[tl * 64 + j] = sinf(a.in[16][l * 64 + j] * s); }
            __syncthreads();
            { const float* w2 = a.in[13] + (size_t)l * 64 * 64; float s = a.in[14][l * 64 + j];
              for (int m = 0; m < 64; ++m) s += h1[tl * 64 + m] * w2[m * 64 + j];
              FH2[((size_t)l * 64 + j) * 2304 + tt] = sinf(a.in[16][l * 64 + j] * s); }
            __syncthreads();
        }
    }
}


#define FFT_HD __device__ __forceinline__
typedef float c2 __attribute__((ext_vector_type(2)));
FFT_HD c2 c2swap(c2 a) { return __builtin_shufflevector(a, a, 1, 0); }
FFT_HD c2 c2mul(c2 a, c2 b) {
    c2 t, d;
    asm("v_pk_mul_f32 %0, %1, %2 op_sel:[0,0] op_sel_hi:[1,0]" : "=&v"(t) : "v"(a), "v"(b));
    asm("v_pk_fma_f32 %0, %1, %2, %3 op_sel:[1,1,0] op_sel_hi:[0,1,1] neg_lo:[0,1,0]" : "=&v"(d) : "v"(a), "v"(b), "v"(t));
    return d;
}
FFT_HD c2 c2mulconj(c2 a, c2 b) {
    c2 t, d;
    asm("v_pk_mul_f32 %0, %1, %2 op_sel:[0,0] op_sel_hi:[1,0] neg_hi:[0,1]" : "=&v"(t) : "v"(a), "v"(b));
    asm("v_pk_fma_f32 %0, %1, %2, %3 op_sel:[1,1,0] op_sel_hi:[0,1,1] neg_lo:[0,1,0] neg_hi:[0,1,0]" : "=&v"(d) : "v"(a), "v"(b), "v"(t));
    return d;
}
FFT_HD c2 c2mulk(c2 a, float br, float bi) { return c2mul(a, (c2){br, bi}); }
FFT_HD c2 c2add_mi(c2 s, c2 t) { c2 d; asm("v_pk_add_f32 %0, %1, %2 op_sel:[0,1] op_sel_hi:[1,0] neg_hi:[0,1]" : "=&v"(d) : "v"(s), "v"(t)); return d; }
FFT_HD c2 c2sub_mi(c2 s, c2 t) { c2 d; asm("v_pk_add_f32 %0, %1, %2 op_sel:[0,1] op_sel_hi:[1,0] neg_lo:[0,1]" : "=&v"(d) : "v"(s), "v"(t)); return d; }
FFT_HD void dft4v(c2& a, c2& b, c2& c, c2& d) {
    const c2 s0 = a + c, s1 = a - c, s2 = b + d, t = b - d;
    a = s0 + s2; c = s0 - s2; b = c2add_mi(s1, t); d = c2sub_mi(s1, t);
}
FFT_HD void dft4v_z(c2& a, c2& b, c2& c, c2& d) {
    const c2 a0 = a, b0 = b; a = a0 + b0; c = a0 - b0; b = c2add_mi(a0, b0); d = c2sub_mi(a0, b0);
}
FFT_HD void dft4v_cr(c2& a, c2& b, c2& c, c2& d) {
    const c2 s0 = c2add_mi(a, c), s1 = c2sub_mi(a, c), s2 = b + d, t = b - d;
    a = s0 + s2; c = s0 - s2; b = c2add_mi(s1, t); d = c2sub_mi(s1, t);
}
#define PERM16(k) ((((k) >> 2) & 3) + 4 * ((k) & 3))
template <bool ZH> FFT_HD void dft16v(c2 (&v)[16]) {
    const float C1 = 0.92387953251128674f, S1 = 0.38268343236508978f, R2 = 0.70710678118654752f;
#pragma unroll
    for (int na = 0; na < 4; ++na) { if (ZH) dft4v_z(v[na], v[na + 4], v[na + 8], v[na + 12]); else dft4v(v[na], v[na + 4], v[na + 8], v[na + 12]); }
    v[5] = c2mulk(v[5], C1, -S1); v[6] = c2mulk(v[6], R2, -R2); v[7] = c2mulk(v[7], S1, -C1);
    v[9] = c2mulk(v[9], R2, -R2);   v[11] = c2mulk(v[11], -R2, -R2);
    v[13] = c2mulk(v[13], S1, -C1); v[14] = c2mulk(v[14], -R2, -R2); v[15] = c2mulk(v[15], -C1, S1);
    dft4v(v[0], v[1], v[2], v[3]); dft4v(v[4], v[5], v[6], v[7]); dft4v_cr(v[8], v[9], v[10], v[11]); dft4v(v[12], v[13], v[14], v[15]);
}

typedef c2 cf2;
__device__ __forceinline__ void fft_twiddles(int tid, LAS cf2* T, c2 (&tw2)[16]) {
    const int tt = tid & 255, n0 = tt & 15, k2 = tt >> 4;
    LAS cf2* scr = T + 256 + tid * 17;
    if (tid < 256) { float s, c; const int m1 = (16 * (tid >> 4) * (tid & 15)) & 4095; sincosf(-6.283185307179586f * (float)m1 * (1.0f / 4096.0f), &s, &c); T[tid] = (cf2){c, s}; }
#pragma unroll 1
    for (int k = 0; k < 16; ++k) { float s, c; const int m2 = (n0 * (k2 + 16 * k)) & 4095; sincosf(-6.283185307179586f * (float)m2 * (1.0f / 4096.0f), &s, &c); scr[k] = (cf2){c, s}; }
    LDS_WAIT(); asm volatile("" ::: "memory");
#pragma unroll
    for (int k = 0; k < 16; ++k) tw2[k] = scr[k];
    __syncthreads();
}
template <bool TABLE2, bool ZH = false> __device__ __forceinline__ void fft4096(c2 (&v)[16], LAS cf2* buf, int tt, const LAS cf2* T, const c2 (&tw2)[16]) {
    dft16v<ZH>(v);
    { const LAS cf2* T1 = T + (tt >> 4) * 16;
#pragma unroll
      for (int k = 0; k < 16; ++k) { c2 a = v[PERM16(k)]; if (k) a = c2mul(a, T1[k]); buf[tt + 272 * k] = a; } }
    __syncthreads();
    const int n0 = tt & 15, k2 = tt >> 4;
#pragma unroll
    for (int n1 = 0; n1 < 16; ++n1) v[n1] = buf[n0 + 16 * n1 + 272 * k2];
    __syncthreads();
    dft16v<false>(v);
    { const LAS cf2* T2 = T + n0 * 16;
#pragma unroll
      for (int k1 = 0; k1 < 16; ++k1) { c2 w = tw2[TABLE2 ? 0 : k1]; if (TABLE2 && k1) w = c2mul(w, T2[k1]); buf[k2 + 16 * k1 + 257 * n0] = c2mul(v[PERM16(k1)], w); } }
    __syncthreads();
#pragma unroll
    for (int m = 0; m < 16; ++m) v[m] = buf[tt + 257 * m];
    __syncthreads();
    dft16v<false>(v);
    { c2 w[16];
#pragma unroll
      for (int k = 0; k < 16; ++k) w[k] = v[PERM16(k)];
#pragma unroll
      for (int k = 0; k < 16; ++k) v[k] = w[k]; }
}

template <int NP> __device__ __forceinline__ void filt_taps4(const float* FH2T, const LAS float* w3s, int p0, float (&d)[NP][4][4]) {
#pragma unroll
    for (int g = 0; g < NP; ++g)
#pragma unroll
        for (int i = 0; i < 4; ++i)
#pragma unroll
            for (int od = 0; od < 4; ++od) d[g][i][od] = 0.f;
#pragma unroll 4
    for (int j = 0; j < 64; ++j) { const f32x4 w = *(const LAS f32x4*)(w3s + j * 4);
#pragma unroll
        for (int g = 0; g < NP; ++g) { const f32x4 h = *(const f32x4*)(FH2T + (size_t)j * 2304 + p0 + 1024 * g);
#pragma unroll
            for (int i = 0; i < 4; ++i)
#pragma unroll
                for (int od = 0; od < 4; ++od) d[g][i][od] += h[i] * w[od]; } }
}
__device__ __forceinline__ void ph_filters(const Args& a, const Frame& F) {
    const int team = F.tid >> 8, tt = F.tid & 255, tw = (F.tid >> 6) & 3;
    LAS cf2* fbuf = (LAS cf2*)F.lds;
    LAS cf2* TW = fbuf + 2 * 4352;
    LAS cf2* zt = TW + 256 + team * 4096;
    LAS float* w3s = (LAS float*)(TW + 256 + 2 * 4096) + team * 256;
    LAS float* red = (LAS float*)(TW + 256 + 2 * 4096) + 512 + team * 16;
    LAS float* cx = (LAS float*)(fbuf + team * 4352);
    c2 tw2[16]; fft_twiddles(F.tid, TW, tw2);
    for (int it = F.vcu; it < 2 * (D / 2); it += F.G) {
        const int l = it / (D / 2), c = 2 * (it % (D / 2)) + team;
        const float* FH2 = (const float*)(a.ws + WS_FH2) + (size_t)l * 64 * 2304;
        __syncthreads();
        { const int od = tt >> 6, j = tt & 63; w3s[j * 4 + od] = a.in[15][((size_t)l * 64 + j) * 4096 + od * 1024 + c]; }
        __syncthreads();
        const float ad = fabsf(-3.0701134573f + (float)c * ((-15.3505672866f + 3.0701134573f) / 1023.0f));
        float s0 = 0.f, s1 = 0.f, c0 = 0.f, c1 = 0.f;
        { float d[2][4][4]; filt_taps4<2>(FH2, w3s, 4 * tt, d);
#pragma unroll
          for (int g = 0; g < 2; ++g)
#pragma unroll
              for (int i = 0; i < 4; ++i) { const int t = 4 * tt + i + 1024 * g; const float win = __expf(-((float)t / (float)(SEQ - 1)) * ad);
                  const float k0 = d[g][i][0] * win, k1 = d[g][i][1] * win, k2 = d[g][i][2] * win, k3 = d[g][i][3] * win;
                  s0 += fabsf(k0) + (t > 0 ? fabsf(k1) : 0.f); s1 += fabsf(k2) + (t > 0 ? fabsf(k3) : 0.f);
                  zt[t] = (cf2){k0, k2}; if (t > 0) zt[4096 - t] = (cf2){k1, k3}; } }
        if (tt == 0) zt[2048] = (cf2){0.f, 0.f};
        if (l == 0 && tt < 64) { float d[1][4][4]; filt_taps4<1>(FH2 + SEQ, w3s, 4 * tt, d);
#pragma unroll
            for (int i = 0; i < 4; ++i) { const int t = 4 * tt + i; const float win = __expf(-((float)t / (float)(CTX - 1)) * ad);
                const float k0 = d[0][i][0] * win, k1 = d[0][i][1] * win, k2 = d[0][i][2] * win, k3 = d[0][i][3] * win;
                cx[t] = k0; cx[256 + t] = k1; cx[512 + t] = k2; cx[768 + t] = k3;
                c0 += fabsf(k0) + (t > 0 ? fabsf(k1) : 0.f); c1 += fabsf(k2) + (t > 0 ? fabsf(k3) : 0.f); } }
        s0 = wave_sum(s0); s1 = wave_sum(s1); c0 = wave_sum(c0); c1 = wave_sum(c1);
        if (F.lane == 0) { red[tw * 4] = s0; red[tw * 4 + 1] = s1; red[tw * 4 + 2] = c0; red[tw * 4 + 3] = c1; }
        __syncthreads();
        const float i0 = 1.0f / ((red[0] + red[4]) + (red[8] + red[12])), i1 = 1.0f / ((red[1] + red[5]) + (red[9] + red[13]));
        if (l == 0) { const float j0 = 1.0f / ((red[2] + red[6]) + (red[10] + red[14])), j1 = 1.0f / ((red[3] + red[7]) + (red[11] + red[15]));
            float* TF = (float*)(a.ws + WS_TFC);
#pragma unroll
            for (int od = 0; od < 4; ++od) TF[((size_t)od * D + c) * CTX + tt] = cx[od * 256 + tt] * (od < 2 ? j0 : j1); }
        c2 v[16];
#pragma unroll
        for (int j = 0; j < 16; ++j) { const cf2 r = zt[tt + 256 * j]; v[j] = (c2){r.x * i0, r.y * i1}; }
        __syncthreads();
        fft4096<true>(v, fbuf + team * 4352, tt, TW, tw2);
#pragma unroll
        for (int j = 0; j < 16; ++j) zt[tt + 256 * j] = v[j];
        __syncthreads();
        { cf2* K0 = (cf2*)(a.ws + WS_KF) + (((size_t)l * 2 + 0) * D + c) * 4096; cf2* K1 = (cf2*)(a.ws + WS_KF) + (((size_t)l * 2 + 1) * D + c) * 4096;
          const float sc = 0.5f / 4096.0f;
#pragma unroll
          for (int j = 0; j < 16; ++j) { const int f = tt + 256 * j; const cf2 zb = zt[(4096 - f) & 4095]; const float ar = v[j].x, ai = v[j].y, br = zb.x, bi = zb.y;
              K0[f] = (cf2){(ar + br) * sc, (ai - bi) * sc}; K1[f] = (cf2){(ai + bi) * sc, -(ar - br) * sc}; } }
    }
}

constexpr int NITW = NE * ((D / 128) * (NGU / 32) + (DE / 128) * (D / 32));
__device__ __forceinline__ void wx_load(const Args& a, int l, int it, int lane, f32x4 (&v)[16], unsigned char*& dst, size_t& K) {
    constexpr int I_GU = (D / 128) * (NGU / 32), I_D = (DE / 128) * (D / 32);
    unsigned char* WGU = a.ws + WS_WGU + (size_t)l * NE * NGU * D; unsigned char* WD = a.ws + WS_WD + (size_t)l * NE * D * DE;
    const float* src; size_t ld;
    if (it < NE * I_GU) { const int e = it / I_GU, r = it % I_GU, kb = r / (NGU / 32), nb = r % (NGU / 32); const int n0 = 32 * nb, jt = n0 >> 8, rr = n0 & 255;
        src = (rr < 128 ? a.in[31] : a.in[32]) + ((size_t)l * NE + e) * D * DE + (size_t)(128 * kb) * DE + 128 * jt + (rr & 127); ld = DE;
        dst = WGU + (size_t)e * NGU * D + (size_t)n0 * D + 128 * kb; K = D; }
    else { const int r0 = it - NE * I_GU, e = r0 / I_D, r = r0 % I_D, kb = r / (D / 32), nb = r % (D / 32);
        src = a.in[33] + ((size_t)l * NE + e) * DE * D + (size_t)(128 * kb) * D + 32 * nb; ld = D;
        dst = WD + (size_t)e * D * DE + (size_t)(32 * nb) * DE + 128 * kb; K = DE; }
    const float* p = src + (size_t)(16 * (lane >> 3)) * ld + (lane & 7) * 4;
#pragma unroll
    for (int i = 0; i < 16; ++i) v[i] = *(const f32x4*)(p + (size_t)i * ld);
}
__device__ __forceinline__ void wx_store(const f32x4 (&v)[16], unsigned char* dst, size_t K, int lane) {
    unsigned char* q = dst + (size_t)(4 * (lane & 7)) * K + 16 * (lane >> 3);
#pragma unroll
    for (int j = 0; j < 4; ++j) { v4u o;
        o.x = pk4_fp8(v[0][j] * 32.f, v[1][j] * 32.f, v[2][j] * 32.f, v[3][j] * 32.f); o.y = pk4_fp8(v[4][j] * 32.f, v[5][j] * 32.f, v[6][j] * 32.f, v[7][j] * 32.f);
        o.z = pk4_fp8(v[8][j] * 32.f, v[9][j] * 32.f, v[10][j] * 32.f, v[11][j] * 32.f); o.w = pk4_fp8(v[12][j] * 32.f, v[13][j] * 32.f, v[14][j] * 32.f, v[15][j] * 32.f);
        *(v4u*)(q + (size_t)j * K) = o; }
}

template <int MODE, bool COMB> __device__ __forceinline__ void ph_norm(const Args& a, const Frame& F, int l) {
    const int gw = F.vcu * 8 + F.wave, NGW = F.G * 8, lane = F.lane;
    float* X = (float*)(a.ws + WS_X); bf16* H = (bf16*)(a.ws + WS_H);
    const float* MOD = (const float*)(a.ws + WS_MOD);
    LAS float* WRt = (LAS float*)F.lds;
    if (MODE == 1) { const float* wr = a.in[30] + (size_t)l * D * NE; for (int i = F.tid; i < D * NE; i += 512) WRt[(i & 15) * 1024 + (i >> 4)] = wr[i]; __syncthreads(); }
    const float* g = MODE == 0 ? a.in[6] + l * D : (MODE == 1 ? a.in[7] + l * D : a.in[34]);
    const int nrows = MODE == 2 ? MLAT : MTOT;
    for (int rowA = gw; rowA < nrows; rowA += 2 * NGW) {
        const int nr = rowA + NGW < nrows ? 2 : 1;
        f32x4 v[2][4]; int myinv[2] = {-1, -1};
#pragma unroll
        for (int h = 0; h < 2; ++h) if (h < nr) { const int row = rowA + h * NGW; const f32x4* xr = (const f32x4*)(X + (size_t)row * D) + lane;
#pragma unroll
            for (int j = 0; j < 4; ++j) v[h][j] = xr[64 * j];
            if (COMB) myinv[h] = ((const int*)(a.ws + WS_INV))[(size_t)row * NE + (lane & 15)]; }
        if (COMB) {
            const int lp = MODE == 2 ? 1 : l - 1;
            const float* SELG = (const float*)(a.ws + WS_SELG); const bf16* YS = (const bf16*)(a.ws + WS_YS);
#pragma unroll
            for (int h = 0; h < 2; ++h) if (h < nr) { const int row = rowA + h * NGW, r = row < MLAT ? (row >> 11) : 8;
                unsigned m = (unsigned)(__ballot(myinv[h] >= 0) & 0xFFFFull);
                f32x4 acc[4];
#pragma unroll
                for (int j = 0; j < 4; ++j) acc[j] = (f32x4){0.f, 0.f, 0.f, 0.f};
                while (m) {
                    int ee[4], ss[4]; float gt[4]; v2u y[4][4];
#pragma unroll
                    for (int k = 0; k < 4; ++k) { ee[k] = m ? __builtin_ctz(m) : -1; if (m) m &= m - 1; ss[k] = ee[k] >= 0 ? __shfl(myinv[h], ee[k] < 0 ? 0 : ee[k]) : 0; }
#pragma unroll
                    for (int k = 0; k < 4; ++k) { const int e = ee[k] < 0 ? 0 : ee[k]; gt[k] = ee[k] >= 0 ? SELG[e * EROWS + ss[k]] : 0.f; const v2u* yr = (const v2u*)(YS + ((size_t)e * EROWS + ss[k]) * D) + lane;
#pragma unroll
                        for (int j = 0; j < 4; ++j) y[k][j] = yr[64 * j]; }
#pragma unroll
                    for (int k = 0; k < 4; ++k)
#pragma unroll
                        for (int j = 0; j < 4; ++j) acc[j] += gt[k] * (f32x4){bflo(y[k][j].x), bfhi(y[k][j].x), bflo(y[k][j].y), bfhi(y[k][j].y)};
                }
                const f32x4* m5 = (const f32x4*)(MOD + ((size_t)lp * 9 + r) * 6144 + 5 * 1024) + lane;
#pragma unroll
                for (int j = 0; j < 4; ++j) v[h][j] += m5[64 * j] * acc[j];
                if (MODE != 2) { f32x4* xw = (f32x4*)(X + (size_t)row * D) + lane;
#pragma unroll
                    for (int j = 0; j < 4; ++j) xw[64 * j] = v[h][j]; } }
        }
#pragma unroll
        for (int h = 0; h < 2; ++h) if (h < nr) { const int row = rowA + h * NGW, r = row < MLAT ? (row >> 11) : 8;
            float ss = 0.f;
#pragma unroll
            for (int j = 0; j < 4; ++j) ss += (v[h][j][0] * v[h][j][0] + v[h][j][1] * v[h][j][1]) + (v[h][j][2] * v[h][j][2] + v[h][j][3] * v[h][j][3]);
            const float rstd = 1.0f / sqrtf(wave_sum(ss) * (1.0f / D) + 1e-6f);
            const f32x4* gp = (const f32x4*)g + lane;
            if (MODE == 2) { f32x4* o = (f32x4*)(a.out + (size_t)row * D) + lane;
#pragma unroll
                for (int j = 0; j < 4; ++j) o[64 * j] = v[h][j] * rstd * gp[64 * j];
            } else {
                const float* mrow = MOD + ((size_t)l * 9 + r) * 6144 + (MODE == 0 ? 0 : 3 * 1024);
                const f32x4* sh = (const f32x4*)mrow + lane; const f32x4* sc = (const f32x4*)(mrow + 1024) + lane;
                v2u* o8 = (v2u*)(H + (size_t)row * D) + lane;
#pragma unroll
                for (int j = 0; j < 4; ++j) { v[h][j] = (v[h][j] * rstd * gp[64 * j]) * (1.0f + sc[64 * j]) + sh[64 * j]; v2u w; w.x = pk2(v[h][j][0], v[h][j][1]); w.y = pk2(v[h][j][2], v[h][j][3]); o8[64 * j] = w; }
                if (MODE == 1) {
                    float p[16];
#pragma unroll
                    for (int e = 0; e < NE; ++e) { float s = 0.f;
#pragma unroll
                        for (int j = 0; j < 4; ++j) { const f32x4 w = *(const LAS f32x4*)(WRt + e * 1024 + 4 * lane + 256 * j); s += (v[h][j][0] * w[0] + v[h][j][1] * w[1]) + (v[h][j][2] * w[2] + v[h][j][3] * w[3]); }
                        p[e] = s; if (e & 1) asm volatile("" ::: "memory"); }
#pragma unroll
                    for (int i = 0; i < 8; ++i) { const bool up = lane & 32; const float keep = up ? p[i + 8] : p[i], send = up ? p[i] : p[i + 8]; p[i] = keep + __shfl_xor(send, 32); }
#pragma unroll
                    for (int i = 0; i < 4; ++i) { const bool up = lane & 16; const float keep = up ? p[i + 4] : p[i], send = up ? p[i] : p[i + 4]; p[i] = keep + __shfl_xor(send, 16); }
#pragma unroll
                    for (int i = 0; i < 2; ++i) { const bool up = lane & 8; const float keep = up ? p[i + 2] : p[i], send = up ? p[i] : p[i + 2]; p[i] = keep + __shfl_xor(send, 8); }
                    { const bool up = lane & 4; const float keep = up ? p[1] : p[0], send = up ? p[0] : p[1]; p[0] = keep + __shfl_xor(send, 4); }
                    float mine = p[0]; mine += __shfl_xor(mine, 1); mine += __shfl_xor(mine, 2);
                    float mx = mine;
#pragma unroll
                    for (int o = 4; o < 64; o <<= 1) mx = fmaxf(mx, __shfl_xor(mx, o));
                    const float pe = expf(mine - mx); float den = pe;
#pragma unroll
                    for (int o = 4; o < 64; o <<= 1) den += __shfl_xor(den, o);
                    if ((lane & 3) == 0) ((float*)(a.ws + WS_AFF))[(size_t)row * NE + (lane >> 2)] = pe / den;
                }
            }
        }
    }
}

__device__ __forceinline__ void ph_rank(const Args& a, const Frame& F, int l) {
    LAS unsigned* part = (LAS unsigned*)F.lds;
    const float* AFF = (const float*)(a.ws + WS_AFF); float* SELG = (float*)(a.ws + WS_SELG); int* INV = (int*)(a.ws + WS_INV);
    const bf16* H = (const bf16*)(a.ws + WS_H); unsigned char* XS = a.ws + WS_XS;
    const int tid = F.tid, lane = F.lane, wave = F.wave;
    const unsigned long long ltmask = (1ull << lane) - 1ull;
    const int nitems = 128 + (l == 0 ? 128 : 0);
    for (int it = F.vcu; it < nitems; it += F.G) {
        const bool isctx = it >= 128; const int r = it & 127, e = r & 15, b = r >> 4;
        const int n = isctx ? CTX : SEQ, cap = isctx ? 32 : 256, row0 = isctx ? MLAT + b * CTX : b * SEQ, slot0 = isctx ? 2048 + b * 32 : b * 256;
        unsigned k[4];
#pragma unroll
        for (int q = 0; q < 4; ++q) { const int j = 4 * tid + q; k[q] = j < n ? __builtin_bit_cast(unsigned, AFF[(size_t)(row0 + j) * NE + e]) : 0u; }
        __syncthreads();
        unsigned prefix = 0u;
#pragma unroll 1
        for (int bit = 28; bit >= 0; bit -= 2) {
            const unsigned c1 = prefix | (1u << bit), c2 = prefix | (2u << bit), c3 = prefix | (3u << bit);
            unsigned n1 = 0, n2 = 0, n3 = 0;
#pragma unroll
            for (int q = 0; q < 4; ++q) { n1 += __popcll(__ballot(k[q] >= c1)); n2 += __popcll(__ballot(k[q] >= c2)); n3 += __popcll(__ballot(k[q] >= c3)); }
            LAS unsigned* pb = part + ((bit >> 1) & 1) * 24;
            if (lane == 0) { pb[wave] = n1; pb[8 + wave] = n2; pb[16 + wave] = n3; }
            __syncthreads();
            const v4u a0 = *(const LAS v4u*)pb, a1 = *(const LAS v4u*)(pb + 4), b0 = *(const LAS v4u*)(pb + 8), b1 = *(const LAS v4u*)(pb + 12), d0 = *(const LAS v4u*)(pb + 16), d1 = *(const LAS v4u*)(pb + 20);
            const unsigned t1 = ((a0.x + a0.y) + (a0.z + a0.w)) + ((a1.x + a1.y) + (a1.z + a1.w)), t2 = ((b0.x + b0.y) + (b0.z + b0.w)) + ((b1.x + b1.y) + (b1.z + b1.w)),
                           t3 = ((d0.x + d0.y) + (d0.z + d0.w)) + ((d1.x + d1.y) + (d1.z + d1.w));
            if ((int)t3 >= cap) prefix = c3; else if ((int)t2 >= cap) prefix = c2; else if ((int)t1 >= cap) prefix = c1;
        }
        const unsigned T = prefix;
        __syncthreads();
        { const unsigned c = __popcll(__ballot(k[0] > T)) + __popcll(__ballot(k[1] > T)) + __popcll(__ballot(k[2] > T)) + __popcll(__ballot(k[3] > T));
          if (lane == 0) part[wave] = c; }
        unsigned long long be[4]; unsigned weq = 0;
#pragma unroll
        for (int q = 0; q < 4; ++q) { be[q] = __ballot(k[q] == T); weq += __popcll(be[q]); }
        if (lane == 0) part[16 + wave] = weq;
        __syncthreads();
        unsigned ngt = 0, eqbase = 0;
#pragma unroll
        for (int w = 0; w < 8; ++w) { ngt += part[w]; if (w < wave) eqbase += part[16 + w]; }
        const int need = cap - (int)ngt;
        unsigned eqrank = eqbase + __popcll(be[0] & ltmask) + __popcll(be[1] & ltmask) + __popcll(be[2] & ltmask) + __popcll(be[3] & ltmask);
        bool sel[4];
#pragma unroll
        for (int q = 0; q < 4; ++q) { const bool eq = k[q] == T; sel[q] = k[q] > T || (eq && (int)eqrank < need); eqrank += eq ? 1u : 0u; }
        __syncthreads();
        unsigned long long bs[4]; unsigned wsel = 0;
#pragma unroll
        for (int q = 0; q < 4; ++q) { bs[q] = __ballot(sel[q]); wsel += __popcll(bs[q]); }
        if (lane == 0) part[wave] = wsel;
        __syncthreads();
        unsigned sbase = 0;
#pragma unroll
        for (int w = 0; w < 8; ++w) if (w < wave) sbase += part[w];
        unsigned srank = sbase + __popcll(bs[0] & ltmask) + __popcll(bs[1] & ltmask) + __popcll(bs[2] & ltmask) + __popcll(bs[3] & ltmask);
        int slot[4];
#pragma unroll
        for (int q = 0; q < 4; ++q) { const int j = 4 * tid + q; slot[q] = -1;
            if (sel[q]) { slot[q] = slot0 + (int)srank; ++srank; SELG[e * EROWS + slot[q]] = __builtin_bit_cast(float, k[q]); }
            if (j < n) INV[(size_t)(row0 + j) * NE + e] = slot[q]; }
        { LAS int* lst = (LAS int*)(part + 64) + wave * 512;
          unsigned wr_ = __popcll(bs[0] & ltmask) + __popcll(bs[1] & ltmask) + __popcll(bs[2] & ltmask) + __popcll(bs[3] & ltmask);
#pragma unroll
          for (int q = 0; q < 4; ++q) if (sel[q]) { lst[2 * wr_] = row0 + 4 * tid + q; lst[2 * wr_ + 1] = slot[q]; ++wr_; }
          LDS_WAIT(); asm volatile("" ::: "memory");
          const int nsel = (int)wsel;
          for (int i0 = 0; i0 < nsel; i0 += 4) { v4u r0[4], r1[4]; int sl[4];
#pragma unroll
              for (int k = 0; k < 4; ++k) { const int i = i0 + k < nsel ? i0 + k : nsel - 1; const int rw = lst[2 * i]; sl[k] = lst[2 * i + 1];
                  const v4u* hp = (const v4u*)(H + (size_t)rw * D) + lane; r0[k] = hp[0]; r1[k] = hp[64]; }
#pragma unroll
              for (int k = 0; k < 4; ++k) { v2u* xp = (v2u*)(XS + ((size_t)e * EROWS + sl[k]) * D) + lane;
                  v2u w0, w1; w0.x = pk4_fp8(bflo(r0[k].x), bfhi(r0[k].x), bflo(r0[k].y), bfhi(r0[k].y)); w0.y = pk4_fp8(bflo(r0[k].z), bfhi(r0[k].z), bflo(r0[k].w), bfhi(r0[k].w));
                  w1.x = pk4_fp8(bflo(r1[k].x), bfhi(r1[k].x), bflo(r1[k].y), bfhi(r1[k].y)); w1.y = pk4_fp8(bflo(r1[k].z), bfhi(r1[k].z), bflo(r1[k].w), bfhi(r1[k].w));
                  xp[0] = w0; xp[64] = w1; } }
        }
        __syncthreads();
    }
}
__device__ __forceinline__ float conv3_at(const bf16* rowp, int t, int L, float w0, float w1, float w2, float bias) {
    const int tm = t > 0 ? t - 1 : 0, tp = t < L - 1 ? t + 1 : L - 1;
    const float vm = bf2f(rowp[tm]), x0 = bf2f(rowp[t]), vp = bf2f(rowp[tp]);
    const float xm = t > 0 ? vm : 0.f, xp = t < L - 1 ? vp : 0.f;
    return w0 * xm + w1 * x0 + w2 * xp + bias;
}
template <int L> __device__ __forceinline__ void hyena_direct_item(const Args& a, const Frame& F, int l, int c) {
    constexpr int NBQ = L == SEQ ? 4 : 8, NPASS = NB / NBQ, TP = L >= 512 ? L / 512 : 1, BP = NBQ * L / 512 / TP;
    constexpr int ROW0 = L == SEQ ? 0 : MLAT;
    LAS float* kk = (LAS float*)F.lds;
    LAS float* ub = kk + 2 * L;
    LAS float* zb = ub + NBQ * L;
    const bf16* HYT = (const bf16*)(a.ws + WS_HYT); bf16* YAT = (bf16*)(a.ws + WS_YAT);
    const float* TF = (const float*)(a.ws + WS_TFC);
    const float* cw = a.in[9] + (size_t)l * 3 * NHY; const float* cb = a.in[10] + (size_t)l * NHY;
    float w[3][3], bs[3];
#pragma unroll
    for (int s = 0; s < 3; ++s) { bs[s] = cb[s * D + c];
#pragma unroll
        for (int k = 0; k < 3; ++k) w[s][k] = cw[k * NHY + s * D + c]; }
    const float hb0 = a.in[17][((size_t)l * 2 + 0) * D + c], hb1 = a.in[17][((size_t)l * 2 + 1) * D + c];
    int tq[TP], bq[BP];
#pragma unroll
    for (int i = 0; i < TP; ++i) tq[i] = L >= 512 ? F.tid + 512 * i : (F.tid & (L - 1));
#pragma unroll
    for (int i = 0; i < BP; ++i) bq[i] = L >= 512 ? i : (F.tid / L) + (512 / L) * i;
    for (int ps = 0; ps < NPASS; ++ps) {
        for (int i = F.tid; i < NBQ * L; i += 512) { const int b = i / L, t = i % L; const bf16* rp = HYT + (size_t)(2 * D + c) * MTOT + ROW0 + (ps * NBQ + b) * L;
            ub[i] = conv3_at(rp, t, L, w[2][0], w[2][1], w[2][2], bs[2]); }
#pragma unroll 1
        for (int o = 0; o < 2; ++o) {
            __syncthreads();
            for (int t = F.tid; t < L; t += 512) { kk[L - 1 + t] = TF[((size_t)(o * 2 + 0) * D + c) * L + t]; if (t > 0) kk[L - 1 - t] = TF[((size_t)(o * 2 + 1) * D + c) * L + t]; }
            __syncthreads();
            const LAS float* src = o == 0 ? ub : zb;
            float acc[TP][BP];
#pragma unroll
            for (int i = 0; i < TP; ++i)
#pragma unroll
                for (int j = 0; j < BP; ++j) acc[i][j] = 0.f;
            for (int s = 0; s < L; ++s) { float kv[TP], uv[BP];
#pragma unroll
                for (int i = 0; i < TP; ++i) kv[i] = kk[tq[i] - s + L - 1];
#pragma unroll
                for (int j = 0; j < BP; ++j) uv[j] = src[bq[j] * L + s];
#pragma unroll
                for (int i = 0; i < TP; ++i)
#pragma unroll
                    for (int j = 0; j < BP; ++j) acc[i][j] += kv[i] * uv[j]; }
            __syncthreads();
#pragma unroll
            for (int i = 0; i < TP; ++i)
#pragma unroll
                for (int j = 0; j < BP; ++j) { const int t = tq[i], b = bq[j]; const int gb = ps * NBQ + b;
                    const bf16* rp = HYT + (size_t)(o * D + c) * MTOT + ROW0 + gb * L;
                    const float xg = o == 0 ? conv3_at(rp, t, L, w[0][0], w[0][1], w[0][2], bs[0]) : conv3_at(rp, t, L, w[1][0], w[1][1], w[1][2], bs[1]);
                    const float uin = src[b * L + t];
                    const float r = xg * (acc[i][j] + uin * (o == 0 ? hb0 : hb1));
                    if (o == 0) zb[b * L + t] = r; else YAT[(size_t)c * MTOT + ROW0 + gb * L + t] = (bf16)f2bf(r); }
        }
        __syncthreads();
    }
}

__device__ __forceinline__ void read8_lds(const LAS unsigned short* row, int tt, float (&o)[8]) {
#pragma unroll
    for (int j = 0; j < 8; ++j) o[j] = bf2f(row[tt + 256 * j]);
}
__device__ __forceinline__ void hy_load_rows(const bf16* HYT, int c, int p, int tt, v4u (&pre)[6], unsigned (&lf)[6], unsigned (&rg)[6]) {
#pragma unroll
    for (int r = 0; r < 6; ++r) { const int f = (r < 2 ? 2 * D : (r < 4 ? 0 : D)) + c, bb = 2 * p + (r & 1); const bf16* rp = HYT + (size_t)f * MTOT + bb * SEQ;
        pre[r] = *(const v4u*)(rp + tt * 8);
        lf[r] = rp[tt > 0 ? 8 * tt - 1 : 0]; rg[r] = rp[tt < 255 ? 8 * tt + 8 : SEQ - 1]; }
}
__device__ __forceinline__ v4u hy_conv_vec(v4u x, unsigned lf, unsigned rg, int tt, float w0, float w1, float w2, float bias) {
    float e[10]; e[0] = tt > 0 ? bf2f((unsigned short)lf) : 0.f; e[1] = bflo(x.x); e[2] = bfhi(x.x); e[3] = bflo(x.y); e[4] = bfhi(x.y); e[5] = bflo(x.z); e[6] = bfhi(x.z); e[7] = bflo(x.w); e[8] = bfhi(x.w);
    e[9] = tt < 255 ? bf2f((unsigned short)rg) : 0.f;
    float y[8];
#pragma unroll
    for (int i = 0; i < 8; ++i) y[i] = w0 * e[i] + w1 * e[i + 1] + w2 * e[i + 2] + bias;
    v4u o; o.x = pg8::cvt_pk_bf16(y[0], y[1]); o.y = pg8::cvt_pk_bf16(y[2], y[3]); o.z = pg8::cvt_pk_bf16(y[4], y[5]); o.w = pg8::cvt_pk_bf16(y[6], y[7]); return o;
}
__device__ __forceinline__ void ph_hyena_fft(const Args& a, const Frame& F, int l) {
    const int team = F.tid >> 8, tt = F.tid & 255;
    LAS cf2* buf = (LAS cf2*)F.lds + team * 4352;
    LAS cf2* tw1 = (LAS cf2*)F.lds + 2 * 4352;
    LAS unsigned short* stage = (LAS unsigned short*)(tw1 + 256) + team * 6 * SEQ;
    c2 tw2[16]; fft_twiddles(F.tid, tw1, tw2);
    const bf16* HYT = (const bf16*)(a.ws + WS_HYT); bf16* YAT = (bf16*)(a.ws + WS_YAT);
    const float* cwb = a.in[9] + (size_t)l * 3 * NHY; const float* cbb = a.in[10] + (size_t)l * NHY;
    v4u pre[6]; unsigned lf[6], rg[6];
    if (F.vcu < D) hy_load_rows(HYT, F.vcu, team, tt, pre, lf, rg);
    for (int c = F.vcu; c < D; c += F.G) {
        const float* cw = cwb + c; const float* cb = cbb + c;
        float w[3][3], bs[3];
#pragma unroll
        for (int s = 0; s < 3; ++s) { bs[s] = cb[s * D];
#pragma unroll
            for (int k = 0; k < 3; ++k) w[s][k] = cw[k * NHY + s * D]; }
        const float hb0 = a.in[17][((size_t)l * 2 + 0) * D + c], hb1 = a.in[17][((size_t)l * 2 + 1) * D + c];
#pragma unroll 1
        for (int pp = 0; pp < 2; ++pp) {
            const int b0 = 2 * (team + 2 * pp), b1 = b0 + 1;
            __syncthreads();
#pragma unroll
            for (int r = 0; r < 6; ++r) { const int s = r < 2 ? 2 : (r < 4 ? 0 : 1);
                *(LAS v4u*)(stage + r * SEQ + tt * 8) = hy_conv_vec(pre[r], lf[r], rg[r], tt, w[s][0], w[s][1], w[s][2], bs[s]); }
            { const int cn = pp == 0 ? c : c + F.G, pn = team + 2 * (pp ^ 1); if (cn < D) hy_load_rows(HYT, cn, pn, tt, pre, lf, rg); }
            __syncthreads();
            float u0[8], u1[8];
            read8_lds(stage + 0 * SEQ, tt, u0); read8_lds(stage + 1 * SEQ, tt, u1);
#pragma unroll 1
            for (int o = 0; o < 2; ++o) {
                cf2 kk[16];
                { const cf2* K = (const cf2*)(a.ws + WS_KF) + (((size_t)l * 2 + o) * D + c) * 4096 + tt;
#pragma unroll
                  for (int k = 0; k < 16; ++k) kk[k] = K[256 * k]; }
                const float hb = o == 0 ? hb0 : hb1;
                c2 v[16];
#pragma unroll
                for (int j = 0; j < 8; ++j) v[j] = (c2){u0[j], u1[j]};
                fft4096<false, true>(v, buf, tt, tw1, tw2);
#pragma unroll
                for (int k = 0; k < 16; ++k) v[k] = c2mulconj(v[k], kk[k]);
                fft4096<false>(v, buf, tt, tw1, tw2);
                float g0[8], g1[8];
                read8_lds(stage + (2 + 2 * o) * SEQ, tt, g0); read8_lds(stage + (3 + 2 * o) * SEQ, tt, g1);
#pragma unroll
                for (int j = 0; j < 8; ++j) { u0[j] = g0[j] * (v[j].x + u0[j] * hb); u1[j] = g1[j] * (-v[j].y + u1[j] * hb); }
            }
            bf16* o0 = YAT + (size_t)c * MTOT + b0 * SEQ + tt; bf16* o1 = YAT + (size_t)c * MTOT + b1 * SEQ + tt;
#pragma unroll
            for (int j = 0; j < 8; ++j) { o0[256 * j] = (bf16)f2bf(u0[j]); o1[256 * j] = (bf16)f2bf(u1[j]); }
        }
    }
    __syncthreads();
}

__device__ __forceinline__ void ph_hyena_ctx(const Args& a, const Frame& F, int l) {
    typedef float f32x2_ __attribute__((ext_vector_type(2)));
    const int team = F.tid >> 8, t = F.tid & 255;
    LAS float* kk = (LAS float*)F.lds + team * 4608;
    LAS float* ub = kk + 512;
    LAS float* zb = ub + 2048;
    const bf16* HYT = (const bf16*)(a.ws + WS_HYT); bf16* YAT = (bf16*)(a.ws + WS_YAT); const float* TF = (const float*)(a.ws + WS_TFC);
    const float* cwb = a.in[9] + (size_t)l * 3 * NHY; const float* cbb = a.in[10] + (size_t)l * NHY;
    for (int it = F.vcu; it < D / 2; it += F.G) {
        const int c = 2 * it + team; const float* cw = cwb + c; const float* cb = cbb + c;
        __syncthreads();
        { const float w0 = cw[2 * D], w1 = cw[NHY + 2 * D], w2 = cw[2 * NHY + 2 * D], bb = cb[2 * D];
          float uu[NB];
#pragma unroll
          for (int b = 0; b < NB; ++b) uu[b] = conv3_at(HYT + (size_t)(2 * D + c) * MTOT + MLAT + b * CTX, t, CTX, w0, w1, w2, bb);
          *(LAS f32x4*)(ub + t * 8) = (f32x4){uu[0], uu[1], uu[2], uu[3]}; *(LAS f32x4*)(ub + t * 8 + 4) = (f32x4){uu[4], uu[5], uu[6], uu[7]}; }
#pragma unroll 1
        for (int o = 0; o < 2; ++o) {
            kk[255 + t] = TF[((size_t)(o * 2 + 0) * D + c) * CTX + t]; if (t > 0) kk[255 - t] = TF[((size_t)(o * 2 + 1) * D + c) * CTX + t];
            const float hb = a.in[17][((size_t)l * 2 + o) * D + c];
            const float w0 = cw[o * D], w1 = cw[NHY + o * D], w2 = cw[2 * NHY + o * D], bb = cb[o * D];
            float xg[NB];
#pragma unroll
            for (int b = 0; b < NB; ++b) xg[b] = conv3_at(HYT + (size_t)(o * D + c) * MTOT + MLAT + b * CTX, t, CTX, w0, w1, w2, bb);
            __syncthreads();
            const LAS float* src = o == 0 ? ub : zb;
            f32x2_ acc[4] = {{0.f, 0.f}, {0.f, 0.f}, {0.f, 0.f}, {0.f, 0.f}};
#pragma unroll 4
            for (int s = 0; s < CTX; ++s) { const float k0 = kk[t + 255 - s]; const f32x2_ kv = {k0, k0};
                const f32x4 ua = *(const LAS f32x4*)(src + s * 8), uc = *(const LAS f32x4*)(src + s * 8 + 4);
                acc[0] += kv * (f32x2_){ua[0], ua[1]}; acc[1] += kv * (f32x2_){ua[2], ua[3]}; acc[2] += kv * (f32x2_){uc[0], uc[1]}; acc[3] += kv * (f32x2_){uc[2], uc[3]}; }
            const f32x4 sa = *(const LAS f32x4*)(src + t * 8), sb = *(const LAS f32x4*)(src + t * 8 + 4);
            float r[NB];
            r[0] = xg[0] * (acc[0][0] + sa[0] * hb); r[1] = xg[1] * (acc[0][1] + sa[1] * hb); r[2] = xg[2] * (acc[1][0] + sa[2] * hb); r[3] = xg[3] * (acc[1][1] + sa[3] * hb);
            r[4] = xg[4] * (acc[2][0] + sb[0] * hb); r[5] = xg[5] * (acc[2][1] + sb[1] * hb); r[6] = xg[6] * (acc[3][0] + sb[2] * hb); r[7] = xg[7] * (acc[3][1] + sb[3] * hb);
            __syncthreads();
            if (o == 0) { *(LAS f32x4*)(zb + t * 8) = (f32x4){r[0], r[1], r[2], r[3]}; *(LAS f32x4*)(zb + t * 8 + 4) = (f32x4){r[4], r[5], r[6], r[7]}; }
            else {
#pragma unroll
                for (int b = 0; b < NB; ++b) YAT[(size_t)c * MTOT + MLAT + b * CTX + t] = (bf16)f2bf(r[b]); }
        }
    }
    __syncthreads();
}

__device__ __forceinline__ void ph_sc(const Args& a, const Frame& F, int l, int nrows) {
    const int gw = F.vcu * 8 + F.wave, NGW = F.G * 8, lane = F.lane;
    const bf16* PR = (const bf16*)(a.ws + WS_PR); bf16* YC = (bf16*)(a.ws + WS_YCAT) + 2ull * MTOT * D;
    const float* cw = a.in[25] + (size_t)l * 3 * D;
    float w[3][16];
#pragma unroll
    for (int k = 0; k < 3; ++k)
#pragma unroll
        for (int j = 0; j < 16; ++j) w[k][j] = cw[k * D + lane * 16 + j];
    v4u q[8];
#define SC_LOAD(ROW) { const int r_ = (ROW) < nrows ? (ROW) : nrows - 1, rm_ = r_ > 0 ? r_ - 1 : 0, rp_ = r_ < nrows - 1 ? r_ + 1 : r_; \
        const bf16* pc_ = PR + (size_t)r_ * NPR + PR_P + lane * 16; const bf16* pm_ = PR + (size_t)rm_ * NPR + PR_P + lane * 16; const bf16* pn_ = PR + (size_t)rp_ * NPR + PR_P + lane * 16; \
        const bf16* bp_ = PR + (size_t)r_ * NPR + PR_BG + lane * 16; \
        q[0] = *(const v4u*)pm_; q[1] = *(const v4u*)(pm_ + 8); q[2] = *(const v4u*)pn_; q[3] = *(const v4u*)(pn_ + 8); q[4] = *(const v4u*)pc_; q[5] = *(const v4u*)(pc_ + 8); q[6] = *(const v4u*)bp_; q[7] = *(const v4u*)(bp_ + 8); }
    SC_LOAD(gw)
    for (int row = gw; row < nrows; row += NGW) {
        const int L = row < MLAT ? SEQ : CTX, t = row < MLAT ? (row & (SEQ - 1)) : ((row - MLAT) & (CTX - 1));
        const v4u z = (v4u){0u, 0u, 0u, 0u};
        const v4u m0 = t > 0 ? q[0] : z, m1 = t > 0 ? q[1] : z, n0 = t < L - 1 ? q[2] : z, n1 = t < L - 1 ? q[3] : z, c0 = q[4], c1 = q[5], g0 = q[6], g1 = q[7];
        SC_LOAD(row + NGW)
        unsigned mm[8] = {m0.x, m0.y, m0.z, m0.w, m1.x, m1.y, m1.z, m1.w}, cc[8] = {c0.x, c0.y, c0.z, c0.w, c1.x, c1.y, c1.z, c1.w}, nn[8] = {n0.x, n0.y, n0.z, n0.w, n1.x, n1.y, n1.z, n1.w}, gg[8] = {g0.x, g0.y, g0.z, g0.w, g1.x, g1.y, g1.z, g1.w};
        unsigned o[8];
#pragma unroll
        for (int j = 0; j < 8; ++j) {
            const float lo = bflo(gg[j]) * (w[0][2 * j] * bflo(mm[j]) + w[1][2 * j] * bflo(cc[j]) + w[2][2 * j] * bflo(nn[j]));
            const float hi = bfhi(gg[j]) * (w[0][2 * j + 1] * bfhi(mm[j]) + w[1][2 * j + 1] * bfhi(cc[j]) + w[2][2 * j + 1] * bfhi(nn[j]));
            o[j] = pk2(lo, hi); }
        v4u* op = (v4u*)(YC + (size_t)row * D + lane * 16); op[0] = (v4u){o[0], o[1], o[2], o[3]}; op[1] = (v4u){o[4], o[5], o[6], o[7]};
    }
#undef SC_LOAD
}

__device__ __forceinline__ void ph_transpose_ya(const Args& a, const Frame& F, int nrows) {
    const int gw = F.vcu * 8 + F.wave, NGW = F.G * 8, lane = F.lane;
    LAS unsigned short* tl = (LAS unsigned short*)(F.lds + F.wave * 16384);
    const bf16* YAT = (const bf16*)(a.ws + WS_YAT); bf16* YA = (bf16*)(a.ws + WS_YCAT);
    const int nitems = (nrows / 64) * 16;
    for (int it = gw; it < nitems; it += NGW) {
        const int tb = it >> 4, cb = it & 15, tok0 = tb * 64, c0 = cb * 64;
        v4u r[8];
#pragma unroll
        for (int k = 0; k < 8; ++k) r[k] = *(const v4u*)(YAT + (size_t)(c0 + (lane >> 3) + 8 * k) * MTOT + tok0 + (lane & 7) * 8);
#pragma unroll
        for (int k = 0; k < 8; ++k) *(LAS v4u*)(tl + ((lane >> 3) + 8 * k) * 72 + (lane & 7) * 8) = r[k];
        LDS_WAIT(); asm volatile("" ::: "memory");
        unsigned o[32];
#pragma unroll
        for (int j = 0; j < 32; ++j) o[j] = (unsigned)tl[(2 * j) * 72 + lane] | ((unsigned)tl[(2 * j + 1) * 72 + lane] << 16);
        v4u* op = (v4u*)(YA + (size_t)(tok0 + lane) * D + c0);
#pragma unroll
        for (int j = 0; j < 8; ++j) op[j] = (v4u){o[4 * j], o[4 * j + 1], o[4 * j + 2], o[4 * j + 3]};
        LDS_WAIT(); asm volatile("" ::: "memory");
    }
}

__device__ __forceinline__ float neg_expm1_(float x) { return x > -0.02f ? -(x * (1.0f + x * (0.5f + x * 0.16666667f))) : 1.0f - __expf(x); }
template <int PASS> __device__ __forceinline__ void lru_item(const Args& a, const Frame& F, int l, int q, int hd) {
    LAS float* raw = (LAS float*)F.lds;
    LAS float* xc = raw + 67 * 64;
    LAS float* GT = xc + 64 * 65;
    LAS float* SA = GT + 4 * 64 * 65;
    LAS float* CIN = SA + 2 * 4 * 64 * 2;
    LAS unsigned short* xcb = (LAS unsigned short*)(CIN + 128);
    const bf16* PR = (const bf16*)(a.ws + WS_PR);
    const bool isctx = q >= 256; const int b = isctx ? (q - 256) >> 2 : q >> 5, qi = isctx ? (q - 256) & 3 : q & 31;
    const int L = isctx ? CTX : SEQ, seq0 = isctx ? MLAT + b * CTX : b * SEQ, t0 = qi * 64, c0 = hd * 64;
    const int tid = F.tid, lane = F.lane, wave = F.wave;
    const int fr = lane & 15, fq = lane >> 4, gdir = wave >> 2, gax = (wave >> 1) & 1, jb = (wave & 1) * 32;
    float* AGG = (float*)(a.ws + WS_AGG); bf16* LAB = (bf16*)(a.ws + WS_LAB);
    v4u rv[2];
#pragma unroll
    for (int k = 0; k < 2; ++k) { const int i = tid + 512 * k, tr = i >> 3, sg = i & 7, t = t0 - 2 + tr; rv[k] = (v4u){0u, 0u, 0u, 0u};
        if (i < 67 * 8 && t >= 0 && t < L) rv[k] = *(const v4u*)(PR + (unsigned)((seq0 + t) * NPR + PR_REC + c0 + sg * 8)); }
    const int ch = tid & 63;
    const float* cw = a.in[18] + (size_t)l * 4 * D + c0 + ch; const float cw0 = cw[0], cw1 = cw[D], cw2 = cw[2 * D], cw3 = cw[3 * D], cbb = a.in[19][(size_t)l * D + c0 + ch];
    const float* SP = (const float*)(a.ws + WS_SP) + (size_t)l * 2 * D + c0 + 2 * (tid & 31);
    const c2 spm0 = *(const c2*)SP * (c2){-8.0f, -8.0f}, spm1 = *(const c2*)(SP + D) * (c2){-8.0f, -8.0f};
    bf16x8 Bf[2][2]; f32x4 bv[2];
    { const bf16* Wc = (const bf16*)(a.ws + WS_WLRU) + (((size_t)l * 16 + hd) * 256 + 32 * wave) * 64;
#pragma unroll
      for (int nt = 0; nt < 2; ++nt)
#pragma unroll
          for (int ks = 0; ks < 2; ++ks) Bf[nt][ks] = *(const bf16x8*)(Wc + (nt * 16 + fr) * 64 + ks * 32 + fq * 8);
      const float* bias = (gax ? a.in[23] : a.in[21]) + ((size_t)l * 2 + gdir) * D + c0 + jb;
#pragma unroll
      for (int nt = 0; nt < 2; ++nt) bv[nt] = *(const f32x4*)(bias + nt * 16 + 4 * fq); }
    v4u gg = (v4u){0u, 0u, 0u, 0u}; float hcar = 0.f;
    if (PASS == 2) {
        gg = *(const v4u*)(PR + ((size_t)seq0 + t0 + (tid >> 3)) * NPR + PR_GELU + c0 + (tid & 7) * 8);
        if (tid < 128) {
            const int dir = tid >> 6; const float* ag = AGG + ((size_t)dir * NCHUNK) * D * 2 + (size_t)(c0 + ch) * 2;
            const int cbase = 256 + b * 4, lbase = b * 32;
            float ga[35], gb[35];
#pragma unroll
            for (int p = 0; p < 35; ++p) { int chunk; bool valid;
                if (isctx) { chunk = dir == 0 ? cbase + p : cbase + 3 - p; valid = dir == 0 ? p < qi : p < 3 - qi; }
                else if (p < 4) { chunk = dir == 0 ? cbase + p : cbase + 3 - p; valid = true; }
                else { chunk = dir == 0 ? lbase + (p - 4) : lbase + 31 - (p - 4); valid = dir == 0 ? (p - 4) < qi : (p - 4) < 31 - qi; }
                if (p >= 4 && isctx) valid = false;
                ga[p] = 1.f; gb[p] = 0.f;
                if (valid) { const f32x2 g = *(const f32x2*)(ag + (size_t)chunk * D * 2); ga[p] = g[0]; gb[p] = g[1]; } }
#pragma unroll
            for (int p = 0; p < 35; ++p) hcar = ga[p] * hcar + gb[p];
        }
    }
    __syncthreads();
#pragma unroll
    for (int k = 0; k < 2; ++k) { const int i = tid + 512 * k; if (i < 67 * 8) { const v4u r = rv[k];
        LAS float* d = raw + (i >> 3) * 64 + (i & 7) * 8; d[0] = bflo(r.x); d[1] = bfhi(r.x); d[2] = bflo(r.y); d[3] = bfhi(r.y); d[4] = bflo(r.z); d[5] = bfhi(r.z); d[6] = bflo(r.w); d[7] = bfhi(r.w); } }
    if (PASS == 2 && tid < 128) CIN[tid] = hcar;
    __syncthreads();
#pragma unroll
    for (int k = 0; k < 8; ++k) { const int tt = (tid >> 6) + 8 * k;
        const float x = cw0 * raw[tt * 64 + ch] + cw1 * raw[(tt + 1) * 64 + ch] + cw2 * raw[(tt + 2) * 64 + ch] + cw3 * raw[(tt + 3) * 64 + ch] + cbb;
        xc[tt * 65 + ch] = x; xcb[tt * 72 + ch] = (unsigned short)f2bf(x); }
    __syncthreads();
    {
      LAS float* gp = GT + (gdir * 2 + gax) * 64 * 65 + jb + 4 * fq;
#pragma unroll
      for (int mt = 0; mt < 4; ++mt) { f32x4 acc[2] = {bv[0], bv[1]};
#pragma unroll
          for (int ks = 0; ks < 2; ++ks) { const bf16x8 Af = *(const LAS bf16x8*)(xcb + (mt * 16 + fr) * 72 + ks * 32 + fq * 8);
#pragma unroll
              for (int nt = 0; nt < 2; ++nt) acc[nt] = __builtin_amdgcn_mfma_f32_16x16x32_bf16(Bf[nt][ks], Af, acc[nt], 0, 0, 0); }
#pragma unroll
          for (int nt = 0; nt < 2; ++nt)
#pragma unroll
              for (int r = 0; r < 4; ++r) gp[(mt * 16 + fr) * 65 + nt * 16 + r] = sigmoidf_(acc[nt][r]); } }
    __syncthreads();
    {
      const int cp = tid & 31;
#pragma unroll
      for (int k = 0; k < 8; ++k) { const int dir = k >> 2, tt = (tid >> 5) + 16 * (k & 3);
          LAS float* pr = GT + (dir * 2) * 64 * 65 + tt * 65 + 2 * cp; LAS float* pi = pr + 64 * 65;
          const c2 r = (c2){pr[0], pr[1]}, iv = (c2){pi[0], pi[1]}, xv = (c2){xc[tt * 65 + 2 * cp], xc[tt * 65 + 2 * cp + 1]};
          const c2 la = r * (dir ? spm1 : spm0);
          const unsigned labp = pg8::cvt_pk_bf16(la.x, la.y);
          const c2 lar = (c2){__builtin_bit_cast(float, labp << 16), __builtin_bit_cast(float, labp & 0xffff0000u)};
          const c2 ex = lar * (c2){1.4426950408889634f, 1.4426950408889634f};
          const c2 av = (c2){__builtin_amdgcn_exp2f(ex.x), __builtin_amdgcn_exp2f(ex.y)}, x2 = lar + lar;
          const c2 one = (c2){1.0f, 1.0f};
          const c2 pol = -(x2 * (one + x2 * ((c2){0.5f, 0.5f} + x2 * (c2){0.16666667f, 0.16666667f}))), sq = one - av * av;
          const c2 om = (c2){x2.x > -0.02f ? pol.x : sq.x, x2.y > -0.02f ? pol.y : sq.y};
          const c2 bv0 = (c2){__builtin_amdgcn_sqrtf(om.x), __builtin_amdgcn_sqrtf(om.y)} * (iv * xv);
          const unsigned bbp = pg8::cvt_pk_bf16(bv0.x, bv0.y);
          pr[0] = av.x; pr[1] = av.y; pi[0] = __builtin_bit_cast(float, bbp << 16); pi[1] = __builtin_bit_cast(float, bbp & 0xffff0000u);
          if (PASS == 1) { unsigned* lp = (unsigned*)(LAB + (unsigned)((dir * 2 * MTOT + seq0 + t0 + tt) * D + c0 + 2 * cp)); lp[0] = labp; lp[(size_t)MTOT * D / 2] = bbp; } } }
    __syncthreads();
    const int sdir = tid >> 8, ssq = (tid >> 6) & 3, sch = tid & 63;
    const int tfirst = sdir == 0 ? 16 * ssq : 63 - 16 * ssq, tstep = sdir == 0 ? 1 : -1;
    LAS float* pa = GT + (sdir * 2) * 64 * 65 + sch; LAS float* pb = pa + 64 * 65;
    { float h = 0.f, ap = 1.f;
#pragma unroll
      for (int s = 0; s < 16; ++s) { const int tt = tfirst + tstep * s; const float av = pa[tt * 65]; h = av * h + pb[tt * 65]; ap *= av; }
      SA[((sdir * 4 + ssq) * 64 + sch) * 2] = ap; SA[((sdir * 4 + ssq) * 64 + sch) * 2 + 1] = h; }
    __syncthreads();
    if (PASS == 1) {
        if (tid < 128) { const int dir = tid >> 6; float h = 0.f, ap = 1.f;
#pragma unroll
            for (int s = 0; s < 4; ++s) { const float sa = SA[((dir * 4 + s) * 64 + ch) * 2], sb = SA[((dir * 4 + s) * 64 + ch) * 2 + 1]; h = sa * h + sb; ap *= sa; }
            *(f32x2*)(AGG + (((size_t)dir * NCHUNK + q) * D + c0 + ch) * 2) = (f32x2){ap, h}; }
    } else {
        float h = CIN[sdir * 64 + sch];
#pragma unroll
        for (int s = 0; s < 3; ++s) if (s < ssq) { const float sa = SA[((sdir * 4 + s) * 64 + sch) * 2], sb = SA[((sdir * 4 + s) * 64 + sch) * 2 + 1]; h = sa * h + sb; }
#pragma unroll
        for (int s = 0; s < 16; ++s) { const int tt = tfirst + tstep * s; h = pa[tt * 65] * h + pb[tt * 65]; pb[tt * 65] = h; }
        __syncthreads();
        bf16* YB = (bf16*)(a.ws + WS_YCAT) + (size_t)MTOT * D;
        { const int tt = tid >> 3, sg = tid & 7; const size_t row = (size_t)seq0 + t0 + tt; const v4u g = gg;
          const LAS float* hf = GT + (0 * 2 + 1) * 64 * 65 + tt * 65 + sg * 8; const LAS float* hb = GT + (1 * 2 + 1) * 64 * 65 + tt * 65 + sg * 8;
          v4u o; o.x = pk2(bflo(g.x) * (hf[0] + hb[0]), bfhi(g.x) * (hf[1] + hb[1])); o.y = pk2(bflo(g.y) * (hf[2] + hb[2]), bfhi(g.y) * (hf[3] + hb[3]));
          o.z = pk2(bflo(g.z) * (hf[4] + hb[4]), bfhi(g.z) * (hf[5] + hb[5])); o.w = pk2(bflo(g.w) * (hf[6] + hb[6]), bfhi(g.w) * (hf[7] + hb[7]));
          *(v4u*)(YB + row * D + c0 + sg * 8) = o; }
    }
}

__device__ __forceinline__ void lru_rows(const bf16* PR, int it, int tid, v4u (&rv)[2]) {
    const int q = it >> 4, hd = it & 15; const bool isctx = q >= 256; const int b = isctx ? (q - 256) >> 2 : q >> 5, qi = isctx ? (q - 256) & 3 : q & 31;
    const int L = isctx ? CTX : SEQ, seq0 = isctx ? MLAT + b * CTX : b * SEQ, t0 = qi * 64, c0 = hd * 64;
#pragma unroll
    for (int k = 0; k < 2; ++k) { const int i = tid + 512 * k, tr = (i >> 3) < 66 ? (i >> 3) : 66, sg = i & 7; int t = t0 - 2 + tr; t = t < 0 ? 0 : (t > L - 1 ? L - 1 : t);
        rv[k] = *(const v4u*)(PR + (unsigned)((seq0 + t) * NPR + PR_REC + c0 + sg * 8)); }
}
__device__ __forceinline__ void ph_lru1(const Args& a, const Frame& F, int l) {
    constexpr int PASS = 1;
    LAS float* raw = (LAS float*)F.lds;
    LAS float* xc = raw + 67 * 64;
    LAS float* GT = xc + 64 * 65;
    LAS float* SA = GT + 4 * 64 * 65;
    LAS float* CIN = SA + 2 * 4 * 64 * 2;
    LAS unsigned short* xcb = (LAS unsigned short*)(CIN + 128);
    const bf16* PR = (const bf16*)(a.ws + WS_PR);
    const int tid = F.tid, lane = F.lane, wave = F.wave, ch = tid & 63;
    const int fr = lane & 15, fq = lane >> 4, gdir = wave >> 2, gax = (wave >> 1) & 1, jb = (wave & 1) * 32;
    float* AGG = (float*)(a.ws + WS_AGG); bf16* LAB = (bf16*)(a.ws + WS_LAB);
    constexpr int NIT = NCHUNK * 16;
    if (F.vcu >= NIT) return;
    const int hd = F.vcu & 15, c0 = hd * 64;
    const float* cw = a.in[18] + (size_t)l * 4 * D + c0 + ch; const float cw0 = cw[0], cw1 = cw[D], cw2 = cw[2 * D], cw3 = cw[3 * D], cbb = a.in[19][(size_t)l * D + c0 + ch];
    const float* SP = (const float*)(a.ws + WS_SP) + (size_t)l * 2 * D + c0 + 2 * (tid & 31);
    const c2 spm0 = *(const c2*)SP * (c2){-8.0f, -8.0f}, spm1 = *(const c2*)(SP + D) * (c2){-8.0f, -8.0f};
    bf16x8 Bf[2][2]; f32x4 bv[2];
    { const bf16* Wc = (const bf16*)(a.ws + WS_WLRU) + (((size_t)l * 16 + hd) * 256 + 32 * wave) * 64;
#pragma unroll
      for (int nt = 0; nt < 2; ++nt)
#pragma unroll
          for (int ks = 0; ks < 2; ++ks) Bf[nt][ks] = *(const bf16x8*)(Wc + (nt * 16 + fr) * 64 + ks * 32 + fq * 8);
      const float* bias = (gax ? a.in[23] : a.in[21]) + ((size_t)l * 2 + gdir) * D + c0 + jb;
#pragma unroll
      for (int nt = 0; nt < 2; ++nt) bv[nt] = *(const f32x4*)(bias + nt * 16 + 4 * fq); }
    v4u rv[2];
    lru_rows(PR, F.vcu, tid, rv);
    for (int it = F.vcu; it < NIT; it += F.G) {
        const int q = it >> 4;
        const bool isctx = q >= 256; const int b = isctx ? (q - 256) >> 2 : q >> 5, qi = isctx ? (q - 256) & 3 : q & 31;
        const int L = isctx ? CTX : SEQ, seq0 = isctx ? MLAT + b * CTX : b * SEQ, t0 = qi * 64;
        __syncthreads();
#pragma unroll
        for (int k = 0; k < 2; ++k) { const int i = tid + 512 * k, t = t0 - 2 + (i >> 3); if (i < 67 * 8) { v4u r = rv[k]; if (t < 0 || t >= L) r = (v4u){0u, 0u, 0u, 0u};
            LAS float* d = raw + (i >> 3) * 64 + (i & 7) * 8; d[0] = bflo(r.x); d[1] = bfhi(r.x); d[2] = bflo(r.y); d[3] = bfhi(r.y); d[4] = bflo(r.z); d[5] = bfhi(r.z); d[6] = bflo(r.w); d[7] = bfhi(r.w); } }
        { const int itn = it + F.G < NIT ? it + F.G : it; lru_rows(PR, itn, tid, rv); }
        __syncthreads();
#pragma unroll
        for (int k = 0; k < 8; ++k) { const int tt = (tid >> 6) + 8 * k;
            const float x = cw0 * raw[tt * 64 + ch] + cw1 * raw[(tt + 1) * 64 + ch] + cw2 * raw[(tt + 2) * 64 + ch] + cw3 * raw[(tt + 3) * 64 + ch] + cbb;
            xc[tt * 65 + ch] = x; xcb[tt * 72 + ch] = (unsigned short)f2bf(x); }
        __syncthreads();
        {
          LAS float* gp = GT + (gdir * 2 + gax) * 64 * 65 + jb + 4 * fq;
#pragma unroll
          for (int mt = 0; mt < 4; ++mt) { f32x4 acc[2] = {bv[0], bv[1]};
#pragma unroll
              for (int ks = 0; ks < 2; ++ks) { const bf16x8 Af = *(const LAS bf16x8*)(xcb + (mt * 16 + fr) * 72 + ks * 32 + fq * 8);
#pragma unroll
                  for (int nt = 0; nt < 2; ++nt) acc[nt] = __builtin_amdgcn_mfma_f32_16x16x32_bf16(Bf[nt][ks], Af, acc[nt], 0, 0, 0); }
#pragma unroll
              for (int nt = 0; nt < 2; ++nt)
#pragma unroll
                  for (int r = 0; r < 4; ++r) gp[(mt * 16 + fr) * 65 + nt * 16 + r] = sigmoidf_(acc[nt][r]); } }
        __syncthreads();
        {
          const int cp = tid & 31;
#pragma unroll
          for (int k = 0; k < 8; ++k) { const int dir = k >> 2, tt = (tid >> 5) + 16 * (k & 3);
              LAS float* pr = GT + (dir * 2) * 64 * 65 + tt * 65 + 2 * cp; LAS float* pi = pr + 64 * 65;
              const c2 r = (c2){pr[0], pr[1]}, iv = (c2){pi[0], pi[1]}, xv = (c2){xc[tt * 65 + 2 * cp], xc[tt * 65 + 2 * cp + 1]};
              const c2 la = r * (dir ? spm1 : spm0);
              const unsigned labp = pg8::cvt_pk_bf16(la.x, la.y);
              const c2 lar = (c2){__builtin_bit_cast(float, labp << 16), __builtin_bit_cast(float, labp & 0xffff0000u)};
              const c2 ex = lar * (c2){1.4426950408889634f, 1.4426950408889634f};
              const c2 av = (c2){__builtin_amdgcn_exp2f(ex.x), __builtin_amdgcn_exp2f(ex.y)}, x2 = lar + lar;
              const c2 one = (c2){1.0f, 1.0f};
              const c2 pol = -(x2 * (one + x2 * ((c2){0.5f, 0.5f} + x2 * (c2){0.16666667f, 0.16666667f}))), sq = one - av * av;
              const c2 om = (c2){x2.x > -0.02f ? pol.x : sq.x, x2.y > -0.02f ? pol.y : sq.y};
              const c2 bv0 = (c2){__builtin_amdgcn_sqrtf(om.x), __builtin_amdgcn_sqrtf(om.y)} * (iv * xv);
              const unsigned bbp = pg8::cvt_pk_bf16(bv0.x, bv0.y);
              pr[0] = av.x; pr[1] = av.y; pi[0] = __builtin_bit_cast(float, bbp << 16); pi[1] = __builtin_bit_cast(float, bbp & 0xffff0000u);
              { unsigned* lp = (unsigned*)(LAB + (unsigned)((dir * 2 * MTOT + seq0 + t0 + tt) * D + c0 + 2 * cp)); lp[0] = labp; lp[(size_t)MTOT * D / 2] = bbp; } } }
        __syncthreads();
        const int sdir = tid >> 8, ssq = (tid >> 6) & 3, sch = tid & 63;
        const int tfirst = sdir == 0 ? 16 * ssq : 63 - 16 * ssq, tstep = sdir == 0 ? 1 : -1;
        LAS float* pa = GT + (sdir * 2) * 64 * 65 + sch; LAS float* pb = pa + 64 * 65;
        { float h = 0.f, ap = 1.f;
#pragma unroll
          for (int s = 0; s < 16; ++s) { const int tt = tfirst + tstep * s; const float av = pa[tt * 65]; h = av * h + pb[tt * 65]; ap *= av; }
          SA[((sdir * 4 + ssq) * 64 + sch) * 2] = ap; SA[((sdir * 4 + ssq) * 64 + sch) * 2 + 1] = h; }
        __syncthreads();

            if (tid < 128) { const int dir = tid >> 6; float h = 0.f, ap = 1.f;
#pragma unroll
                for (int s = 0; s < 4; ++s) { const float sa = SA[((dir * 4 + s) * 64 + ch) * 2], sb = SA[((dir * 4 + s) * 64 + ch) * 2 + 1]; h = sa * h + sb; ap *= sa; }
                *(f32x2*)(AGG + (((size_t)dir * NCHUNK + q) * D + c0 + ch) * 2) = (f32x2){ap, h}; }

    }
}
__device__ __forceinline__ void lru_item_p2(const Args& a, const Frame& F, int l, int q, int hd, int wit) {
    LAS float* GT = (LAS float*)F.lds;
    LAS float* SA = GT + 4 * 64 * 65;
    LAS float* CIN = SA + 2 * 4 * 64 * 2;
    const bf16* PR = (const bf16*)(a.ws + WS_PR); const bf16* LAB = (const bf16*)(a.ws + WS_LAB); const float* AGG = (const float*)(a.ws + WS_AGG);
    const bool isctx = q >= 256; const int b = isctx ? (q - 256) >> 2 : q >> 5, qi = isctx ? (q - 256) & 3 : q & 31;
    const int seq0 = isctx ? MLAT + b * CTX : b * SEQ, t0 = qi * 64, c0 = hd * 64;
    const int tid = F.tid, ch = tid & 63;
    v4u lv[4];
#pragma unroll
    for (int k = 0; k < 4; ++k) { const int tt = (tid >> 3) & 63, sg = tid & 7; lv[k] = *(const v4u*)(LAB + ((size_t)k * MTOT + seq0 + t0 + tt) * D + c0 + sg * 8); }
    const v4u gg = *(const v4u*)(PR + ((size_t)seq0 + t0 + (tid >> 3)) * NPR + PR_GELU + c0 + (tid & 7) * 8);
    float hcar = 0.f;
    if (tid < 128) { const int dir = tid >> 6; const float* ag = AGG + ((size_t)dir * NCHUNK) * D * 2 + (size_t)(c0 + ch) * 2;
        const int cbase = 256 + b * 4, lbase = b * 32;
        float ga[35], gb[35];
#pragma unroll
        for (int p = 0; p < 35; ++p) { int chunk; bool valid;
            if (isctx) { chunk = dir == 0 ? cbase + p : cbase + 3 - p; valid = dir == 0 ? p < qi : p < 3 - qi; }
            else if (p < 4) { chunk = dir == 0 ? cbase + p : cbase + 3 - p; valid = true; }
            else { chunk = dir == 0 ? lbase + (p - 4) : lbase + 31 - (p - 4); valid = dir == 0 ? (p - 4) < qi : (p - 4) < 31 - qi; }
            if (p >= 4 && isctx) valid = false;
            ga[p] = 1.f; gb[p] = 0.f;
            if (valid) { const f32x2 g = *(const f32x2*)(ag + (size_t)chunk * D * 2); ga[p] = g[0]; gb[p] = g[1]; } }
#pragma unroll
        for (int p = 0; p < 35; ++p) hcar = ga[p] * hcar + gb[p]; }
    f32x4 wv[16]; unsigned char* wd = nullptr; size_t wK = 0; const bool have = wit < NITW;
    if (have) wx_load(a, l, wit, F.lane, wv, wd, wK);
    __syncthreads();
    { const int tt = tid >> 3, sg = tid & 7;
#pragma unroll
      for (int k = 0; k < 4; ++k) { LAS float* d = GT + k * 64 * 65 + tt * 65 + sg * 8; const v4u r = lv[k];
          float f[8] = {bflo(r.x), bfhi(r.x), bflo(r.y), bfhi(r.y), bflo(r.z), bfhi(r.z), bflo(r.w), bfhi(r.w)};
#pragma unroll
          for (int j = 0; j < 8; ++j) d[j] = (k & 1) ? f[j] : __expf(f[j]); } }
    if (tid < 128) CIN[tid] = hcar;
    __syncthreads();
    const int sdir = tid >> 8, ssq = (tid >> 6) & 3, sch = tid & 63;
    const int tfirst = sdir == 0 ? 16 * ssq : 63 - 16 * ssq, tstep = sdir == 0 ? 1 : -1;
    LAS float* pa = GT + (sdir * 2) * 64 * 65 + sch; LAS float* pb = pa + 64 * 65;
    float av[16], bw[16];
    { float h = 0.f, ap = 1.f;
#pragma unroll
      for (int s = 0; s < 16; ++s) { const int tt = tfirst + tstep * s; av[s] = pa[tt * 65]; bw[s] = pb[tt * 65]; h = av[s] * h + bw[s]; ap *= av[s]; }
      SA[((sdir * 4 + ssq) * 64 + sch) * 2] = ap; SA[((sdir * 4 + ssq) * 64 + sch) * 2 + 1] = h; }
    __syncthreads();
    { float h = CIN[sdir * 64 + sch];
#pragma unroll
      for (int s = 0; s < 3; ++s) if (s < ssq) { const float sa = SA[((sdir * 4 + s) * 64 + sch) * 2], sb = SA[((sdir * 4 + s) * 64 + sch) * 2 + 1]; h = sa * h + sb; }
#pragma unroll
      for (int s = 0; s < 16; ++s) { const int tt = tfirst + tstep * s; h = av[s] * h + bw[s]; pb[tt * 65] = h; } }
    __syncthreads();
    bf16* YB = (bf16*)(a.ws + WS_YCAT) + (size_t)MTOT * D;
    { const int tt = tid >> 3, sg = tid & 7; const size_t row = (size_t)seq0 + t0 + tt; const v4u g = gg;
      const LAS float* hf = GT + (0 * 2 + 1) * 64 * 65 + tt * 65 + sg * 8; const LAS float* hb = GT + (1 * 2 + 1) * 64 * 65 + tt * 65 + sg * 8;
      v4u o; o.x = pk2(bflo(g.x) * (hf[0] + hb[0]), bfhi(g.x) * (hf[1] + hb[1])); o.y = pk2(bflo(g.y) * (hf[2] + hb[2]), bfhi(g.y) * (hf[3] + hb[3]));
      o.z = pk2(bflo(g.z) * (hf[4] + hb[4]), bfhi(g.z) * (hf[5] + hb[5])); o.w = pk2(bflo(g.w) * (hf[6] + hb[6]), bfhi(g.w) * (hf[7] + hb[7]));
      *(v4u*)(YB + row * D + c0 + sg * 8) = o; }
    if (have) wx_store(wv, wd, wK, F.lane);
}
#ifndef REP_LRU1
#define REP_LRU1 1
#endif
#ifndef REP_HY
#define REP_HY 1
#endif
#ifndef REP_CTX
#define REP_CTX 1
#endif
#ifndef REP_SC
#define REP_SC 1
#endif
#ifndef REP_LRU2
#define REP_LRU2 1
#endif
#ifndef REP_TR
#define REP_TR 1
#endif
#ifndef REP_NORM2
#define REP_NORM2 1
#endif
#ifndef REP_RANK
#define REP_RANK 1
#endif
#ifndef MK_SINGLE
#define MK_SINGLE 1
#endif
__global__ void __launch_bounds__(512, 2) mk_fwd(Args args) {
    extern __shared__ __attribute__((aligned(16))) unsigned char lds[];
    Frame F;
    F.lds = (LAS unsigned char*)lds;
    F.tid = threadIdx.x; F.lane = F.tid & 63; F.wave = __builtin_amdgcn_readfirstlane(F.tid >> 6);
    F.G = gridDim.x; { const int bx = blockIdx.x; F.vcu = (F.G % 8 == 0) ? (bx % 8) * (F.G / 8) + bx / 8 : bx; }
    volatile LAS unsigned* MISC = (volatile LAS unsigned*)(F.lds + MISC_OFF);
    for (int u = F.tid; u < 32; u += 512) MISC[u] = 0u;
    __syncthreads();
    unsigned* ctl = (unsigned*)(args.ws + WS_CTL);
    XcdBarrier bar; bar.bar = ctl + CW_BAR + args.li * XCD_BAR_WORDS; bar.x = 0; bar.st = nullptr;
    if (MK_SINGLE) bar = xcd_barrier_post(ctl + CW_BAR + args.li * XCD_BAR_WORDS, MISC + 8);
    const int lo = args.ph_lo, hi = args.ph_hi;
#define IN(k) (lo <= (k) && (k) < hi)
#define SEAM(k) do { if (MK_SINGLE && IN((k) + 1)) xcd_barrier(bar); } while (0)
    const int bid = (int)blockIdx.x; const int vcu0 = F.vcu, G0 = F.G;
#define LAUNDER() do { int t_ = threadIdx.x; asm volatile("" : "+v"(t_)); F.tid = t_; F.lane = t_ & 63; F.wave = __builtin_amdgcn_readfirstlane(t_ >> 6); int g_ = G0, v_ = vcu0; asm volatile("" : "+s"(g_), "+s"(v_)); F.G = g_; F.vcu = v_; } while (0)
    LAS unsigned char* ring = F.lds;

    if (IN(0)) { LAUNDER(); ph_prologue(args, F); SEAM(0); }
    if (IN(1)) { LAUNDER(); ph_filters(args, F); SEAM(1); }
#pragma unroll 1
    for (int l = 0; l < 2; ++l) {
        const int pb = 2 + 10 * l;
        const int mrows = l == 0 ? MTOT : MLAT;
        bf16* WIN = (bf16*)(args.ws + WS_WIN) + (size_t)l * NIN * D; bf16* WOUT = (bf16*)(args.ws + WS_WOUT) + (size_t)l * 4 * D * D;
        bf16* H = (bf16*)(args.ws + WS_H); bf16* PR = (bf16*)(args.ws + WS_PR); bf16* YCAT = (bf16*)(args.ws + WS_YCAT);
        if (IN(pb + 0)) {
            LAUNDER();
            if (l == 0) ph_norm<0, false>(args, F, l); else ph_norm<0, true>(args, F, l);
            SEAM(pb + 0);
        }
        if (IN(pb + 1)) {
            { pg8::Gemm g{WIN, H, NHY, mrows, D}; RectOrder S; S.init(NHY / 256, mrows / 256, 0, 0, 0, 0, F.G, bid);
              EpiPlainBf16 E{(bf16*)(args.ws + WS_HYT), MTOT};
              pg8::gemm_phase<EpiPlainBf16, RectOrder, true, true>(ring, g, S, E); }
            { pg8::Gemm g{H, WIN + (size_t)NHY * D, MTOT, N2, D}; RectOrder S;
              if (l == 0) S.init(MTOT / 256, N2 / 256, 0, 0, 0, 0, F.G, bid); else S.init(MLAT / 256, N2 / 256, MCTX / 256, 4, MLAT / 256, 4, F.G, bid);
              EpiInProj E{PR};
              pg8::gemm_phase<EpiInProj, RectOrder, true, true>(ring, g, S, E); }
            SEAM(pb + 1);
        }
        if (IN(pb + 2)) {
            LAUNDER();
            for (int rep = 0; rep < REP_LRU1; ++rep) { if ((F.G & 15) == 0) ph_lru1(args, F, l); else for (int it = F.vcu; it < NCHUNK * 16; it += F.G) lru_item<1>(args, F, l, it >> 4, it & 15); }
            __syncthreads();
            LAUNDER();
            for (int rep = 0; rep < REP_HY; ++rep) ph_hyena_fft(args, F, l);
            LAUNDER();
            if (l == 0) for (int rep = 0; rep < REP_CTX; ++rep) ph_hyena_ctx(args, F, l);
            LAUNDER();
            for (int rep = 0; rep < REP_SC; ++rep) ph_sc(args, F, l, mrows);
            SEAM(pb + 2);
        }
        if (IN(pb + 3)) {
            LAUNDER();
            {
              int wit = F.vcu * 8 + F.wave; const int NGW = F.G * 8;
              for (int it = F.vcu; it < (mrows / LCH) * 16; it += F.G) { lru_item_p2(args, F, l, it >> 4, it & 15, wit); wit += NGW; }
              for (; wit < NITW; wit += NGW) { f32x4 wv[16]; unsigned char* wd; size_t wK; wx_load(args, l, wit, F.lane, wv, wd, wK); wx_store(wv, wd, wK, F.lane); } }
            __syncthreads();
            LAUNDER();
            for (int rep = 0; rep < REP_TR; ++rep) ph_transpose_ya(args, F, mrows);
            SEAM(pb + 3);
        }
        if (IN(pb + 4)) {
            bf16* MB = (bf16*)(args.ws + WS_MB);
            TripleOrder S; S.init(mrows / 256, MTOT / 256, F.G, bid);
            pg8::Gemm g{YCAT, WOUT, 3 * MTOT, 3 * D, D}; EpiGate3 E{PR + PR_GATE, MB, MTOT / 256};
            pg8::gemm_phase<EpiGate3, TripleOrder, true, true>(ring, g, S, E);
            SEAM(pb + 4);
        }
        if (IN(pb + 5)) {
            pg8::Gemm g{(bf16*)(args.ws + WS_MB), WOUT + 3ull * D * D, mrows, D, D}; RectOrder S; S.init(mrows / 256, 4, 0, 0, 0, 0, F.G, bid);
            EpiResid E{(float*)(args.ws + WS_X), (const float*)(args.ws + WS_MOD) + (size_t)l * 9 * 6144 + 2 * 1024};
            pg8::gemm_phase<EpiResid, RectOrder, true, true>(ring, g, S, E);
            SEAM(pb + 5);
        }
        if (IN(pb + 6)) { LAUNDER(); for (int rep = 0; rep < REP_NORM2; ++rep) ph_norm<1, false>(args, F, l); SEAM(pb + 6); }
        if (IN(pb + 7)) { LAUNDER(); for (int rep = 0; rep < REP_RANK; ++rep) ph_rank(args, F, l); SEAM(pb + 7); }
        if (IN(pb + 8)) {
            pg8::Gemm g{(bf16*)(args.ws + WS_XS), (bf16*)(args.ws + WS_WGU + (size_t)l * NE * NGU * D), NE * EROWS, NE * NGU, D / 2}; GroupOrder S; S.init(NE, l == 0 ? 9 : 8, 9, 22, F.G, bid);
            EpiSwiglu E{args.ws + WS_HID};
            pg8::gemm_phase<EpiSwiglu, GroupOrder, true, true, true>(ring, g, S, E);
            SEAM(pb + 8);
        }
        if (IN(pb + 9)) {
            pg8::Gemm g{(bf16*)(args.ws + WS_HID), (bf16*)(args.ws + WS_WD + (size_t)l * NE * D * DE), NE * EROWS, NE * D, DE / 2}; GroupOrder S; S.init(NE, l == 0 ? 9 : 8, 9, 4, F.G, bid);
            EpiYs E{(bf16*)(args.ws + WS_YS)};
            pg8::gemm_phase<EpiYs, GroupOrder, true, true, true>(ring, g, S, E);
            SEAM(pb + 9);
        }
    }
    if (IN(22)) { LAUNDER(); ph_norm<2, true>(args, F, 1); }
#undef IN
#undef SEAM
}

extern "C" void kernel_launch(void* const* d_in, const int* in_sizes, int n_in, void* d_out, int out_size, void* d_ws, size_t ws_size, hipStream_t stream) {
    static int grid = 0;
    if (grid == 0) {
        if (n_in != 35 || out_size != MLAT * D || ws_size < WS_END) { fprintf(stderr, "kernel_launch: unexpected shapes (n_in %d, out %d, ws %zu < %zu)\n", n_in, out_size, ws_size, (size_t)WS_END); grid = -1; return; }
        int dev = 0, cus = 0, per_cu = 0;
        if (hipGetDevice(&dev) != hipSuccess || hipDeviceGetAttribute(&cus, hipDeviceAttributeMultiprocessorCount, dev) != hipSuccess) { grid = -1; return; }
        if (hipFuncSetAttribute((const void*)mk_fwd, hipFuncAttributeMaxDynamicSharedMemorySize, LDS_BYTES) != hipSuccess) { fprintf(stderr, "kernel_launch: hipFuncSetAttribute failed\n"); grid = -1; return; }
        if (hipOccupancyMaxActiveBlocksPerMultiprocessor(&per_cu, (const void*)mk_fwd, 512, LDS_BYTES) != hipSuccess || per_cu < 1) fprintf(stderr, "kernel_launch: occupancy query says %d\n", per_cu);
        (void)hipGetLastError();
        grid = cus;
    }
    if (grid < 0) return;
    if (hipMemsetAsync((char*)d_ws + WS_CTL, 0, CTL_ZERO_BYTES, stream) != hipSuccess) return;
    Args a{};
    for (int i = 0; i < 35; ++i) a.in[i] = (const float*)d_in[i];
    a.out = (float*)d_out; a.ws = (unsigned char*)d_ws; a.pad = 0;
#if defined(PROBE_LO)
    a.ph_lo = 0; a.ph_hi = PROBE_HI; a.li = 0; hipLaunchKernelGGL(mk_fwd, dim3(grid), dim3(512), LDS_BYTES, stream, a);
    a.ph_lo = PROBE_LO; a.ph_hi = NPHASE; a.li = 1; hipLaunchKernelGGL(mk_fwd, dim3(grid), dim3(512), LDS_BYTES, stream, a);
#elif MK_SINGLE
    a.ph_lo = 0; a.ph_hi = NPHASE; a.li = 0;
    hipLaunchKernelGGL(mk_fwd, dim3(grid), dim3(512), LDS_BYTES, stream, a);
#else
    for (int p = 0; p < NPHASE; ++p) { a.ph_lo = p; a.ph_hi = p + 1; a.li = 0; hipLaunchKernelGGL(mk_fwd, dim3(grid), dim3(512), LDS_BYTES, stream, a); }
#endif
}
```

```cpp
#include <hip/hip_runtime.h>
#include <cstdio>
#include <cstdint>
namespace pg8 {
#define PG8_LAS __attribute__((address_space(3)))
typedef unsigned short bf16_t;
typedef short bf16x8 __attribute__((ext_vector_type(8)));
typedef float f32x4 __attribute__((ext_vector_type(4)));
typedef unsigned u32x4 __attribute__((ext_vector_type(4)));
constexpr int BM = 256, BK = 64, HALF = 128, HTB = HALF * BK * 2  , STAGE_BYTES = 8 * HTB, NXCD = 8, WGM = 8;

__host__ __device__ __forceinline__ int lds_byte(int r, int c) { const int st = (r >> 4) * 2 + (c >> 5), rr = r & 15, cc = c & 31, ob = rr * 64 + cc * 2; return st * 1024 + (ob ^ (((ob >> 9) & 1) << 5)); }
__host__ __device__ __forceinline__ void stage_rc(int b, int& R, int& C) { const int st = b / 1024, sb = b % 1024, swz = sb ^ (((sb >> 9) & 1) << 5); R = (st >> 1) * 16 + swz / 64; C = (st & 1) * 32 + (swz % 64) / 2; }
__host__ __device__ __forceinline__ int perm32(int rho) { const int n = rho >> 4, i = rho & 15; return 8 * (i >> 2) + 4 * n + (i & 3); }

struct Unit { int pm, pn; };
struct Gemm { const bf16_t* A; const bf16_t* Bt; int M, N, K; };

struct StaticOrder {
    int nM, nN, nwg, G, c;
    __host__ __device__ void init(int M, int N, int G_, int c_) { nM = M / BM; nN = N / BM; nwg = nM * nN; G = G_; c = c_; }
    __host__ __device__ bool next(int i, Unit& u) const {
        const long L = (long)i * G + c; if (L >= nwg) return false;
        int wgid = (int)L; { const int q = nwg / NXCD, r = nwg % NXCD, xcd = wgid % NXCD, off = wgid / NXCD; wgid = (xcd < r ? xcd * (q + 1) : r * (q + 1) + (xcd - r) * q) + off; }
        const int nig = WGM * nN, gid = wgid / nig, fm = gid * WGM, gsz = (nM - fm) < WGM ? (nM - fm) : WGM;
        u.pm = fm + ((wgid % nig) % gsz); u.pn = (wgid % nig) / gsz; return true;
    }
    __device__ __forceinline__ void a_ready(const Unit&) const {}
    __device__ __forceinline__ void done(const Unit&) const {}
};
__device__ __forceinline__ unsigned cvt_pk_bf16(float lo, float hi) { unsigned r; asm volatile("v_cvt_pk_bf16_f32 %0, %1, %2" : "=v"(r) : "v"(lo), "v"(hi)); return r; }
typedef float f32x2 __attribute__((ext_vector_type(2)));
typedef int i32x4_ __attribute__((ext_vector_type(4))); typedef int i32x8_ __attribute__((ext_vector_type(8)));
__device__ __forceinline__ bf16x8 frag_lo(i32x8_ v) { const i32x4_ t = __builtin_shufflevector(v, v, 0, 1, 2, 3); return __builtin_bit_cast(bf16x8, t); }
__device__ __forceinline__ bf16x8 frag_hi(i32x8_ v) { const i32x4_ t = __builtin_shufflevector(v, v, 4, 5, 6, 7); return __builtin_bit_cast(bf16x8, t); }
__device__ __forceinline__ i32x8_ cat8(bf16x8 lo, bf16x8 hi) { const i32x4_ a = __builtin_bit_cast(i32x4_, lo), b = __builtin_bit_cast(i32x4_, hi); return __builtin_shufflevector(a, b, 0, 1, 2, 3, 4, 5, 6, 7); }
template <class Epi, class Sched, bool ALIGN_EPI = false, bool SP2 = false, bool FP8 = false>
__device__ __forceinline__ void gemm_phase(PG8_LAS unsigned char* lds, const Gemm g, const Sched& S, const Epi& E) {
    int tid_ = threadIdx.x; asm volatile("" : "+v"(tid_));
    const int tid = tid_, wid = __builtin_amdgcn_readfirstlane(tid >> 6), lane = tid & 63, wr = wid >> 2, wc = wid & 3, fr = lane & 15, fq = lane >> 4;
    const int K = g.K, nt = K / BK;
    unsigned voffA[2], voffB[2];
#pragma unroll
    for (int i = 0; i < 2; ++i) { int R, C; stage_rc(tid * 16 + i * 8192, R, C); const int Rb = Epi::PERM ? ((R & ~31) + perm32(R & 31)) : R;
        const int ch = C >> 3; const unsigned Cb = FP8 ? (unsigned)(((ch & 3) * 2 + (ch >> 2)) * 16) : (unsigned)C * 2u;
        voffA[i] = (unsigned)(R * K) * 2u + Cb; voffB[i] = (unsigned)(Rb * K) * 2u + Cb; }
    const size_t kstep = (size_t)(BK * 2);
    const size_t hstep = (size_t)HALF * K * 2;
    const size_t tstep = 2 * hstep;
    const unsigned ldsw = (unsigned)wid * 1024u;
    const int aoff = lds_byte(wr * 64 + fr, fq * 8), boff = lds_byte(wc * 32 + fr, fq * 8);
#define PG8_SA(b, h) (((b) * 2 + (h)) * HTB)
#define PG8_SB(b, h) ((4 + (b) * 2 + (h)) * HTB)
#define PG8_STAGE(bufoff, gbase, voff) do { _Pragma("unroll") for (int _i = 0; _i < 2; ++_i) \
        __builtin_amdgcn_global_load_lds((const unsigned*)((const char*)(gbase) + (voff)[_i]), (PG8_LAS unsigned*)(lds + (bufoff) + ldsw + _i * 8192), 16, 0, 0); } while (0)
#define PG8_LDA(dst, b, h) do { _Pragma("unroll") for (int m = 0; m < 4; ++m) { dst[m].lo = *(const PG8_LAS i32x4_*)(lds + PG8_SA(b, h) + aoff + m * 2048); dst[m].hi = *(const PG8_LAS i32x4_*)(lds + PG8_SA(b, h) + aoff + m * 2048 + 1024); } } while (0)
#define PG8_LDB(dst, b, h) do { _Pragma("unroll") for (int n = 0; n < 2; ++n) { dst[n].lo = *(const PG8_LAS i32x4_*)(lds + PG8_SB(b, h) + boff + n * 2048); dst[n].hi = *(const PG8_LAS i32x4_*)(lds + PG8_SB(b, h) + boff + n * 2048 + 1024); } } while (0)
#define PG8_MMA(ai, bj, At, Bt) do { __builtin_amdgcn_s_setprio(1); if constexpr (FP8) { _Pragma("unroll") for (int m = 0; m < 4; ++m) _Pragma("unroll") for (int n = 0; n < 2; ++n) \
        asm volatile("v_mfma_scale_f32_16x16x128_f8f6f4 %0, %1, %2, %0, %3, %4 op_sel_hi:[0,0,0]" : "+v"(acc[ai][bj][m][n]) : "v"(Bt[n]), "v"(At[m]), "v"(sclw), "v"(scla)); } \
        else { _Pragma("unroll") for (int m = 0; m < 4; ++m) _Pragma("unroll") for (int n = 0; n < 2; ++n) { \
        acc[ai][bj][m][n] = __builtin_amdgcn_mfma_f32_16x16x32_bf16(frag_lo(Bt[n]), frag_lo(At[m]), acc[ai][bj][m][n], 0, 0, 0); \
        acc[ai][bj][m][n] = __builtin_amdgcn_mfma_f32_16x16x32_bf16(frag_hi(Bt[n]), frag_hi(At[m]), acc[ai][bj][m][n], 0, 0, 0); } } __builtin_amdgcn_s_setprio(0); } while (0)
#define PG8_WAIT_V(n) asm volatile("s_waitcnt vmcnt(" #n ")" ::: "memory")
#define PG8_WAIT_L(n) asm volatile("s_waitcnt lgkmcnt(" #n ")" ::: "memory")
#define PG8_BAR __builtin_amdgcn_s_barrier()
#define PG8_SCHED __builtin_amdgcn_sched_barrier(0)
    Unit cur, nxt; int ui = 0;
    if (!S.next(0, cur)) return;
    f32x4 acc[2][2][4][2];
#pragma unroll
    for (int a = 0; a < 2; ++a)
#pragma unroll
        for (int b = 0; b < 2; ++b)
#pragma unroll
            for (int m = 0; m < 4; ++m)
#pragma unroll
                for (int n = 0; n < 2; ++n) acc[a][b][m][n] = (f32x4){0.f, 0.f, 0.f, 0.f};
    i32x8_ At[4], B0[2], B1[2];
    int sclw = 0x7a7a7a7a, scla = 0x7f7f7f7f;
    if constexpr (FP8) asm volatile("" : "+v"(sclw), "+v"(scla));
    const char* cA = (const char*)g.A + (size_t)cur.pm * tstep; const char* cB = (const char*)g.Bt + (size_t)cur.pn * tstep;
    S.a_ready(cur);
    if constexpr (SP2) {
        PG8_STAGE(PG8_SB(0, 0), cB, voffB); PG8_STAGE(PG8_SB(0, 1), cB + hstep, voffB); PG8_STAGE(PG8_SA(0, 0), cA, voffA); PG8_STAGE(PG8_SA(0, 1), cA + hstep, voffA);
        if (wr == 1) PG8_BAR;
        PG8_WAIT_V(2); PG8_BAR;
        PG8_STAGE(PG8_SB(1, 0), cB + kstep, voffB); PG8_STAGE(PG8_SA(1, 0), cA + kstep, voffA); PG8_STAGE(PG8_SB(1, 1), cB + hstep + kstep, voffB);
        PG8_WAIT_V(6); PG8_BAR;
    } else {
        PG8_STAGE(PG8_SB(0, 0), cB, voffB); PG8_STAGE(PG8_SA(0, 0), cA, voffA); PG8_STAGE(PG8_SB(0, 1), cB + hstep, voffB); PG8_STAGE(PG8_SA(0, 1), cA + hstep, voffA);
        if (wr == 1) PG8_BAR;
        PG8_WAIT_V(4); PG8_BAR;
        PG8_STAGE(PG8_SB(1, 0), cB + kstep, voffB); PG8_STAGE(PG8_SA(1, 0), cA + kstep, voffA); PG8_STAGE(PG8_SB(1, 1), cB + hstep + kstep, voffB);
        PG8_WAIT_V(6); PG8_BAR;
    }
    for (;;) {
        const bool has_next = S.next(ui + 1, nxt);
        const char* nA = has_next ? (const char*)g.A + (size_t)nxt.pm * tstep : cA; const char* nB = has_next ? (const char*)g.Bt + (size_t)nxt.pn * tstep : cB;
#pragma unroll 1
        for (int t = 0; t < nt; t += 2) {
            const bool last = (t == nt - 2);
            const char* a1 = cA + (size_t)(t + 1) * kstep;
            const char* a2 = last ? nA : cA + (size_t)(t + 2) * kstep; const char* b2 = last ? nB : cB + (size_t)(t + 2) * kstep;
            const char* a3 = a2 + kstep; const char* b3 = b2 + kstep;
            if (last && has_next) S.a_ready(nxt);
            if constexpr (SP2) {
            PG8_LDB(B0, 0, 0); PG8_LDB(B1, 0, 1); PG8_SCHED; PG8_LDA(At, 0, 0); PG8_STAGE(PG8_SA(1, 1), a1 + hstep, voffA);
            PG8_WAIT_V(8); PG8_WAIT_L(0); PG8_BAR; PG8_MMA(0, 0, At, B0); PG8_MMA(0, 1, At, B1); PG8_BAR; PG8_SCHED;
            PG8_LDA(At, 0, 1); PG8_STAGE(PG8_SB(0, 0), b2, voffB); PG8_STAGE(PG8_SB(0, 1), b2 + hstep, voffB); PG8_STAGE(PG8_SA(0, 0), a2, voffA);
            PG8_WAIT_V(8); PG8_WAIT_L(0); PG8_BAR; PG8_MMA(1, 0, At, B0); PG8_MMA(1, 1, At, B1); PG8_BAR; PG8_SCHED;
            PG8_LDB(B0, 1, 0); PG8_LDB(B1, 1, 1); PG8_SCHED; PG8_LDA(At, 1, 0); PG8_STAGE(PG8_SA(0, 1), a2 + hstep, voffA);
            PG8_WAIT_V(8); PG8_WAIT_L(0); PG8_BAR; PG8_MMA(0, 0, At, B0); PG8_MMA(0, 1, At, B1); PG8_BAR; PG8_SCHED;
            PG8_LDA(At, 1, 1); PG8_STAGE(PG8_SB(1, 0), b3, voffB); PG8_STAGE(PG8_SB(1, 1), b3 + hstep, voffB); PG8_STAGE(PG8_SA(1, 0), a3, voffA);
            PG8_WAIT_V(8); PG8_WAIT_L(0); PG8_BAR; PG8_MMA(1, 0, At, B0); PG8_MMA(1, 1, At, B1); PG8_BAR; PG8_SCHED;
            } else {
            PG8_LDB(B0, 0, 0); PG8_SCHED; PG8_LDA(At, 0, 0); PG8_STAGE(PG8_SA(1, 1), a1 + hstep, voffA);
            PG8_WAIT_L(8); PG8_BAR; PG8_WAIT_L(0); PG8_MMA(0, 0, At, B0); PG8_BAR; PG8_SCHED;
            PG8_LDB(B1, 0, 1); PG8_STAGE(PG8_SB(0, 0), b2, voffB);
            PG8_BAR; PG8_WAIT_L(0); PG8_MMA(0, 1, At, B1); PG8_BAR;
            PG8_LDA(At, 0, 1); PG8_STAGE(PG8_SA(0, 0), a2, voffA);
            PG8_BAR; PG8_WAIT_L(0); PG8_MMA(1, 0, At, B0); PG8_BAR; PG8_SCHED;
            PG8_STAGE(PG8_SB(0, 1), b2 + hstep, voffB);
            PG8_WAIT_V(6); PG8_BAR; PG8_MMA(1, 1, At, B1); PG8_BAR;
            PG8_LDB(B0, 1, 0); PG8_SCHED; PG8_LDA(At, 1, 0); PG8_STAGE(PG8_SA(0, 1), a2 + hstep, voffA);
            PG8_WAIT_L(8); PG8_BAR; PG8_WAIT_L(0); PG8_MMA(0, 0, At, B0); PG8_BAR; PG8_SCHED;
            PG8_LDB(B1, 1, 1); PG8_STAGE(PG8_SB(1, 0), b3, voffB);
            PG8_BAR; PG8_WAIT_L(0); PG8_MMA(0, 1, At, B1); PG8_BAR;
            PG8_LDA(At, 1, 1); PG8_STAGE(PG8_SA(1, 0), a3, voffA);
            PG8_BAR; PG8_WAIT_L(0); PG8_MMA(1, 0, At, B0); PG8_BAR; PG8_SCHED;
            PG8_STAGE(PG8_SB(1, 1), b3 + hstep, voffB);
            PG8_WAIT_V(6); PG8_BAR; PG8_MMA(1, 1, At, B1); PG8_BAR;
            }
        }
        if constexpr (ALIGN_EPI) { if (wr == 0) PG8_BAR; }
        if constexpr (FP8) asm volatile("s_nop 15\n\ts_nop 15" ::: "memory");
        if constexpr (!Epi::AFTER_DRAIN) { E(acc, cur, wr, wc, fr, fq); S.done(cur); }
        if (!has_next) break;
        if (!(Epi::CHAIN && E.keep(cur))) {
#pragma unroll
        for (int a = 0; a < 2; ++a)
#pragma unroll
            for (int b = 0; b < 2; ++b)
#pragma unroll
                for (int m = 0; m < 4; ++m)
#pragma unroll
                    for (int n = 0; n < 2; ++n) acc[a][b][m][n] = (f32x4){0.f, 0.f, 0.f, 0.f};
        }
        cur = nxt; cA = nA; cB = nB; ++ui;
        if constexpr (ALIGN_EPI) { if (wr == 1) PG8_BAR; }
    }
    PG8_WAIT_V(0);
    if constexpr (!ALIGN_EPI) { if (wr == 0) PG8_BAR; }
    PG8_BAR;
    if constexpr (Epi::AFTER_DRAIN) { E.fused(acc, cur, wr, wc, fr, fq, lds, wid, lane); S.done(cur); }
#undef PG8_SA
#undef PG8_SB
#undef PG8_STAGE
#undef PG8_LDA
#undef PG8_LDB
#undef PG8_MMA
#undef PG8_WAIT_V
#undef PG8_WAIT_L
#undef PG8_BAR
#undef PG8_SCHED
}
}
#define GAS __attribute__((address_space(1)))
#define LAS __attribute__((address_space(3)))
typedef unsigned short bf16;
typedef unsigned v4u __attribute__((ext_vector_type(4)));
typedef unsigned v2u __attribute__((ext_vector_type(2)));
typedef float f32x4 __attribute__((ext_vector_type(4)));
typedef float f32x2 __attribute__((ext_vector_type(2)));
typedef short bf16x8 __attribute__((ext_vector_type(8)));
typedef GAS unsigned gu32;
#define RLX_AGENT __ATOMIC_RELAXED, __HIP_MEMORY_SCOPE_AGENT
#define LDS_WAIT() asm volatile("s_waitcnt lgkmcnt(0)" ::: "memory")
#define VM_WAIT() asm volatile("s_waitcnt vmcnt(0)" ::: "memory")
__device__ __forceinline__ unsigned f2bf(float f) { unsigned u = __builtin_bit_cast(unsigned, f); return (u + 0x7fffu + ((u >> 16) & 1u)) >> 16; }
__device__ __forceinline__ unsigned pk2(float lo, float hi) { return f2bf(lo) | (f2bf(hi) << 16); }
__device__ __forceinline__ float bf2f(unsigned short b) { return __builtin_bit_cast(float, ((unsigned)b) << 16); }
__device__ __forceinline__ float bflo(unsigned w) { return __builtin_bit_cast(float, w << 16); }
__device__ __forceinline__ float bfhi(unsigned w) { return __builtin_bit_cast(float, w & 0xffff0000u); }
__device__ __forceinline__ float sigmoidf_(float x) { return __builtin_amdgcn_rcpf(1.0f + __expf(-x)); }
__device__ __forceinline__ float gelu_tanh_(float x) { const float t = 1.5957691216f * (x + 0.044715f * x * x * x); return x * __builtin_amdgcn_rcpf(1.0f + __expf(-t)); }
__device__ __forceinline__ unsigned pk4_fp8(float a, float b, float c, float d) { int w = 0; w = __builtin_amdgcn_cvt_pk_fp8_f32(a, b, w, false); w = __builtin_amdgcn_cvt_pk_fp8_f32(c, d, w, true); return (unsigned)w; }
__device__ __forceinline__ float silu_(float x) { return x * __builtin_amdgcn_rcpf(1.0f + __expf(-x)); }

constexpr int D = 1024, NB = 8, SEQ = 2048, CTX = 256;
constexpr int MLAT = NB * SEQ, MCTX = NB * CTX, MTOT = MLAT + MCTX;
constexpr int NHY = 3072, N2 = 8192, NPR = 7168, NIN = 11264;
constexpr int NE = 16, DE = 2816, EROWS = 2304, NGU = 2 * DE;
constexpr int PR_GELU = 0, PR_REC = 1024, PR_BG = 2048, PR_P = 3072, PR_GATE = 4096;
constexpr int LCH = 64, NCHUNK = MTOT / LCH;

__device__ __forceinline__ int xcd_remap(int wgid, int nwg) { const int q = nwg / 8, r = nwg % 8, xcd = wgid % 8, off = wgid / 8; return (xcd < r ? xcd * (q + 1) : r * (q + 1) + (xcd - r) * q) + off; }

struct RectOrder {
    int nM1, nN1, n1, nM2, nN2, n2, pm2, pn2, G, c;
    __device__ void init(int nM1_, int nN1_, int nM2_, int nN2_, int pm2_, int pn2_, int G_, int c_) { nM1 = nM1_; nN1 = nN1_; n1 = nM1 * nN1; nM2 = nM2_; nN2 = nN2_; n2 = nM2 * nN2; pm2 = pm2_; pn2 = pn2_; G = G_; c = c_; }
    __device__ bool next(int i, pg8::Unit& u) const {
        const int L = i * G + c;
        if (L < n1) { const int wgid = xcd_remap(L, n1); const int nig = 8 * nN1, gid = wgid / nig, fm = gid * 8, gsz = (nM1 - fm) < 8 ? (nM1 - fm) : 8;
            u.pm = fm + ((wgid % nig) % gsz); u.pn = (wgid % nig) / gsz; return true; }
        const int L2 = L - n1; if (L2 >= n2) return false;
        u.pm = pm2 + L2 % nM2; u.pn = pn2 + L2 / nM2; return true;
    }
    __device__ __forceinline__ void a_ready(const pg8::Unit&) const {}
    __device__ __forceinline__ void done(const pg8::Unit&) const {}
};
struct ListOrder {
    int mode, t, mstride;
    __device__ void init(int mode_, int t_, int mstride_) { mode = mode_; t = t_; mstride = mstride_; }
    __device__ bool next(int i, pg8::Unit& u) const {
        if (mode == 0) { if (i >= 3) return false; u.pm = i * mstride + 64 + (t & 7); u.pn = i * 4 + (t >> 3); return true; }
        if (mode == 2) { if (i >= 1) return false; u.pm = 64 + (t & 7); u.pn = t >> 3; return true; }
        int wgid;
        if (i == 0) wgid = (t & 7) * 32 + (t >> 3); else if (i == 1 && t < 32) wgid = (t & 7) * 32 + 28 + (t >> 3); else return false;
        const int r = wgid & 31; u.pm = (wgid >> 5) * 8 + (r & 7); u.pn = r >> 3; return true;
    }
    __device__ __forceinline__ void a_ready(const pg8::Unit&) const {}
    __device__ __forceinline__ void done(const pg8::Unit&) const {}
};
struct GroupOrder {
    int mt, mstride, nt, nwg, G, c;
    __device__ void init(int nE, int mt_, int mstride_, int nt_, int G_, int c_) { mt = mt_; mstride = mstride_; nt = nt_; nwg = nE * mt * nt; G = G_; c = c_; }
    __device__ bool next(int i, pg8::Unit& u) const {
        const int L = i * G + c; if (L >= nwg) return false;
        const int wgid = xcd_remap(L, nwg); const int per = mt * nt, e = wgid / per, r = wgid % per;
        u.pm = e * mstride + r % mt; u.pn = e * nt + r / mt; return true;
    }
    __device__ __forceinline__ void a_ready(const pg8::Unit&) const {}
    __device__ __forceinline__ void done(const pg8::Unit&) const {}
};


struct TripleOrder {
    int nM, ntile, mstride, G, c;
    __device__ void init(int nM_, int mstride_, int G_, int c_) { nM = nM_; ntile = nM_ * 4; mstride = mstride_; G = G_; c = c_; }
    __device__ bool next(int u, pg8::Unit& un) const {
        const int t = u / 3, i = u - 3 * t, L = t * G + c; if (L >= ntile) return false;
        const int wgid = xcd_remap(L, ntile); const int nig = 8 * 4, gid = wgid / nig, fm = gid * 8, gsz = (nM - fm) < 8 ? (nM - fm) : 8;
        un.pm = i * mstride + fm + ((wgid % nig) % gsz); un.pn = i * 4 + (wgid % nig) / gsz; return true;
    }
    __device__ __forceinline__ void a_ready(const pg8::Unit&) const {}
    __device__ __forceinline__ void done(const pg8::Unit&) const {}
};

#define EPI_ROW(u, ai, m) ((u).pm * 256 + wr * 64 + fr + (ai) * 128 + (m) * 16)
struct EpiPlainBf16 {
    static constexpr bool PERM = true, AFTER_DRAIN = false, CHAIN = false; __device__ __forceinline__ bool keep(const pg8::Unit&) const { return false; }
    bf16* O; int ldc;
    __device__ __forceinline__ void operator()(const f32x4 (&acc)[2][2][4][2], const pg8::Unit& u, int wr, int wc, int fr, int fq) const {
        const int col0 = u.pn * 256 + wc * 32 + 8 * fq;
#pragma unroll
        for (int ai = 0; ai < 2; ++ai)
#pragma unroll
            for (int m = 0; m < 4; ++m) { bf16* rowp = O + (size_t)EPI_ROW(u, ai, m) * ldc + col0;
#pragma unroll
                for (int bj = 0; bj < 2; ++bj) { const f32x4 v0 = acc[ai][bj][m][0], v1 = acc[ai][bj][m][1];
                    v4u w; w.x = pg8::cvt_pk_bf16(v0[0], v0[1]); w.y = pg8::cvt_pk_bf16(v0[2], v0[3]); w.z = pg8::cvt_pk_bf16(v1[0], v1[1]); w.w = pg8::cvt_pk_bf16(v1[2], v1[3]);
                    *(v4u*)(rowp + bj * 128) = w; } }
    }
};
struct EpiInProj {
    static constexpr bool PERM = true, AFTER_DRAIN = false, CHAIN = false; __device__ __forceinline__ bool keep(const pg8::Unit&) const { return false; }
    bf16* PR;
    __device__ __forceinline__ void operator()(const f32x4 (&acc)[2][2][4][2], const pg8::Unit& u, int wr, int wc, int fr, int fq) const {
        const int pn = u.pn;
        if (pn >= 12 && pn < 20) {
            const int col = PR_P + (pn - 12) * 128 + wc * 32 + 8 * fq;
#pragma unroll
            for (int ai = 0; ai < 2; ++ai)
#pragma unroll
                for (int m = 0; m < 4; ++m) { const f32x4 v0 = acc[ai][0][m][0] * acc[ai][1][m][0], v1 = acc[ai][0][m][1] * acc[ai][1][m][1];
                    v4u w; w.x = pg8::cvt_pk_bf16(v0[0], v0[1]); w.y = pg8::cvt_pk_bf16(v0[2], v0[3]); w.z = pg8::cvt_pk_bf16(v1[0], v1[1]); w.w = pg8::cvt_pk_bf16(v1[2], v1[3]);
                    *(v4u*)(PR + (size_t)EPI_ROW(u, ai, m) * NPR + col) = w; }
        } else {
            const int mode = pn < 4 ? 1 : (pn < 12 ? 0 : 2);
            const int col0 = (pn < 12 ? pn * 256 : PR_GATE + (pn - 20) * 256) + wc * 32 + 8 * fq;
#pragma unroll
            for (int ai = 0; ai < 2; ++ai)
#pragma unroll
                for (int m = 0; m < 4; ++m) { bf16* rowp = PR + (size_t)EPI_ROW(u, ai, m) * NPR + col0;
#pragma unroll
                    for (int bj = 0; bj < 2; ++bj) { f32x4 v0 = acc[ai][bj][m][0], v1 = acc[ai][bj][m][1];
                        if (mode == 1) {
#pragma unroll
                            for (int j = 0; j < 4; ++j) { v0[j] = gelu_tanh_(v0[j]); v1[j] = gelu_tanh_(v1[j]); } }
                        else if (mode == 2) {
#pragma unroll
                            for (int j = 0; j < 4; ++j) { v0[j] = sigmoidf_(v0[j]); v1[j] = sigmoidf_(v1[j]); } }
                        v4u w; w.x = pg8::cvt_pk_bf16(v0[0], v0[1]); w.y = pg8::cvt_pk_bf16(v0[2], v0[3]); w.z = pg8::cvt_pk_bf16(v1[0], v1[1]); w.w = pg8::cvt_pk_bf16(v1[2], v1[3]);
                        *(v4u*)(rowp + bj * 128) = w; } }
        }
    }
};
template <int VAR> struct EpiGate {
    static constexpr bool PERM = true, AFTER_DRAIN = false, CHAIN = false; __device__ __forceinline__ bool keep(const pg8::Unit&) const { return false; }
    const bf16* gates; float* M32; bf16* MB;
    __device__ __forceinline__ void operator()(const f32x4 (&acc)[2][2][4][2], const pg8::Unit& u, int wr, int wc, int fr, int fq) const {
        const int col0 = u.pn * 256 + wc * 32 + 8 * fq;
#pragma unroll
        for (int ai = 0; ai < 2; ++ai)
#pragma unroll
            for (int m = 0; m < 4; ++m) { const size_t row = (size_t)EPI_ROW(u, ai, m);
#pragma unroll
                for (int bj = 0; bj < 2; ++bj) { const int col = col0 + bj * 128;
                    const v4u g = *(const v4u*)(gates + row * NPR + col);
                    f32x4 v0 = acc[ai][bj][m][0], v1 = acc[ai][bj][m][1];
                    v0[0] *= bflo(g.x); v0[1] *= bfhi(g.x); v0[2] *= bflo(g.y); v0[3] *= bfhi(g.y); v1[0] *= bflo(g.z); v1[1] *= bfhi(g.z); v1[2] *= bflo(g.w); v1[3] *= bfhi(g.w);
                    float* mp = M32 + row * D + col;
                    if (VAR >= 1) { v0 += *(const f32x4*)mp; v1 += *(const f32x4*)(mp + 4); }
                    if (VAR <= 1) { *(f32x4*)mp = v0; *(f32x4*)(mp + 4) = v1; }
                    else { v4u w; w.x = pg8::cvt_pk_bf16(v0[0], v0[1]); w.y = pg8::cvt_pk_bf16(v0[2], v0[3]); w.z = pg8::cvt_pk_bf16(v1[0], v1[1]); w.w = pg8::cvt_pk_bf16(v1[2], v1[3]);
                        *(v4u*)(MB + row * D + col) = w; } } }
    }
};

struct EpiGate3 {
    static constexpr bool PERM = true, AFTER_DRAIN = false, CHAIN = true;
    const bf16* gates; bf16* MB; int mstride;
    __device__ __forceinline__ bool keep(const pg8::Unit& u) const { return (u.pn >> 2) < 2; }
    __device__ __forceinline__ void operator()(f32x4 (&acc)[2][2][4][2], const pg8::Unit& u0, int wr, int wc, int fr, int fq) const {
        const int i = u0.pn >> 2; pg8::Unit u; u.pm = u0.pm - i * mstride; u.pn = u0.pn & 3;
        const int col0 = u.pn * 256 + wc * 32 + 8 * fq; const bf16* gt = gates + i * 1024;
#pragma unroll
        for (int ai = 0; ai < 2; ++ai) {
            v4u G[4][2], Gn[4][2];
#pragma unroll
            for (int m = 0; m < 4; ++m) { const size_t row = (size_t)EPI_ROW(u, ai, m);
#pragma unroll
                for (int bj = 0; bj < 2; ++bj) { const bf16* gp = gt + row * NPR + col0 + bj * 128; G[m][bj] = *(const v4u*)gp;
                    Gn[m][bj] = *(const v4u*)(gp + (i < 2 ? 1024 : 0)); } }
#pragma unroll
            for (int m = 0; m < 4; ++m) { const size_t row = (size_t)EPI_ROW(u, ai, m);
#pragma unroll
                for (int bj = 0; bj < 2; ++bj) { const int col = col0 + bj * 128;
                    const v4u g = G[m][bj];
                    float s[8] = {bflo(g.x), bfhi(g.x), bflo(g.y), bfhi(g.y), bflo(g.z), bfhi(g.z), bflo(g.w), bfhi(g.w)};
                    if (i >= 1) {
#pragma unroll
                        for (int j = 0; j < 8; ++j) s[j] = fmaxf(s[j], 1e-18f); }
                    if (i < 2) { const v4u gn = Gn[m][bj];
                        const float d[8] = {bflo(gn.x), bfhi(gn.x), bflo(gn.y), bfhi(gn.y), bflo(gn.z), bfhi(gn.z), bflo(gn.w), bfhi(gn.w)};
#pragma unroll
                        for (int j = 0; j < 8; ++j) s[j] = s[j] * __builtin_amdgcn_rcpf(fmaxf(d[j], 1e-18f)); }
                    f32x4 v0 = acc[ai][bj][m][0], v1 = acc[ai][bj][m][1];
                    v0[0] *= s[0]; v0[1] *= s[1]; v0[2] *= s[2]; v0[3] *= s[3]; v1[0] *= s[4]; v1[1] *= s[5]; v1[2] *= s[6]; v1[3] *= s[7];
                    if (i < 2) { acc[ai][bj][m][0] = v0; acc[ai][bj][m][1] = v1; }
                    else { v4u w; w.x = pg8::cvt_pk_bf16(v0[0], v0[1]); w.y = pg8::cvt_pk_bf16(v0[2], v0[3]); w.z = pg8::cvt_pk_bf16(v1[0], v1[1]); w.w = pg8::cvt_pk_bf16(v1[2], v1[3]);
                        *(v4u*)(MB + row * D + col) = w; } } }
        }
    }
};
struct EpiResid {
    static constexpr bool PERM = false, AFTER_DRAIN = false, CHAIN = false; __device__ __forceinline__ bool keep(const pg8::Unit&) const { return false; }
    float* X; const float* modg;
    __device__ __forceinline__ void operator()(const f32x4 (&acc)[2][2][4][2], const pg8::Unit& u, int wr, int wc, int fr, int fq) const {
        const int r = u.pm < 64 ? (u.pm >> 3) : 8; const float* mg = modg + (size_t)r * 6144;
        const int col0 = u.pn * 256 + wc * 32 + 4 * fq;
        f32x4 gv[2][2];
#pragma unroll
        for (int bj = 0; bj < 2; ++bj)
#pragma unroll
            for (int n = 0; n < 2; ++n) gv[bj][n] = *(const f32x4*)(mg + col0 + bj * 128 + n * 16);
#pragma unroll
        for (int ai = 0; ai < 2; ++ai) {
            f32x4 xv[4][2][2];
#pragma unroll
            for (int m = 0; m < 4; ++m) { const float* rowp = X + (size_t)EPI_ROW(u, ai, m) * D + col0;
#pragma unroll
                for (int bj = 0; bj < 2; ++bj)
#pragma unroll
                    for (int n = 0; n < 2; ++n) xv[m][bj][n] = *(const f32x4*)(rowp + bj * 128 + n * 16); }
#pragma unroll
            for (int m = 0; m < 4; ++m) { float* rowp = X + (size_t)EPI_ROW(u, ai, m) * D + col0;
#pragma unroll
                for (int bj = 0; bj < 2; ++bj)
#pragma unroll
                    for (int n = 0; n < 2; ++n) *(f32x4*)(rowp + bj * 128 + n * 16) = xv[m][bj][n] + gv[bj][n] * acc[ai][bj][m][n]; }
        }
    }
};
struct EpiSwiglu {
    static constexpr bool PERM = true, AFTER_DRAIN = false, CHAIN = false; __device__ __forceinline__ bool keep(const pg8::Unit&) const { return false; }
    unsigned char* HID;
    __device__ __forceinline__ void operator()(const f32x4 (&acc)[2][2][4][2], const pg8::Unit& u, int wr, int wc, int fr, int fq) const {
        const int jn = u.pn % 22; const int col = jn * 128 + wc * 32 + 8 * fq;
#pragma unroll
        for (int ai = 0; ai < 2; ++ai)
#pragma unroll
            for (int m = 0; m < 4; ++m) { f32x4 v0, v1;
#pragma unroll
                for (int j = 0; j < 4; ++j) { v0[j] = silu_(acc[ai][0][m][0][j]) * acc[ai][1][m][0][j]; v1[j] = silu_(acc[ai][0][m][1][j]) * acc[ai][1][m][1][j]; }
                v2u w; w.x = pk4_fp8(v0[0], v0[1], v0[2], v0[3]); w.y = pk4_fp8(v1[0], v1[1], v1[2], v1[3]);
                *(v2u*)(HID + (size_t)EPI_ROW(u, ai, m) * DE + col) = w; }
    }
};
struct EpiYs {
    static constexpr bool PERM = true, AFTER_DRAIN = false, CHAIN = false; __device__ __forceinline__ bool keep(const pg8::Unit&) const { return false; }
    bf16* YS;
    __device__ __forceinline__ void operator()(const f32x4 (&acc)[2][2][4][2], const pg8::Unit& u, int wr, int wc, int fr, int fq) const {
        const int col0 = (u.pn & 3) * 256 + wc * 32 + 8 * fq;
#pragma unroll
        for (int ai = 0; ai < 2; ++ai)
#pragma unroll
            for (int m = 0; m < 4; ++m) { bf16* rowp = YS + (size_t)EPI_ROW(u, ai, m) * D + col0;
#pragma unroll
                for (int bj = 0; bj < 2; ++bj) { const f32x4 v0 = acc[ai][bj][m][0], v1 = acc[ai][bj][m][1];
                    v4u w; w.x = pg8::cvt_pk_bf16(v0[0], v0[1]); w.y = pg8::cvt_pk_bf16(v0[2], v0[3]); w.z = pg8::cvt_pk_bf16(v1[0], v1[1]); w.w = pg8::cvt_pk_bf16(v1[2], v1[3]);
                    *(v4u*)(rowp + bj * 128) = w; } }
    }
};
#define XB_TMO      128
#define XB_XCNT(j)  (256  + 64 * (j))
#define XB_XSUB(j)  (1280 + 64 * (j))
#define XB_XGEN(j)  (2304 + 64 * (j))
#define XB_TOP      3328
#define XB_TOPGEN   3392
#define XCD_BAR_WORDS 3456
#define XB_SPIN_CAP (1u << 18)

__device__ __forceinline__ unsigned xb_ld(unsigned* p)              { return __hip_atomic_load(p, __ATOMIC_RELAXED, __HIP_MEMORY_SCOPE_AGENT); }
__device__ __forceinline__ unsigned xb_add(unsigned* p, unsigned v) { return __hip_atomic_fetch_add(p, v, __ATOMIC_RELAXED, __HIP_MEMORY_SCOPE_AGENT); }
__device__ __forceinline__ unsigned xb_xcc_id() { return (unsigned)__builtin_amdgcn_s_getreg((3 << 11) | 20) & 0xFu; }
#define XB_SPIN(cond, bar) do { unsigned _sp = 0; while (cond) { __builtin_amdgcn_s_sleep(1); \
    if ((++_sp & 255u) == 0u) { if (xb_ld(&(bar)[XB_TMO])) break; if (_sp > XB_SPIN_CAP) { atomicAdd(&(bar)[XB_TMO], 1u); break; } } } } while (0)

struct XcdBarrier {
    unsigned* bar; unsigned x;
    volatile LAS unsigned* st;
};

__device__ __forceinline__ XcdBarrier xcd_barrier_post(unsigned* bar, volatile LAS unsigned* st) {
    XcdBarrier b; b.bar = bar; b.x = xb_xcc_id(); b.st = st;
    if (threadIdx.x == 0) (void)xb_add(&bar[XB_XCNT(b.x)], 1u);
    return b;
}
__device__ __forceinline__ void xcd_barrier_complete(unsigned* bar, unsigned x, unsigned& nloc, unsigned& nx) {
    const unsigned G = gridDim.x * gridDim.y * gridDim.z;
    unsigned sum, cnt, mine, sp = 0u;
    for (;;) {
        sum = 0u; cnt = 0u; mine = 0u;
#pragma unroll
        for (unsigned j = 0; j < 16; ++j) { const unsigned c = xb_ld(&bar[XB_XCNT(j)]); sum += c; cnt += (c > 0u) ? 1u : 0u; mine = (j == x) ? c : mine; }
        if (sum == G) break;
        __builtin_amdgcn_s_sleep(1);
        if ((++sp & 255u) == 0u) { if (xb_ld(&bar[XB_TMO])) break; if (sp > XB_SPIN_CAP) { atomicAdd(&bar[XB_TMO], 1u); break; } }
    }
    nloc = mine > 0u ? mine : 1u; nx = cnt > 0u ? cnt : 1u;
}

__device__ __forceinline__ void xcd_barrier(const XcdBarrier& b) {
    asm volatile("s_waitcnt vmcnt(0)" ::: "memory");
    __syncthreads();
    if (threadIdx.x == 0) {
        unsigned* bar = b.bar;
        __builtin_amdgcn_s_waitcnt(0);
        unsigned nloc = b.st[0], nx = b.st[1];
        if (nloc == 0u) { xcd_barrier_complete(bar, b.x, nloc, nx); b.st[0] = nloc; b.st[1] = nx; }
        const unsigned old = xb_add(&bar[XB_XSUB(b.x)], 1u);
        const unsigned gen = old / nloc;
        if (old + 1u == (gen + 1u) * nloc) {
            __builtin_amdgcn_fence(__ATOMIC_RELEASE, "agent");
            asm volatile("s_waitcnt vmcnt(0)" ::: "memory");
            const unsigned og = xb_add(&bar[XB_TOP], 1u);
            const unsigned tg = og / nx;
            if (og + 1u == (tg + 1u) * nx) xb_add(&bar[XB_TOPGEN], 1u);
            else XB_SPIN(xb_ld(&bar[XB_TOPGEN]) == tg, bar);
            __builtin_amdgcn_fence(__ATOMIC_ACQUIRE, "agent");
            xb_add(&bar[XB_XGEN(b.x)], 1u);
            asm volatile("s_waitcnt vmcnt(0)" ::: "memory");
        } else {
            XB_SPIN(xb_ld(&bar[XB_XGEN(b.x)]) == gen, bar);
            __builtin_amdgcn_fence(__ATOMIC_ACQUIRE, "agent");
            asm volatile("s_waitcnt vmcnt(0)" ::: "memory");
        }
    }
    __syncthreads();
}
constexpr size_t MiB = 1u << 20;
constexpr size_t al_(size_t x) { return (x + MiB - 1) / MiB * MiB; }
constexpr size_t WS_CTL = 0, CTL_ZERO_BYTES = 1 * MiB;
constexpr size_t WS_MOD  = 1 * MiB;
constexpr size_t WS_SP   = WS_MOD + 512 * 1024;
constexpr size_t WS_WIN  = WS_MOD + 1 * MiB;
constexpr size_t WS_WOUT = WS_WIN + al_(2ull * NIN * D * 2);
constexpr size_t WS_WLRU = WS_WOUT + al_(2ull * 4 * D * D * 2);
constexpr size_t WS_WGU  = WS_WLRU + 1 * MiB;
constexpr size_t WS_WD   = WS_WGU + al_(16ull * NGU * D * 2);
constexpr size_t WS_X    = WS_WD + al_(16ull * D * DE * 2);
constexpr size_t WS_FH2  = WS_X + al_((size_t)MTOT * D * 4);
constexpr size_t WS_KF   = WS_FH2 + 2 * MiB;
constexpr size_t WS_TFC  = WS_KF + al_(2ull * 2 * D * 4096 * 8);
constexpr size_t WS_H    = WS_TFC + al_(4ull * D * CTX * 4);
constexpr size_t WS_R    = WS_H + al_((size_t)MTOT * D * 2);
constexpr size_t WS_HYT  = WS_R;
constexpr size_t WS_PR   = WS_HYT + al_((size_t)NHY * MTOT * 2);
constexpr size_t WS_YAT  = WS_PR + al_((size_t)MTOT * NPR * 2);
constexpr size_t WS_YCAT = WS_YAT + al_((size_t)D * MTOT * 2);
constexpr size_t WS_REND = WS_YCAT + al_(3ull * MTOT * D * 2);
constexpr size_t WS_XS   = WS_R;
constexpr size_t WS_HID  = WS_XS + al_((size_t)NE * EROWS * D * 2);
constexpr size_t WS_YS   = WS_HID + al_((size_t)NE * EROWS * DE * 2);
static_assert(WS_YS + (size_t)NE * EROWS * D * 4 <= WS_REND, "MoE overlay fits");
constexpr size_t WS_M32  = WS_REND;
constexpr size_t WS_MB   = WS_M32 + al_((size_t)MTOT * D * 4);
constexpr size_t WS_AFF  = WS_MB + al_((size_t)MTOT * D * 2);
constexpr size_t WS_SELG = WS_AFF + 2 * MiB;
constexpr size_t WS_INV  = WS_SELG + 1 * MiB;
constexpr size_t WS_AGG  = WS_INV + 2 * MiB;
constexpr size_t WS_LAB  = WS_AGG + al_(2ull * NCHUNK * D * 2 * 4);
constexpr size_t WS_END  = WS_LAB + al_(4ull * MTOT * D * 2);
constexpr int CW_BAR = 4096;
constexpr int LDS_BYTES = 147456, MISC_OFF = 147456 - 256;
constexpr int NPHASE = 23;

struct Args { const float* in[35]; float* out; unsigned char* ws; int ph_lo, ph_hi, li, pad; };
struct Frame { LAS unsigned char* lds; int tid, lane, wave, vcu, G; };

__device__ __forceinline__ float wave_sum(float v) {
#pragma unroll
    for (int o = 1; o < 64; o <<= 1) v += __shfl_xor(v, o);
    return v;
}
__device__ __forceinline__ void tr_item(const float* src, size_t ld, bf16* dst, size_t K, LAS float* scr, int lane) {
    f32x4 v[16];
#pragma unroll
    for (int i = 0; i < 16; ++i) v[i] = *(const f32x4*)(src + (size_t)((lane >> 4) + 4 * i) * ld + (lane & 15) * 4);
#pragma unroll
    for (int i = 0; i < 16; ++i) { LAS float* p = scr + ((lane >> 4) + 4 * i) * 65 + (lane & 15) * 4; p[0] = v[i][0]; p[1] = v[i][1]; p[2] = v[i][2]; p[3] = v[i][3]; }
    LDS_WAIT(); asm volatile("" ::: "memory");
    const int c = lane & 7;
#pragma unroll
    for (int j = 0; j < 8; ++j) { const int n = (lane >> 3) + 8 * j; const LAS float* s = scr + (8 * c) * 65 + n;
        v4u o; o.x = pk2(s[0 * 65], s[1 * 65]); o.y = pk2(s[2 * 65], s[3 * 65]); o.z = pk2(s[4 * 65], s[5 * 65]); o.w = pk2(s[6 * 65], s[7 * 65]);
        *(v4u*)(dst + (size_t)n * K + 8 * c) = o; }
    LDS_WAIT(); asm volatile("" ::: "memory");
}
__device__ __forceinline__ int win_src_col(int n0) {
    if (n0 < 3072) return n0;
    const int m = n0 - 3072;
    if (m < 1024) return 3072 + m;
    if (m < 2048) return 4096 + (m - 1024);
    if (m < 3072) return 5120 + (m - 2048);
    if (m < 5120) { const int q = m - 3072, j = q >> 8, r = q & 255; return r < 128 ? 6144 + 128 * j + r : 7168 + 128 * j + (r - 128); }
    return 8192 + (m - 5120);
}

__device__ __forceinline__ void ph_prologue(const Args& a, const Frame& F) {
    const int gw = F.vcu * 8 + F.wave, NGW = F.G * 8, lane = F.lane;
    float* X = (float*)(a.ws + WS_X);
    for (int t = gw; t < SEQ; t += NGW) {
        f32x4 xv[NB][4];
#pragma unroll
        for (int b = 0; b < NB; ++b) { const f32x4* xr = (const f32x4*)(a.in[0] + ((size_t)b * SEQ + t) * D) + lane;
#pragma unroll
            for (int j = 0; j < 4; ++j) xv[b][j] = xr[64 * j]; }
        const int gr = t >> 6, gc = t & 63; f32x4 pe[4];
#pragma unroll
        for (int j = 0; j < 4; ++j)
#pragma unroll
            for (int i = 0; i < 4; ++i) { const int cc = 4 * lane + 256 * j + i; const float pos = (float)(cc < 512 ? gr : gc); const int c2 = cc & 511, idx = c2 & 255;
                const float om = exp2f((float)idx * (-13.287712379549449f / 256.0f)); const float ang = pos * om; pe[j][i] = c2 < 256 ? sinf(ang) : cosf(ang); }
#pragma unroll
        for (int b = 0; b < NB; ++b) { f32x4* xo = (f32x4*)(X + ((size_t)b * SEQ + t) * D) + lane;
#pragma unroll
            for (int j = 0; j < 4; ++j) xo[64 * j] = xv[b][j] + pe[j]; }
    }
    for (int r = gw; r < MCTX; r += NGW) { const f32x4* xr = (const f32x4*)(a.in[2] + (size_t)r * D) + lane; f32x4* xo = (f32x4*)(X + (size_t)(MLAT + r) * D) + lane;
#pragma unroll
        for (int j = 0; j < 4; ++j) xo[64 * j] = xr[64 * j]; }
    {
        LAS float* S = (LAS float*)F.lds;
        LAS float* red = S + 9 * 1024;
        for (int i = F.tid; i < 9 * 1024; i += 512) { const float v = i < 8192 ? a.in[1][i] : a.in[3][i - 8192]; S[i] = v / (1.0f + expf(-v)); }
        __syncthreads();
        float* MOD = (float*)(a.ws + WS_MOD);
        for (int it = F.vcu; it < 2 * 96; it += F.G) {
            const int l = it / 96, cb = it % 96, cj = F.tid & 63, ks = F.tid >> 6;
            const float* w = a.in[4] + (size_t)l * D * 6144 + cb * 64 + cj; float acc[9];
#pragma unroll
            for (int r = 0; r < 9; ++r) acc[r] = 0.f;
            for (int k0 = ks * 128; k0 < ks * 128 + 128; k0 += 32) { float wv[32];
#pragma unroll
                for (int kk = 0; kk < 32; ++kk) wv[kk] = w[(size_t)(k0 + kk) * 6144];
#pragma unroll
                for (int kk = 0; kk < 32; ++kk)
#pragma unroll
                    for (int r = 0; r < 9; ++r) acc[r] += S[r * 1024 + k0 + kk] * wv[kk]; }
#pragma unroll
            for (int r = 0; r < 9; ++r) red[(ks * 9 + r) * 64 + cj] = acc[r];
            __syncthreads();
            for (int o = F.tid; o < 9 * 64; o += 512) { const int r = o >> 6, c2 = o & 63; float s = a.in[5][(size_t)l * 6144 + cb * 64 + c2];
#pragma unroll
                for (int k2 = 0; k2 < 8; ++k2) s += red[(k2 * 9 + r) * 64 + c2];
                MOD[((size_t)l * 9 + r) * 6144 + cb * 64 + c2] = s; }
            __syncthreads();
        }
    }
    {
        LAS float* scr = (LAS float*)(F.lds + F.wave * 16640);
        bf16* WIN = (bf16*)(a.ws + WS_WIN); bf16* WOUT = (bf16*)(a.ws + WS_WOUT);
        constexpr int I_IN = 16 * (NIN / 64), I_OUT = 16 * 16;
        constexpr int NIT = 2 * I_IN + 8 * I_OUT;
        for (int it = gw; it < NIT; it += NGW) {
            if (it < 2 * I_IN) { const int l = it / I_IN, r = it % I_IN, kb = r / (NIN / 64), nb = r % (NIN / 64);
                tr_item(a.in[8] + (size_t)l * D * NIN + (size_t)(64 * kb) * NIN + win_src_col(64 * nb), NIN, WIN + (size_t)l * NIN * D + (size_t)(64 * nb) * D + 64 * kb, D, scr, lane); }
            else { const int r0 = it - 2 * I_IN, mi = r0 / I_OUT, r = r0 % I_OUT, l = mi >> 2, w = mi & 3, kb = r / 16, nb = r % 16;
                tr_item(a.in[26 + w] + (size_t)l * D * D + (size_t)(64 * kb) * D + 64 * nb, D, WOUT + ((size_t)l * 4 + w) * D * D + (size_t)(64 * nb) * D + 64 * kb, D, scr, lane); }
        }
    }
    {
      bf16* WL = (bf16*)(a.ws + WS_WLRU); float* SP = (float*)(a.ws + WS_SP);
      const int gt = F.vcu * 512 + F.tid, NT = F.G * 512;
      for (int i = gt; i < 2 * 16 * 256 * 64; i += NT) { const int k = i & 63, n = (i >> 6) & 255, hd = (i >> 14) & 15, l = i >> 18; const int dir = n >> 7, ax = (n >> 6) & 1, j = n & 63;
          WL[i] = (bf16)f2bf((ax ? a.in[22] : a.in[20])[((((size_t)l * 2 + dir) * 16 + hd) * 64 + k) * 64 + j]); }
      for (int i = gt; i < 4 * D; i += NT) { const float lam = a.in[24][i]; SP[i] = log1pf(expf(-lam)); } }
    __syncthreads();
    {
        LAS float* feats = (LAS float*)F.lds;
        LAS float* h1 = feats + 8 * 36;
        float* FH2 = (float*)(a.ws + WS_FH2);
        for (int it = F.vcu; it < 2 * 288; it += F.G) {
            const int l = it / 288, tb = it % 288, tl = F.tid >> 6, j = F.tid & 63;
            const int tt = tb * 8 + tl; const int L = tt < SEQ ? SEQ : CTX, t = tt < SEQ ? tt : tt - SEQ;
            if (j < 33) { const float wv = (6.283185307179586f / (float)L) * (float)t; float v;
                if (j == 0) v = (float)t / (float)(L - 1);
                else { const int bi = (j - 1) & 15; const float f = 1e-4f + (float)bi * ((15.0f - 1e-4f) / 15.0f); v = j <= 16 ? cosf(f * wv) : -sinf(f * wv); }
                feats[tl * 36 + j] = v; }
            __syncthreads();
            { const float* w1 = a.in[11] + (size_t)l * 33 * 64; float s = a.in[12][l * 64 + j];
              for (int m = 0; m < 33; ++m) s += feats[tl * 36 + m] * w1[m * 64 + j];
              h1[tl * 64 + j] = sinf(a.in[16][l * 64 + j] * s); }
            __syncthreads();
            { const float* w2 = a.in[13] + (size_t)l * 64 * 64; float s = a.in[14][l * 64 + j];
              for (int m = 0; m < 64; ++m) s += h1[tl * 64 + m] * w2[m * 64 + j];
              FH2[((size_t)l * 64 + j) * 2304 + tt] = sinf(a.in[16][l * 64 + j] * s); }
            __syncthreads();
        }
    }
}


#define FFT_HD __device__ __forceinline__
typedef float c2 __attribute__((ext_vector_type(2)));
FFT_HD c2 c2swap(c2 a) { return __builtin_shufflevector(a, a, 1, 0); }
FFT_HD c2 c2mul(c2 a, c2 b) {
    c2 t, d;
    asm("v_pk_mul_f32 %0, %1, %2 op_sel:[0,0] op_sel_hi:[1,0]" : "=&v"(t) : "v"(a), "v"(b));
    asm("v_pk_fma_f32 %0, %1, %2, %3 op_sel:[1,1,0] op_sel_hi:[0,1,1] neg_lo:[0,1,0]" : "=&v"(d) : "v"(a), "v"(b), "v"(t));
    return d;
}
FFT_HD c2 c2mulconj(c2 a, c2 b) {
    c2 t, d;
    asm("v_pk_mul_f32 %0, %1, %2 op_sel:[0,0] op_sel_hi:[1,0] neg_hi:[0,1]" : "=&v"(t) : "v"(a), "v"(b));
    asm("v_pk_fma_f32 %0, %1, %2, %3 op_sel:[1,1,0] op_sel_hi:[0,1,1] neg_lo:[0,1,0] neg_hi:[0,1,0]" : "=&v"(d) : "v"(a), "v"(b), "v"(t));
    return d;
}
FFT_HD c2 c2mulk(c2 a, float br, float bi) { return c2mul(a, (c2){br, bi}); }
FFT_HD c2 c2add_mi(c2 s, c2 t) { c2 d; asm("v_pk_add_f32 %0, %1, %2 op_sel:[0,1] op_sel_hi:[1,0] neg_hi:[0,1]" : "=&v"(d) : "v"(s), "v"(t)); return d; }
FFT_HD c2 c2sub_mi(c2 s, c2 t) { c2 d; asm("v_pk_add_f32 %0, %1, %2 op_sel:[0,1] op_sel_hi:[1,0] neg_lo:[0,1]" : "=&v"(d) : "v"(s), "v"(t)); return d; }
FFT_HD void dft4v(c2& a, c2& b, c2& c, c2& d) {
    const c2 s0 = a + c, s1 = a - c, s2 = b + d, t = b - d;
    a = s0 + s2; c = s0 - s2; b = c2add_mi(s1, t); d = c2sub_mi(s1, t);
}
FFT_HD void dft4v_z(c2& a, c2& b, c2& c, c2& d) {
    const c2 a0 = a, b0 = b; a = a0 + b0; c = a0 - b0; b = c2add_mi(a0, b0); d = c2sub_mi(a0, b0);
}
FFT_HD void dft4v_cr(c2& a, c2& b, c2& c, c2& d) {
    const c2 s0 = c2add_mi(a, c), s1 = c2sub_mi(a, c), s2 = b + d, t = b - d;
    a = s0 + s2; c = s0 - s2; b = c2add_mi(s1, t); d = c2sub_mi(s1, t);
}
#define PERM16(k) ((((k) >> 2) & 3) + 4 * ((k) & 3))
template <bool ZH> FFT_HD void dft16v(c2 (&v)[16]) {
    const float C1 = 0.92387953251128674f, S1 = 0.38268343236508978f, R2 = 0.70710678118654752f;
#pragma unroll
    for (int na = 0; na < 4; ++na) { if (ZH) dft4v_z(v[na], v[na + 4], v[na + 8], v[na + 12]); else dft4v(v[na], v[na + 4], v[na + 8], v[na + 12]); }
    v[5] = c2mulk(v[5], C1, -S1); v[6] = c2mulk(v[6], R2, -R2); v[7] = c2mulk(v[7], S1, -C1);
    v[9] = c2mulk(v[9], R2, -R2);   v[11] = c2mulk(v[11], -R2, -R2);
    v[13] = c2mulk(v[13], S1, -C1); v[14] = c2mulk(v[14], -R2, -R2); v[15] = c2mulk(v[15], -C1, S1);
    dft4v(v[0], v[1], v[2], v[3]); dft4v(v[4], v[5], v[6], v[7]); dft4v_cr(v[8], v[9], v[10], v[11]); dft4v(v[12], v[13], v[14], v[15]);
}

typedef c2 cf2;
__device__ __forceinline__ void fft_twiddles(int tid, LAS cf2* T, c2 (&tw2)[16]) {
    const int tt = tid & 255, n0 = tt & 15, k2 = tt >> 4;
    LAS cf2* scr = T + 256 + tid * 17;
    if (tid < 256) { float s, c; const int m1 = (16 * (tid >> 4) * (tid & 15)) & 4095; sincosf(-6.283185307179586f * (float)m1 * (1.0f / 4096.0f), &s, &c); T[tid] = (cf2){c, s}; }
#pragma unroll 1
    for (int k = 0; k < 16; ++k) { float s, c; const int m2 = (n0 * (k2 + 16 * k)) & 4095; sincosf(-6.283185307179586f * (float)m2 * (1.0f / 4096.0f), &s, &c); scr[k] = (cf2){c, s}; }
    LDS_WAIT(); asm volatile("" ::: "memory");
#pragma unroll
    for (int k = 0; k < 16; ++k) tw2[k] = scr[k];
    __syncthreads();
}
template <bool TABLE2, bool ZH = false> __device__ __forceinline__ void fft4096(c2 (&v)[16], LAS cf2* buf, int tt, const LAS cf2* T, const c2 (&tw2)[16]) {
    dft16v<ZH>(v);
    { const LAS cf2* T1 = T + (tt >> 4) * 16;
#pragma unroll
      for (int k = 0; k < 16; ++k) { c2 a = v[PERM16(k)]; if (k) a = c2mul(a, T1[k]); buf[tt + 272 * k] = a; } }
    __syncthreads();
    const int n0 = tt & 15, k2 = tt >> 4;
#pragma unroll
    for (int n1 = 0; n1 < 16; ++n1) v[n1] = buf[n0 + 16 * n1 + 272 * k2];
    __syncthreads();
    dft16v<false>(v);
    { const LAS cf2* T2 = T + n0 * 16;
#pragma unroll
      for (int k1 = 0; k1 < 16; ++k1) { c2 w = tw2[TABLE2 ? 0 : k1]; if (TABLE2 && k1) w = c2mul(w, T2[k1]); buf[k2 + 16 * k1 + 257 * n0] = c2mul(v[PERM16(k1)], w); } }
    __syncthreads();
#pragma unroll
    for (int m = 0; m < 16; ++m) v[m] = buf[tt + 257 * m];
    __syncthreads();
    dft16v<false>(v);
    { c2 w[16];
#pragma unroll
      for (int k = 0; k < 16; ++k) w[k] = v[PERM16(k)];
#pragma unroll
      for (int k = 0; k < 16; ++k) v[k] = w[k]; }
}

template <int NP> __device__ __forceinline__ void filt_taps4(const float* FH2T, const LAS float* w3s, int p0, float (&d)[NP][4][4]) {
#pragma unroll
    for (int g = 0; g < NP; ++g)
#pragma unroll
        for (int i = 0; i < 4; ++i)
#pragma unroll
            for (int od = 0; od < 4; ++od) d[g][i][od] = 0.f;
#pragma unroll 4
    for (int j = 0; j < 64; ++j) { const f32x4 w = *(const LAS f32x4*)(w3s + j * 4);
#pragma unroll
        for (int g = 0; g < NP; ++g) { const f32x4 h = *(const f32x4*)(FH2T + (size_t)j * 2304 + p0 + 1024 * g);
#pragma unroll
            for (int i = 0; i < 4; ++i)
#pragma unroll
                for (int od = 0; od < 4; ++od) d[g][i][od] += h[i] * w[od]; } }
}
__device__ __forceinline__ void ph_filters(const Args& a, const Frame& F) {
    const int team = F.tid >> 8, tt = F.tid & 255, tw = (F.tid >> 6) & 3;
    LAS cf2* fbuf = (LAS cf2*)F.lds;
    LAS cf2* TW = fbuf + 2 * 4352;
    LAS cf2* zt = TW + 256 + team * 4096;
    LAS float* w3s = (LAS float*)(TW + 256 + 2 * 4096) + team * 256;
    LAS float* red = (LAS float*)(TW + 256 + 2 * 4096) + 512 + team * 16;
    LAS float* cx = (LAS float*)(fbuf + team * 4352);
    c2 tw2[16]; fft_twiddles(F.tid, TW, tw2);
    for (int it = F.vcu; it < 2 * (D / 2); it += F.G) {
        const int l = it / (D / 2), c = 2 * (it % (D / 2)) + team;
        const float* FH2 = (const float*)(a.ws + WS_FH2) + (size_t)l * 64 * 2304;
        __syncthreads();
        { const int od = tt >> 6, j = tt & 63; w3s[j * 4 + od] = a.in[15][((size_t)l * 64 + j) * 4096 + od * 1024 + c]; }
        __syncthreads();
        const float ad = fabsf(-3.0701134573f + (float)c * ((-15.3505672866f + 3.0701134573f) / 1023.0f));
        float s0 = 0.f, s1 = 0.f, c0 = 0.f, c1 = 0.f;
        { float d[2][4][4]; filt_taps4<2>(FH2, w3s, 4 * tt, d);
#pragma unroll
          for (int g = 0; g < 2; ++g)
#pragma unroll
              for (int i = 0; i < 4; ++i) { const int t = 4 * tt + i + 1024 * g; const float win = __expf(-((float)t / (float)(SEQ - 1)) * ad);
                  const float k0 = d[g][i][0] * win, k1 = d[g][i][1] * win, k2 = d[g][i][2] * win, k3 = d[g][i][3] * win;
                  s0 += fabsf(k0) + (t > 0 ? fabsf(k1) : 0.f); s1 += fabsf(k2) + (t > 0 ? fabsf(k3) : 0.f);
                  zt[t] = (cf2){k0, k2}; if (t > 0) zt[4096 - t] = (cf2){k1, k3}; } }
        if (tt == 0) zt[2048] = (cf2){0.f, 0.f};
        if (l == 0 && tt < 64) { float d[1][4][4]; filt_taps4<1>(FH2 + SEQ, w3s, 4 * tt, d);
#pragma unroll
            for (int i = 0; i < 4; ++i) { const int t = 4 * tt + i; const float win = __expf(-((float)t / (float)(CTX - 1)) * ad);
                const float k0 = d[0][i][0] * win, k1 = d[0][i][1] * win, k2 = d[0][i][2] * win, k3 = d[0][i][3] * win;
                cx[t] = k0; cx[256 + t] = k1; cx[512 + t] = k2; cx[768 + t] = k3;
                c0 += fabsf(k0) + (t > 0 ? fabsf(k1) : 0.f); c1 += fabsf(k2) + (t > 0 ? fabsf(k3) : 0.f); } }
        s0 = wave_sum(s0); s1 = wave_sum(s1); c0 = wave_sum(c0); c1 = wave_sum(c1);
        if (F.lane == 0) { red[tw * 4] = s0; red[tw * 4 + 1] = s1; red[tw * 4 + 2] = c0; red[tw * 4 + 3] = c1; }
        __syncthreads();
        const float i0 = 1.0f / ((red[0] + red[4]) + (red[8] + red[12])), i1 = 1.0f / ((red[1] + red[5]) + (red[9] + red[13]));
        if (l == 0) { const float j0 = 1.0f / ((red[2] + red[6]) + (red[10] + red[14])), j1 = 1.0f / ((red[3] + red[7]) + (red[11] + red[15]));
            float* TF = (float*)(a.ws + WS_TFC);
#pragma unroll
            for (int od = 0; od < 4; ++od) TF[((size_t)od * D + c) * CTX + tt] = cx[od * 256 + tt] * (od < 2 ? j0 : j1); }
        c2 v[16];
#pragma unroll
        for (int j = 0; j < 16; ++j) { const cf2 r = zt[tt + 256 * j]; v[j] = (c2){r.x * i0, r.y * i1}; }
        __syncthreads();
        fft4096<true>(v, fbuf + team * 4352, tt, TW, tw2);
#pragma unroll
        for (int j = 0; j < 16; ++j) zt[tt + 256 * j] = v[j];
        __syncthreads();
        { cf2* K0 = (cf2*)(a.ws + WS_KF) + (((size_t)l * 2 + 0) * D + c) * 4096; cf2* K1 = (cf2*)(a.ws + WS_KF) + (((size_t)l * 2 + 1) * D + c) * 4096;
          const float sc = 0.5f / 4096.0f;
#pragma unroll
          for (int j = 0; j < 16; ++j) { const int f = tt + 256 * j; const cf2 zb = zt[(4096 - f) & 4095]; const float ar = v[j].x, ai = v[j].y, br = zb.x, bi = zb.y;
              K0[f] = (cf2){(ar + br) * sc, (ai - bi) * sc}; K1[f] = (cf2){(ai + bi) * sc, -(ar - br) * sc}; } }
    }
}

constexpr int NITW = NE * ((D / 128) * (NGU / 32) + (DE / 128) * (D / 32));
__device__ __forceinline__ void wx_load(const Args& a, int l, int it, int lane, f32x4 (&v)[16], unsigned char*& dst, size_t& K) {
    constexpr int I_GU = (D / 128) * (NGU / 32), I_D = (DE / 128) * (D / 32);
    unsigned char* WGU = a.ws + WS_WGU + (size_t)l * NE * NGU * D; unsigned char* WD = a.ws + WS_WD + (size_t)l * NE * D * DE;
    const float* src; size_t ld;
    if (it < NE * I_GU) { const int e = it / I_GU, r = it % I_GU, kb = r / (NGU / 32), nb = r % (NGU / 32); const int n0 = 32 * nb, jt = n0 >> 8, rr = n0 & 255;
        src = (rr < 128 ? a.in[31] : a.in[32]) + ((size_t)l * NE + e) * D * DE + (size_t)(128 * kb) * DE + 128 * jt + (rr & 127); ld = DE;
        dst = WGU + (size_t)e * NGU * D + (size_t)n0 * D + 128 * kb; K = D; }
    else { const int r0 = it - NE * I_GU, e = r0 / I_D, r = r0 % I_D, kb = r / (D / 32), nb = r % (D / 32);
        src = a.in[33] + ((size_t)l * NE + e) * DE * D + (size_t)(128 * kb) * D + 32 * nb; ld = D;
        dst = WD + (size_t)e * D * DE + (size_t)(32 * nb) * DE + 128 * kb; K = DE; }
    const float* p = src + (size_t)(16 * (lane >> 3)) * ld + (lane & 7) * 4;
#pragma unroll
    for (int i = 0; i < 16; ++i) v[i] = *(const f32x4*)(p + (size_t)i * ld);
}
__device__ __forceinline__ void wx_store(const f32x4 (&v)[16], unsigned char* dst, size_t K, int lane) {
    unsigned char* q = dst + (size_t)(4 * (lane & 7)) * K + 16 * (lane >> 3);
#pragma unroll
    for (int j = 0; j < 4; ++j) { v4u o;
        o.x = pk4_fp8(v[0][j] * 32.f, v[1][j] * 32.f, v[2][j] * 32.f, v[3][j] * 32.f); o.y = pk4_fp8(v[4][j] * 32.f, v[5][j] * 32.f, v[6][j] * 32.f, v[7][j] * 32.f);
        o.z = pk4_fp8(v[8][j] * 32.f, v[9][j] * 32.f, v[10][j] * 32.f, v[11][j] * 32.f); o.w = pk4_fp8(v[12][j] * 32.f, v[13][j] * 32.f, v[14][j] * 32.f, v[15][j] * 32.f);
        *(v4u*)(q + (size_t)j * K) = o; }
}

template <int MODE, bool COMB> __device__ __forceinline__ void ph_norm(const Args& a, const Frame& F, int l, int rlo = 0, int rhi = -1) {
    const int gw = F.vcu * 8 + F.wave, NGW = F.G * 8, lane = F.lane;
    float* X = (float*)(a.ws + WS_X); bf16* H = (bf16*)(a.ws + WS_H);
    const float* MOD = (const float*)(a.ws + WS_MOD);
    LAS float* WRt = (LAS float*)F.lds;
    if (MODE == 1) { const float* wr = a.in[30] + (size_t)l * D * NE; for (int i = F.tid; i < D * NE; i += 512) WRt[(i & 15) * 1024 + (i >> 4)] = wr[i]; __syncthreads(); }
    const float* g = MODE == 0 ? a.in[6] + l * D : (MODE == 1 ? a.in[7] + l * D : a.in[34]);
    const int nrows = rhi >= 0 ? rhi : (MODE == 2 ? MLAT : MTOT);
    for (int rowA = rlo + gw; rowA < nrows; rowA += 2 * NGW) {
        const int nr = rowA + NGW < nrows ? 2 : 1;
        f32x4 v[2][4]; int myinv[2] = {-1, -1};
#pragma unroll
        for (int h = 0; h < 2; ++h) if (h < nr) { const int row = rowA + h * NGW; const f32x4* xr = (const f32x4*)(X + (size_t)row * D) + lane;
#pragma unroll
            for (int j = 0; j < 4; ++j) v[h][j] = xr[64 * j];
            if (COMB) myinv[h] = ((const int*)(a.ws + WS_INV))[(size_t)row * NE + (lane & 15)]; }
        if (COMB) {
            const int lp = MODE == 2 ? 1 : l - 1;
            const float* SELG = (const float*)(a.ws + WS_SELG); const bf16* YS = (const bf16*)(a.ws + WS_YS);
#pragma unroll
            for (int h = 0; h < 2; ++h) if (h < nr) { const int row = rowA + h * NGW, r = row < MLAT ? (row >> 11) : 8;
                unsigned m = (unsigned)(__ballot(myinv[h] >= 0) & 0xFFFFull);
                f32x4 acc[4];
#pragma unroll
                for (int j = 0; j < 4; ++j) acc[j] = (f32x4){0.f, 0.f, 0.f, 0.f};
                while (m) {
                    int ee[4], ss[4]; float gt[4]; v2u y[4][4];
#pragma unroll
                    for (int k = 0; k < 4; ++k) { ee[k] = m ? __builtin_ctz(m) : -1; if (m) m &= m - 1; ss[k] = ee[k] >= 0 ? __shfl(myinv[h], ee[k] < 0 ? 0 : ee[k]) : 0; }
#pragma unroll
                    for (int k = 0; k < 4; ++k) { const int e = ee[k] < 0 ? 0 : ee[k]; gt[k] = ee[k] >= 0 ? SELG[e * EROWS + ss[k]] : 0.f; const v2u* yr = (const v2u*)(YS + ((size_t)e * EROWS + ss[k]) * D) + lane;
#pragma unroll
                        for (int j = 0; j < 4; ++j) y[k][j] = yr[64 * j]; }
#pragma unroll
                    for (int k = 0; k < 4; ++k)
#pragma unroll
                        for (int j = 0; j < 4; ++j) acc[j] += gt[k] * (f32x4){bflo(y[k][j].x), bfhi(y[k][j].x), bflo(y[k][j].y), bfhi(y[k][j].y)};
                }
                const f32x4* m5 = (const f32x4*)(MOD + ((size_t)lp * 9 + r) * 6144 + 5 * 1024) + lane;
#pragma unroll
                for (int j = 0; j < 4; ++j) v[h][j] += m5[64 * j] * acc[j];
                if (MODE != 2) { f32x4* xw = (f32x4*)(X + (size_t)row * D) + lane;
#pragma unroll
                    for (int j = 0; j < 4; ++j) xw[64 * j] = v[h][j]; } }
        }
#pragma unroll
        for (int h = 0; h < 2; ++h) if (h < nr) { const int row = rowA + h * NGW, r = row < MLAT ? (row >> 11) : 8;
            float ss = 0.f;
#pragma unroll
            for (int j = 0; j < 4; ++j) ss += (v[h][j][0] * v[h][j][0] + v[h][j][1] * v[h][j][1]) + (v[h][j][2] * v[h][j][2] + v[h][j][3] * v[h][j][3]);
            const float rstd = 1.0f / sqrtf(wave_sum(ss) * (1.0f / D) + 1e-6f);
            const f32x4* gp = (const f32x4*)g + lane;
            if (MODE == 2) { f32x4* o = (f32x4*)(a.out + (size_t)row * D) + lane;
#pragma unroll
                for (int j = 0; j < 4; ++j) o[64 * j] = v[h][j] * rstd * gp[64 * j];
            } else {
                const float* mrow = MOD + ((size_t)l * 9 + r) * 6144 + (MODE == 0 ? 0 : 3 * 1024);
                const f32x4* sh = (const f32x4*)mrow + lane; const f32x4* sc = (const f32x4*)(mrow + 1024) + lane;
                v2u* o8 = (v2u*)(H + (size_t)row * D) + lane;
#pragma unroll
                for (int j = 0; j < 4; ++j) { v[h][j] = (v[h][j] * rstd * gp[64 * j]) * (1.0f + sc[64 * j]) + sh[64 * j]; v2u w; w.x = pk2(v[h][j][0], v[h][j][1]); w.y = pk2(v[h][j][2], v[h][j][3]); o8[64 * j] = w; }
                if (MODE == 1) {
                    float p[16];
#pragma unroll
                    for (int e = 0; e < NE; ++e) { float s = 0.f;
#pragma unroll
                        for (int j = 0; j < 4; ++j) { const f32x4 w = *(const LAS f32x4*)(WRt + e * 1024 + 4 * lane + 256 * j); s += (v[h][j][0] * w[0] + v[h][j][1] * w[1]) + (v[h][j][2] * w[2] + v[h][j][3] * w[3]); }
                        p[e] = s; if (e & 1) asm volatile("" ::: "memory"); }
#pragma unroll
                    for (int i = 0; i < 8; ++i) { const bool up = lane & 32; const float keep = up ? p[i + 8] : p[i], send = up ? p[i] : p[i + 8]; p[i] = keep + __shfl_xor(send, 32); }
#pragma unroll
                    for (int i = 0; i < 4; ++i) { const bool up = lane & 16; const float keep = up ? p[i + 4] : p[i], send = up ? p[i] : p[i + 4]; p[i] = keep + __shfl_xor(send, 16); }
#pragma unroll
                    for (int i = 0; i < 2; ++i) { const bool up = lane & 8; const float keep = up ? p[i + 2] : p[i], send = up ? p[i] : p[i + 2]; p[i] = keep + __shfl_xor(send, 8); }
                    { const bool up = lane & 4; const float keep = up ? p[1] : p[0], send = up ? p[0] : p[1]; p[0] = keep + __shfl_xor(send, 4); }
                    float mine = p[0]; mine += __shfl_xor(mine, 1); mine += __shfl_xor(mine, 2);
                    float mx = mine;
#pragma unroll
                    for (int o = 4; o < 64; o <<= 1) mx = fmaxf(mx, __shfl_xor(mx, o));
                    const float pe = expf(mine - mx); float den = pe;
#pragma unroll
                    for (int o = 4; o < 64; o <<= 1) den += __shfl_xor(den, o);
                    if ((lane & 3) == 0) ((float*)(a.ws + WS_AFF))[(size_t)row * NE + (lane >> 2)] = pe / den;
                }
            }
        }
    }
}

__device__ __forceinline__ void ph_rank(const Args& a, const Frame& F, int l) {
    LAS unsigned* part = (LAS unsigned*)F.lds;
    const float* AFF = (const float*)(a.ws + WS_AFF); float* SELG = (float*)(a.ws + WS_SELG); int* INV = (int*)(a.ws + WS_INV);
    const bf16* H = (const bf16*)(a.ws + WS_H); unsigned char* XS = a.ws + WS_XS;
    const int tid = F.tid, lane = F.lane, wave = F.wave;
    const unsigned long long ltmask = (1ull << lane) - 1ull;
    const int nitems = 128 + (l == 0 ? 128 : 0);
    for (int it = F.vcu; it < nitems; it += F.G) {
        const bool isctx = it >= 128; const int r = it & 127, e = r & 15, b = r >> 4;
        const int n = isctx ? CTX : SEQ, cap = isctx ? 32 : 256, row0 = isctx ? MLAT + b * CTX : b * SEQ, slot0 = isctx ? 2048 + b * 32 : b * 256;
        unsigned k[4];
#pragma unroll
        for (int q = 0; q < 4; ++q) { const int j = 4 * tid + q; k[q] = j < n ? __builtin_bit_cast(unsigned, AFF[(size_t)(row0 + j) * NE + e]) : 0u; }
        __syncthreads();
        unsigned prefix = 0u;
#pragma unroll 1
        for (int bit = 28; bit >= 0; bit -= 2) {
            const unsigned c1 = prefix | (1u << bit), c2 = prefix | (2u << bit), c3 = prefix | (3u << bit);
            unsigned n1 = 0, n2 = 0, n3 = 0;
#pragma unroll
            for (int q = 0; q < 4; ++q) { n1 += __popcll(__ballot(k[q] >= c1)); n2 += __popcll(__ballot(k[q] >= c2)); n3 += __popcll(__ballot(k[q] >= c3)); }
            LAS unsigned* pb = part + ((bit >> 1) & 1) * 24;
            if (lane == 0) { pb[wave] = n1; pb[8 + wave] = n2; pb[16 + wave] = n3; }
            __syncthreads();
            const v4u a0 = *(const LAS v4u*)pb, a1 = *(const LAS v4u*)(pb + 4), b0 = *(const LAS v4u*)(pb + 8), b1 = *(const LAS v4u*)(pb + 12), d0 = *(const LAS v4u*)(pb + 16), d1 = *(const LAS v4u*)(pb + 20);
            const unsigned t1 = ((a0.x + a0.y) + (a0.z + a0.w)) + ((a1.x + a1.y) + (a1.z + a1.w)), t2 = ((b0.x + b0.y) + (b0.z + b0.w)) + ((b1.x + b1.y) + (b1.z + b1.w)),
                           t3 = ((d0.x + d0.y) + (d0.z + d0.w)) + ((d1.x + d1.y) + (d1.z + d1.w));
            if ((int)t3 >= cap) prefix = c3; else if ((int)t2 >= cap) prefix = c2; else if ((int)t1 >= cap) prefix = c1;
        }
        const unsigned T = prefix;
        __syncthreads();
        { const unsigned c = __popcll(__ballot(k[0] > T)) + __popcll(__ballot(k[1] > T)) + __popcll(__ballot(k[2] > T)) + __popcll(__ballot(k[3] > T));
          if (lane == 0) part[wave] = c; }
        unsigned long long be[4]; unsigned weq = 0;
#pragma unroll
        for (int q = 0; q < 4; ++q) { be[q] = __ballot(k[q] == T); weq += __popcll(be[q]); }
        if (lane == 0) part[16 + wave] = weq;
        __syncthreads();
        unsigned ngt = 0, eqbase = 0;
#pragma unroll
        for (int w = 0; w < 8; ++w) { ngt += part[w]; if (w < wave) eqbase += part[16 + w]; }
        const int need = cap - (int)ngt;
        unsigned eqrank = eqbase + __popcll(be[0] & ltmask) + __popcll(be[1] & ltmask) + __popcll(be[2] & ltmask) + __popcll(be[3] & ltmask);
        bool sel[4];
#pragma unroll
        for (int q = 0; q < 4; ++q) { const bool eq = k[q] == T; sel[q] = k[q] > T || (eq && (int)eqrank < need); eqrank += eq ? 1u : 0u; }
        __syncthreads();
        unsigned long long bs[4]; unsigned wsel = 0;
#pragma unroll
        for (int q = 0; q < 4; ++q) { bs[q] = __ballot(sel[q]); wsel += __popcll(bs[q]); }
        if (lane == 0) part[wave] = wsel;
        __syncthreads();
        unsigned sbase = 0;
#pragma unroll
        for (int w = 0; w < 8; ++w) if (w < wave) sbase += part[w];
        unsigned srank = sbase + __popcll(bs[0] & ltmask) + __popcll(bs[1] & ltmask) + __popcll(bs[2] & ltmask) + __popcll(bs[3] & ltmask);
        int slot[4];
#pragma unroll
        for (int q = 0; q < 4; ++q) { const int j = 4 * tid + q; slot[q] = -1;
            if (sel[q]) { slot[q] = slot0 + (int)srank; ++srank; SELG[e * EROWS + slot[q]] = __builtin_bit_cast(float, k[q]); }
            if (j < n) INV[(size_t)(row0 + j) * NE + e] = slot[q]; }
        { LAS int* lst = (LAS int*)(part + 64) + wave * 512;
          unsigned wr_ = __popcll(bs[0] & ltmask) + __popcll(bs[1] & ltmask) + __popcll(bs[2] & ltmask) + __popcll(bs[3] & ltmask);
#pragma unroll
          for (int q = 0; q < 4; ++q) if (sel[q]) { lst[2 * wr_] = row0 + 4 * tid + q; lst[2 * wr_ + 1] = slot[q]; ++wr_; }
          LDS_WAIT(); asm volatile("" ::: "memory");
          const int nsel = (int)wsel;
          for (int i0 = 0; i0 < nsel; i0 += 4) { v4u r0[4], r1[4]; int sl[4];
#pragma unroll
              for (int k = 0; k < 4; ++k) { const int i = i0 + k < nsel ? i0 + k : nsel - 1; const int rw = lst[2 * i]; sl[k] = lst[2 * i + 1];
                  const v4u* hp = (const v4u*)(H + (size_t)rw * D) + lane; r0[k] = hp[0]; r1[k] = hp[64]; }
#pragma unroll
              for (int k = 0; k < 4; ++k) { v2u* xp = (v2u*)(XS + ((size_t)e * EROWS + sl[k]) * D) + lane;
                  v2u w0, w1; w0.x = pk4_fp8(bflo(r0[k].x), bfhi(r0[k].x), bflo(r0[k].y), bfhi(r0[k].y)); w0.y = pk4_fp8(bflo(r0[k].z), bfhi(r0[k].z), bflo(r0[k].w), bfhi(r0[k].w));
                  w1.x = pk4_fp8(bflo(r1[k].x), bfhi(r1[k].x), bflo(r1[k].y), bfhi(r1[k].y)); w1.y = pk4_fp8(bflo(r1[k].z), bfhi(r1[k].z), bflo(r1[k].w), bfhi(r1[k].w));
                  xp[0] = w0; xp[64] = w1; } }
        }
        __syncthreads();
    }
}
__device__ __forceinline__ float conv3_at(const bf16* rowp, int t, int L, float w0, float w1, float w2, float bias) {
    const int tm = t > 0 ? t - 1 : 0, tp = t < L - 1 ? t + 1 : L - 1;
    const float vm = bf2f(rowp[tm]), x0 = bf2f(rowp[t]), vp = bf2f(rowp[tp]);
    const float xm = t > 0 ? vm : 0.f, xp = t < L - 1 ? vp : 0.f;
    return w0 * xm + w1 * x0 + w2 * xp + bias;
}
template <int L> __device__ __forceinline__ void hyena_direct_item(const Args& a, const Frame& F, int l, int c) {
    constexpr int NBQ = L == SEQ ? 4 : 8, NPASS = NB / NBQ, TP = L >= 512 ? L / 512 : 1, BP = NBQ * L / 512 / TP;
    constexpr int ROW0 = L == SEQ ? 0 : MLAT;
    LAS float* kk = (LAS float*)F.lds;
    LAS float* ub = kk + 2 * L;
    LAS float* zb = ub + NBQ * L;
    const bf16* HYT = (const bf16*)(a.ws + WS_HYT); bf16* YAT = (bf16*)(a.ws + WS_YAT);
    const float* TF = (const float*)(a.ws + WS_TFC);
    const float* cw = a.in[9] + (size_t)l * 3 * NHY; const float* cb = a.in[10] + (size_t)l * NHY;
    float w[3][3], bs[3];
#pragma unroll
    for (int s = 0; s < 3; ++s) { bs[s] = cb[s * D + c];
#pragma unroll
        for (int k = 0; k < 3; ++k) w[s][k] = cw[k * NHY + s * D + c]; }
    const float hb0 = a.in[17][((size_t)l * 2 + 0) * D + c], hb1 = a.in[17][((size_t)l * 2 + 1) * D + c];
    int tq[TP], bq[BP];
#pragma unroll
    for (int i = 0; i < TP; ++i) tq[i] = L >= 512 ? F.tid + 512 * i : (F.tid & (L - 1));
#pragma unroll
    for (int i = 0; i < BP; ++i) bq[i] = L >= 512 ? i : (F.tid / L) + (512 / L) * i;
    for (int ps = 0; ps < NPASS; ++ps) {
        for (int i = F.tid; i < NBQ * L; i += 512) { const int b = i / L, t = i % L; const bf16* rp = HYT + (size_t)(2 * D + c) * MTOT + ROW0 + (ps * NBQ + b) * L;
            ub[i] = conv3_at(rp, t, L, w[2][0], w[2][1], w[2][2], bs[2]); }
#pragma unroll 1
        for (int o = 0; o < 2; ++o) {
            __syncthreads();
            for (int t = F.tid; t < L; t += 512) { kk[L - 1 + t] = TF[((size_t)(o * 2 + 0) * D + c) * L + t]; if (t > 0) kk[L - 1 - t] = TF[((size_t)(o * 2 + 1) * D + c) * L + t]; }
            __syncthreads();
            const LAS float* src = o == 0 ? ub : zb;
            float acc[TP][BP];
#pragma unroll
            for (int i = 0; i < TP; ++i)
#pragma unroll
                for (int j = 0; j < BP; ++j) acc[i][j] = 0.f;
            for (int s = 0; s < L; ++s) { float kv[TP], uv[BP];
#pragma unroll
                for (int i = 0; i < TP; ++i) kv[i] = kk[tq[i] - s + L - 1];
#pragma unroll
                for (int j = 0; j < BP; ++j) uv[j] = src[bq[j] * L + s];
#pragma unroll
                for (int i = 0; i < TP; ++i)
#pragma unroll
                    for (int j = 0; j < BP; ++j) acc[i][j] += kv[i] * uv[j]; }
            __syncthreads();
#pragma unroll
            for (int i = 0; i < TP; ++i)
#pragma unroll
                for (int j = 0; j < BP; ++j) { const int t = tq[i], b = bq[j]; const int gb = ps * NBQ + b;
                    const bf16* rp = HYT + (size_t)(o * D + c) * MTOT + ROW0 + gb * L;
                    const float xg = o == 0 ? conv3_at(rp, t, L, w[0][0], w[0][1], w[0][2], bs[0]) : conv3_at(rp, t, L, w[1][0], w[1][1], w[1][2], bs[1]);
                    const float uin = src[b * L + t];
                    const float r = xg * (acc[i][j] + uin * (o == 0 ? hb0 : hb1));
                    if (o == 0) zb[b * L + t] = r; else YAT[(size_t)c * MTOT + ROW0 + gb * L + t] = (bf16)f2bf(r); }
        }
        __syncthreads();
    }
}

__device__ __forceinline__ void read8_lds(const LAS unsigned short* row, int tt, float (&o)[8]) {
#pragma unroll
    for (int j = 0; j < 8; ++j) o[j] = bf2f(row[tt + 256 * j]);
}
__device__ __forceinline__ void hy_load_rows(const bf16* HYT, int c, int p, int tt, v4u (&pre)[6], unsigned (&lf)[6], unsigned (&rg)[6]) {
#pragma unroll
    for (int r = 0; r < 6; ++r) { const int f = (r < 2 ? 2 * D : (r < 4 ? 0 : D)) + c, bb = 2 * p + (r & 1); const bf16* rp = HYT + (size_t)f * MTOT + bb * SEQ;
        pre[r] = *(const v4u*)(rp + tt * 8);
        lf[r] = rp[tt > 0 ? 8 * tt - 1 : 0]; rg[r] = rp[tt < 255 ? 8 * tt + 8 : SEQ - 1]; }
}
__device__ __forceinline__ v4u hy_conv_vec(v4u x, unsigned lf, unsigned rg, int tt, float w0, float w1, float w2, float bias) {
    float e[10]; e[0] = tt > 0 ? bf2f((unsigned short)lf) : 0.f; e[1] = bflo(x.x); e[2] = bfhi(x.x); e[3] = bflo(x.y); e[4] = bfhi(x.y); e[5] = bflo(x.z); e[6] = bfhi(x.z); e[7] = bflo(x.w); e[8] = bfhi(x.w);
    e[9] = tt < 255 ? bf2f((unsigned short)rg) : 0.f;
    float y[8];
#pragma unroll
    for (int i = 0; i < 8; ++i) y[i] = w0 * e[i] + w1 * e[i + 1] + w2 * e[i + 2] + bias;
    v4u o; o.x = pg8::cvt_pk_bf16(y[0], y[1]); o.y = pg8::cvt_pk_bf16(y[2], y[3]); o.z = pg8::cvt_pk_bf16(y[4], y[5]); o.w = pg8::cvt_pk_bf16(y[6], y[7]); return o;
}
__device__ __forceinline__ void ph_hyena_fft(const Args& a, const Frame& F, int l) {
    const int team = F.tid >> 8, tt = F.tid & 255;
    LAS cf2* buf = (LAS cf2*)F.lds + team * 4352;
    LAS cf2* tw1 = (LAS cf2*)F.lds + 2 * 4352;
    LAS unsigned short* stage = (LAS unsigned short*)(tw1 + 256) + team * 6 * SEQ;
    c2 tw2[16]; fft_twiddles(F.tid, tw1, tw2);
    const bf16* HYT = (const bf16*)(a.ws + WS_HYT); bf16* YAT = (bf16*)(a.ws + WS_YAT);
    const float* cwb = a.in[9] + (size_t)l * 3 * NHY; const float* cbb = a.in[10] + (size_t)l * NHY;
    v4u pre[6]; unsigned lf[6], rg[6];
    if (F.vcu < D) hy_load_rows(HYT, F.vcu, team, tt, pre, lf, rg);
    for (int c = F.vcu; c < D; c += F.G) {
        const float* cw = cwb + c; const float* cb = cbb + c;
        float w[3][3], bs[3];
#pragma unroll
        for (int s = 0; s < 3; ++s) { bs[s] = cb[s * D];
#pragma unroll
            for (int k = 0; k < 3; ++k) w[s][k] = cw[k * NHY + s * D]; }
        const float hb0 = a.in[17][((size_t)l * 2 + 0) * D + c], hb1 = a.in[17][((size_t)l * 2 + 1) * D + c];
#pragma unroll 1
        for (int pp = 0; pp < 2; ++pp) {
            const int b0 = 2 * (team + 2 * pp), b1 = b0 + 1;
            __syncthreads();
#pragma unroll
            for (int r = 0; r < 6; ++r) { const int s = r < 2 ? 2 : (r < 4 ? 0 : 1);
                *(LAS v4u*)(stage + r * SEQ + tt * 8) = hy_conv_vec(pre[r], lf[r], rg[r], tt, w[s][0], w[s][1], w[s][2], bs[s]); }
            { const int cn = pp == 0 ? c : c + F.G, pn = team + 2 * (pp ^ 1); if (cn < D) hy_load_rows(HYT, cn, pn, tt, pre, lf, rg); }
            __syncthreads();
            float u0[8], u1[8];
            read8_lds(stage + 0 * SEQ, tt, u0); read8_lds(stage + 1 * SEQ, tt, u1);
#pragma unroll 1
            for (int o = 0; o < 2; ++o) {
                cf2 kk[16];
                { const cf2* K = (const cf2*)(a.ws + WS_KF) + (((size_t)l * 2 + o) * D + c) * 4096 + tt;
#pragma unroll
                  for (int k = 0; k < 16; ++k) kk[k] = K[256 * k]; }
                const float hb = o == 0 ? hb0 : hb1;
                c2 v[16];
#pragma unroll
                for (int j = 0; j < 8; ++j) v[j] = (c2){u0[j], u1[j]};
                fft4096<false, true>(v, buf, tt, tw1, tw2);
#pragma unroll
                for (int k = 0; k < 16; ++k) v[k] = c2mulconj(v[k], kk[k]);
                fft4096<false>(v, buf, tt, tw1, tw2);
                float g0[8], g1[8];
                read8_lds(stage + (2 + 2 * o) * SEQ, tt, g0); read8_lds(stage + (3 + 2 * o) * SEQ, tt, g1);
#pragma unroll
                for (int j = 0; j < 8; ++j) { u0[j] = g0[j] * (v[j].x + u0[j] * hb); u1[j] = g1[j] * (-v[j].y + u1[j] * hb); }
            }
            bf16* o0 = YAT + (size_t)c * MTOT + b0 * SEQ + tt; bf16* o1 = YAT + (size_t)c * MTOT + b1 * SEQ + tt;
#pragma unroll
            for (int j = 0; j < 8; ++j) { o0[256 * j] = (bf16)f2bf(u0[j]); o1[256 * j] = (bf16)f2bf(u1[j]); }
        }
    }
    __syncthreads();
}

__device__ __forceinline__ void ph_hyena_ctx(const Args& a, const Frame& F, int l) {
    typedef float f32x2_ __attribute__((ext_vector_type(2)));
    const int team = F.tid >> 8, t = F.tid & 255;
    LAS float* kk = (LAS float*)F.lds + team * 4608;
    LAS float* ub = kk + 512;
    LAS float* zb = ub + 2048;
    const bf16* HYT = (const bf16*)(a.ws + WS_HYT); bf16* YAT = (bf16*)(a.ws + WS_YAT); const float* TF = (const float*)(a.ws + WS_TFC);
    const float* cwb = a.in[9] + (size_t)l * 3 * NHY; const float* cbb = a.in[10] + (size_t)l * NHY;
    for (int it = F.vcu; it < D / 2; it += F.G) {
        const int c = 2 * it + team; const float* cw = cwb + c; const float* cb = cbb + c;
        __syncthreads();
        { const float w0 = cw[2 * D], w1 = cw[NHY + 2 * D], w2 = cw[2 * NHY + 2 * D], bb = cb[2 * D];
          float uu[NB];
#pragma unroll
          for (int b = 0; b < NB; ++b) uu[b] = conv3_at(HYT + (size_t)(2 * D + c) * MTOT + MLAT + b * CTX, t, CTX, w0, w1, w2, bb);
          *(LAS f32x4*)(ub + t * 8) = (f32x4){uu[0], uu[1], uu[2], uu[3]}; *(LAS f32x4*)(ub + t * 8 + 4) = (f32x4){uu[4], uu[5], uu[6], uu[7]}; }
#pragma unroll 1
        for (int o = 0; o < 2; ++o) {
            kk[255 + t] = TF[((size_t)(o * 2 + 0) * D + c) * CTX + t]; if (t > 0) kk[255 - t] = TF[((size_t)(o * 2 + 1) * D + c) * CTX + t];
            const float hb = a.in[17][((size_t)l * 2 + o) * D + c];
            const float w0 = cw[o * D], w1 = cw[NHY + o * D], w2 = cw[2 * NHY + o * D], bb = cb[o * D];
            float xg[NB];
#pragma unroll
            for (int b = 0; b < NB; ++b) xg[b] = conv3_at(HYT + (size_t)(o * D + c) * MTOT + MLAT + b * CTX, t, CTX, w0, w1, w2, bb);
            __syncthreads();
            const LAS float* src = o == 0 ? ub : zb;
            f32x2_ acc[4] = {{0.f, 0.f}, {0.f, 0.f}, {0.f, 0.f}, {0.f, 0.f}};
#pragma unroll 4
            for (int s = 0; s < CTX; ++s) { const float k0 = kk[t + 255 - s]; const f32x2_ kv = {k0, k0};
                const f32x4 ua = *(const LAS f32x4*)(src + s * 8), uc = *(const LAS f32x4*)(src + s * 8 + 4);
                acc[0] += kv * (f32x2_){ua[0], ua[1]}; acc[1] += kv * (f32x2_){ua[2], ua[3]}; acc[2] += kv * (f32x2_){uc[0], uc[1]}; acc[3] += kv * (f32x2_){uc[2], uc[3]}; }
            const f32x4 sa = *(const LAS f32x4*)(src + t * 8), sb = *(const LAS f32x4*)(src + t * 8 + 4);
            float r[NB];
            r[0] = xg[0] * (acc[0][0] + sa[0] * hb); r[1] = xg[1] * (acc[0][1] + sa[1] * hb); r[2] = xg[2] * (acc[1][0] + sa[2] * hb); r[3] = xg[3] * (acc[1][1] + sa[3] * hb);
            r[4] = xg[4] * (acc[2][0] + sb[0] * hb); r[5] = xg[5] * (acc[2][1] + sb[1] * hb); r[6] = xg[6] * (acc[3][0] + sb[2] * hb); r[7] = xg[7] * (acc[3][1] + sb[3] * hb);
            __syncthreads();
            if (o == 0) { *(LAS f32x4*)(zb + t * 8) = (f32x4){r[0], r[1], r[2], r[3]}; *(LAS f32x4*)(zb + t * 8 + 4) = (f32x4){r[4], r[5], r[6], r[7]}; }
            else {
#pragma unroll
                for (int b = 0; b < NB; ++b) YAT[(size_t)c * MTOT + MLAT + b * CTX + t] = (bf16)f2bf(r[b]); }
        }
    }
    __syncthreads();
}

__device__ __forceinline__ void ph_sc(const Args& a, const Frame& F, int l, int nrows) {
    const int gw = F.vcu * 8 + F.wave, NGW = F.G * 8, lane = F.lane;
    const bf16* PR = (const bf16*)(a.ws + WS_PR); bf16* YC = (bf16*)(a.ws + WS_YCAT) + 2ull * MTOT * D;
    const float* cw = a.in[25] + (size_t)l * 3 * D;
    float w[3][16];
#pragma unroll
    for (int k = 0; k < 3; ++k)
#pragma unroll
        for (int j = 0; j < 16; ++j) w[k][j] = cw[k * D + lane * 16 + j];
    for (int row = gw; row < nrows; row += NGW) {
        const int L = row < MLAT ? SEQ : CTX, t = row < MLAT ? (row & (SEQ - 1)) : ((row - MLAT) & (CTX - 1));
        const bf16* pp = PR + (size_t)row * NPR + PR_P + lane * 16;
        v4u z = (v4u){0u, 0u, 0u, 0u};
        v4u m0 = z, m1 = z, n0 = z, n1 = z;
        if (t > 0) { m0 = *(const v4u*)(pp - NPR); m1 = *(const v4u*)(pp - NPR + 8); }
        if (t < L - 1) { n0 = *(const v4u*)(pp + NPR); n1 = *(const v4u*)(pp + NPR + 8); }
        const v4u c0 = *(const v4u*)pp, c1 = *(const v4u*)(pp + 8);
        const bf16* bp = PR + (size_t)row * NPR + PR_BG + lane * 16; const v4u g0 = *(const v4u*)bp, g1 = *(const v4u*)(bp + 8);
        unsigned mm[8] = {m0.x, m0.y, m0.z, m0.w, m1.x, m1.y, m1.z, m1.w}, cc[8] = {c0.x, c0.y, c0.z, c0.w, c1.x, c1.y, c1.z, c1.w}, nn[8] = {n0.x, n0.y, n0.z, n0.w, n1.x, n1.y, n1.z, n1.w}, gg[8] = {g0.x, g0.y, g0.z, g0.w, g1.x, g1.y, g1.z, g1.w};
        unsigned o[8];
#pragma unroll
        for (int j = 0; j < 8; ++j) {
            const float lo = bflo(gg[j]) * (w[0][2 * j] * bflo(mm[j]) + w[1][2 * j] * bflo(cc[j]) + w[2][2 * j] * bflo(nn[j]));
            const float hi = bfhi(gg[j]) * (w[0][2 * j + 1] * bfhi(mm[j]) + w[1][2 * j + 1] * bfhi(cc[j]) + w[2][2 * j + 1] * bfhi(nn[j]));
            o[j] = pk2(lo, hi); }
        v4u* op = (v4u*)(YC + (size_t)row * D + lane * 16); op[0] = (v4u){o[0], o[1], o[2], o[3]}; op[1] = (v4u){o[4], o[5], o[6], o[7]};
    }
}

__device__ __forceinline__ void ph_transpose_ya(const Args& a, const Frame& F, int nrows) {
    const int gw = F.vcu * 8 + F.wave, NGW = F.G * 8, lane = F.lane;
    LAS unsigned short* tl = (LAS unsigned short*)(F.lds + F.wave * 16384);
    const bf16* YAT = (const bf16*)(a.ws + WS_YAT); bf16* YA = (bf16*)(a.ws + WS_YCAT);
    const int nitems = (nrows / 64) * 16;
    for (int it = gw; it < nitems; it += NGW) {
        const int tb = it >> 4, cb = it & 15, tok0 = tb * 64, c0 = cb * 64;
        v4u r[8];
#pragma unroll
        for (int k = 0; k < 8; ++k) r[k] = *(const v4u*)(YAT + (size_t)(c0 + (lane >> 3) + 8 * k) * MTOT + tok0 + (lane & 7) * 8);
#pragma unroll
        for (int k = 0; k < 8; ++k) *(LAS v4u*)(tl + ((lane >> 3) + 8 * k) * 72 + (lane & 7) * 8) = r[k];
        LDS_WAIT(); asm volatile("" ::: "memory");
        unsigned o[32];
#pragma unroll
        for (int j = 0; j < 32; ++j) o[j] = (unsigned)tl[(2 * j) * 72 + lane] | ((unsigned)tl[(2 * j + 1) * 72 + lane] << 16);
        v4u* op = (v4u*)(YA + (size_t)(tok0 + lane) * D + c0);
#pragma unroll
        for (int j = 0; j < 8; ++j) op[j] = (v4u){o[4 * j], o[4 * j + 1], o[4 * j + 2], o[4 * j + 3]};
        LDS_WAIT(); asm volatile("" ::: "memory");
    }
}

__device__ __forceinline__ float neg_expm1_(float x) { return x > -0.02f ? -(x * (1.0f + x * (0.5f + x * 0.16666667f))) : 1.0f - __expf(x); }
template <int PASS> __device__ __forceinline__ void lru_item(const Args& a, const Frame& F, int l, int q, int hd) {
    LAS float* raw = (LAS float*)F.lds;
    LAS float* xc = raw + 67 * 64;
    LAS float* GT = xc + 64 * 65;
    LAS float* SA = GT + 4 * 64 * 65;
    LAS float* CIN = SA + 2 * 4 * 64 * 2;
    LAS unsigned short* xcb = (LAS unsigned short*)(CIN + 128);
    const bf16* PR = (const bf16*)(a.ws + WS_PR);
    const bool isctx = q >= 256; const int b = isctx ? (q - 256) >> 2 : q >> 5, qi = isctx ? (q - 256) & 3 : q & 31;
    const int L = isctx ? CTX : SEQ, seq0 = isctx ? MLAT + b * CTX : b * SEQ, t0 = qi * 64, c0 = hd * 64;
    const int tid = F.tid, lane = F.lane, wave = F.wave;
    const int fr = lane & 15, fq = lane >> 4, gdir = wave >> 2, gax = (wave >> 1) & 1, jb = (wave & 1) * 32;
    float* AGG = (float*)(a.ws + WS_AGG); bf16* LAB = (bf16*)(a.ws + WS_LAB);
    v4u rv[2];
#pragma unroll
    for (int k = 0; k < 2; ++k) { const int i = tid + 512 * k, tr = i >> 3, sg = i & 7, t = t0 - 2 + tr; rv[k] = (v4u){0u, 0u, 0u, 0u};
        if (i < 67 * 8 && t >= 0 && t < L) rv[k] = *(const v4u*)(PR + (unsigned)((seq0 + t) * NPR + PR_REC + c0 + sg * 8)); }
    const int ch = tid & 63;
    const float* cw = a.in[18] + (size_t)l * 4 * D + c0 + ch; const float cw0 = cw[0], cw1 = cw[D], cw2 = cw[2 * D], cw3 = cw[3 * D], cbb = a.in[19][(size_t)l * D + c0 + ch];
    const float* SP = (const float*)(a.ws + WS_SP) + (size_t)l * 2 * D + c0 + 2 * (tid & 31);
    const c2 spm0 = *(const c2*)SP * (c2){-8.0f, -8.0f}, spm1 = *(const c2*)(SP + D) * (c2){-8.0f, -8.0f};
    bf16x8 Bf[2][2]; f32x4 bv[2];
    { const bf16* Wc = (const bf16*)(a.ws + WS_WLRU) + (((size_t)l * 16 + hd) * 256 + 32 * wave) * 64;
#pragma unroll
      for (int nt = 0; nt < 2; ++nt)
#pragma unroll
          for (int ks = 0; ks < 2; ++ks) Bf[nt][ks] = *(const bf16x8*)(Wc + (nt * 16 + fr) * 64 + ks * 32 + fq * 8);
      const float* bias = (gax ? a.in[23] : a.in[21]) + ((size_t)l * 2 + gdir) * D + c0 + jb;
#pragma unroll
      for (int nt = 0; nt < 2; ++nt) bv[nt] = *(const f32x4*)(bias + nt * 16 + 4 * fq); }
    v4u gg = (v4u){0u, 0u, 0u, 0u}; float hcar = 0.f;
    if (PASS == 2) {
        gg = *(const v4u*)(PR + ((size_t)seq0 + t0 + (tid >> 3)) * NPR + PR_GELU + c0 + (tid & 7) * 8);
        if (tid < 128) {
            const int dir = tid >> 6; const float* ag = AGG + ((size_t)dir * NCHUNK) * D * 2 + (size_t)(c0 + ch) * 2;
            const int cbase = 256 + b * 4, lbase = b * 32;
            float ga[35], gb[35];
#pragma unroll
            for (int p = 0; p < 35; ++p) { int chunk; bool valid;
                if (isctx) { chunk = dir == 0 ? cbase + p : cbase + 3 - p; valid = dir == 0 ? p < qi : p < 3 - qi; }
                else if (p < 4) { chunk = dir == 0 ? cbase + p : cbase + 3 - p; valid = true; }
                else { chunk = dir == 0 ? lbase + (p - 4) : lbase + 31 - (p - 4); valid = dir == 0 ? (p - 4) < qi : (p - 4) < 31 - qi; }
                if (p >= 4 && isctx) valid = false;
                ga[p] = 1.f; gb[p] = 0.f;
                if (valid) { const f32x2 g = *(const f32x2*)(ag + (size_t)chunk * D * 2); ga[p] = g[0]; gb[p] = g[1]; } }
#pragma unroll
            for (int p = 0; p < 35; ++p) hcar = ga[p] * hcar + gb[p];
        }
    }
    __syncthreads();
#pragma unroll
    for (int k = 0; k < 2; ++k) { const int i = tid + 512 * k; if (i < 67 * 8) { const v4u r = rv[k];
        LAS float* d = raw + (i >> 3) * 64 + (i & 7) * 8; d[0] = bflo(r.x); d[1] = bfhi(r.x); d[2] = bflo(r.y); d[3] = bfhi(r.y); d[4] = bflo(r.z); d[5] = bfhi(r.z); d[6] = bflo(r.w); d[7] = bfhi(r.w); } }
    if (PASS == 2 && tid < 128) CIN[tid] = hcar;
    __syncthreads();
#pragma unroll
    for (int k = 0; k < 8; ++k) { const int tt = (tid >> 6) + 8 * k;
        const float x = cw0 * raw[tt * 64 + ch] + cw1 * raw[(tt + 1) * 64 + ch] + cw2 * raw[(tt + 2) * 64 + ch] + cw3 * raw[(tt + 3) * 64 + ch] + cbb;
        xc[tt * 65 + ch] = x; xcb[tt * 72 + ch] = (unsigned short)f2bf(x); }
    __syncthreads();
    {
      LAS float* gp = GT + (gdir * 2 + gax) * 64 * 65 + jb + 4 * fq;
#pragma unroll
      for (int mt = 0; mt < 4; ++mt) { f32x4 acc[2] = {bv[0], bv[1]};
#pragma unroll
          for (int ks = 0; ks < 2; ++ks) { const bf16x8 Af = *(const LAS bf16x8*)(xcb + (mt * 16 + fr) * 72 + ks * 32 + fq * 8);
#pragma unroll
              for (int nt = 0; nt < 2; ++nt) acc[nt] = __builtin_amdgcn_mfma_f32_16x16x32_bf16(Bf[nt][ks], Af, acc[nt], 0, 0, 0); }
#pragma unroll
          for (int nt = 0; nt < 2; ++nt)
#pragma unroll
              for (int r = 0; r < 4; ++r) gp[(mt * 16 + fr) * 65 + nt * 16 + r] = sigmoidf_(acc[nt][r]); } }
    __syncthreads();
    {
      const int cp = tid & 31;
#pragma unroll
      for (int k = 0; k < 8; ++k) { const int dir = k >> 2, tt = (tid >> 5) + 16 * (k & 3);
          LAS float* pr = GT + (dir * 2) * 64 * 65 + tt * 65 + 2 * cp; LAS float* pi = pr + 64 * 65;
          const c2 r = (c2){pr[0], pr[1]}, iv = (c2){pi[0], pi[1]}, xv = (c2){xc[tt * 65 + 2 * cp], xc[tt * 65 + 2 * cp + 1]};
          const c2 la = r * (dir ? spm1 : spm0);
          const unsigned labp = pg8::cvt_pk_bf16(la.x, la.y);
          const c2 lar = (c2){__builtin_bit_cast(float, labp << 16), __builtin_bit_cast(float, labp & 0xffff0000u)};
          const c2 ex = lar * (c2){1.4426950408889634f, 1.4426950408889634f};
          const c2 av = (c2){__builtin_amdgcn_exp2f(ex.x), __builtin_amdgcn_exp2f(ex.y)}, x2 = lar + lar;
          const c2 one = (c2){1.0f, 1.0f};
          const c2 pol = -(x2 * (one + x2 * ((c2){0.5f, 0.5f} + x2 * (c2){0.16666667f, 0.16666667f}))), sq = one - av * av;
          const c2 om = (c2){x2.x > -0.02f ? pol.x : sq.x, x2.y > -0.02f ? pol.y : sq.y};
          const c2 bv0 = (c2){__builtin_amdgcn_sqrtf(om.x), __builtin_amdgcn_sqrtf(om.y)} * (iv * xv);
          const unsigned bbp = pg8::cvt_pk_bf16(bv0.x, bv0.y);
          pr[0] = av.x; pr[1] = av.y; pi[0] = __builtin_bit_cast(float, bbp << 16); pi[1] = __builtin_bit_cast(float, bbp & 0xffff0000u);
          if (PASS == 1) { unsigned* lp = (unsigned*)(LAB + (unsigned)((dir * 2 * MTOT + seq0 + t0 + tt) * D + c0 + 2 * cp)); lp[0] = labp; lp[(size_t)MTOT * D / 2] = bbp; } } }
    __syncthreads();
    const int sdir = tid >> 8, ssq = (tid >> 6) & 3, sch = tid & 63;
    const int tfirst = sdir == 0 ? 16 * ssq : 63 - 16 * ssq, tstep = sdir == 0 ? 1 : -1;
    LAS float* pa = GT + (sdir * 2) * 64 * 65 + sch; LAS float* pb = pa + 64 * 65;
    { float h = 0.f, ap = 1.f;
#pragma unroll
      for (int s = 0; s < 16; ++s) { const int tt = tfirst + tstep * s; const float av = pa[tt * 65]; h = av * h + pb[tt * 65]; ap *= av; }
      SA[((sdir * 4 + ssq) * 64 + sch) * 2] = ap; SA[((sdir * 4 + ssq) * 64 + sch) * 2 + 1] = h; }
    __syncthreads();
    if (PASS == 1) {
        if (tid < 128) { const int dir = tid >> 6; float h = 0.f, ap = 1.f;
#pragma unroll
            for (int s = 0; s < 4; ++s) { const float sa = SA[((dir * 4 + s) * 64 + ch) * 2], sb = SA[((dir * 4 + s) * 64 + ch) * 2 + 1]; h = sa * h + sb; ap *= sa; }
            *(f32x2*)(AGG + (((size_t)dir * NCHUNK + q) * D + c0 + ch) * 2) = (f32x2){ap, h}; }
    } else {
        float h = CIN[sdir * 64 + sch];
#pragma unroll
        for (int s = 0; s < 3; ++s) if (s < ssq) { const float sa = SA[((sdir * 4 + s) * 64 + sch) * 2], sb = SA[((sdir * 4 + s) * 64 + sch) * 2 + 1]; h = sa * h + sb; }
#pragma unroll
        for (int s = 0; s < 16; ++s) { const int tt = tfirst + tstep * s; h = pa[tt * 65] * h + pb[tt * 65]; pb[tt * 65] = h; }
        __syncthreads();
        bf16* YB = (bf16*)(a.ws + WS_YCAT) + (size_t)MTOT * D;
        { const int tt = tid >> 3, sg = tid & 7; const size_t row = (size_t)seq0 + t0 + tt; const v4u g = gg;
          const LAS float* hf = GT + (0 * 2 + 1) * 64 * 65 + tt * 65 + sg * 8; const LAS float* hb = GT + (1 * 2 + 1) * 64 * 65 + tt * 65 + sg * 8;
          v4u o; o.x = pk2(bflo(g.x) * (hf[0] + hb[0]), bfhi(g.x) * (hf[1] + hb[1])); o.y = pk2(bflo(g.y) * (hf[2] + hb[2]), bfhi(g.y) * (hf[3] + hb[3]));
          o.z = pk2(bflo(g.z) * (hf[4] + hb[4]), bfhi(g.z) * (hf[5] + hb[5])); o.w = pk2(bflo(g.w) * (hf[6] + hb[6]), bfhi(g.w) * (hf[7] + hb[7]));
          *(v4u*)(YB + row * D + c0 + sg * 8) = o; }
    }
}

__device__ __forceinline__ void lru_rows(const bf16* PR, int it, int tid, v4u (&rv)[2]) {
    const int q = it >> 4, hd = it & 15; const bool isctx = q >= 256; const int b = isctx ? (q - 256) >> 2 : q >> 5, qi = isctx ? (q - 256) & 3 : q & 31;
    const int L = isctx ? CTX : SEQ, seq0 = isctx ? MLAT + b * CTX : b * SEQ, t0 = qi * 64, c0 = hd * 64;
#pragma unroll
    for (int k = 0; k < 2; ++k) { const int i = tid + 512 * k, tr = (i >> 3) < 66 ? (i >> 3) : 66, sg = i & 7; int t = t0 - 2 + tr; t = t < 0 ? 0 : (t > L - 1 ? L - 1 : t);
        rv[k] = *(const v4u*)(PR + (unsigned)((seq0 + t) * NPR + PR_REC + c0 + sg * 8)); }
}
__device__ __forceinline__ void ph_lru1(const Args& a, const Frame& F, int l) {
    constexpr int PASS = 1;
    LAS float* raw = (LAS float*)F.lds;
    LAS float* xc = raw + 67 * 64;
    LAS float* GT = xc + 64 * 65;
    LAS float* SA = GT + 4 * 64 * 65;
    LAS float* CIN = SA + 2 * 4 * 64 * 2;
    LAS unsigned short* xcb = (LAS unsigned short*)(CIN + 128);
    const bf16* PR = (const bf16*)(a.ws + WS_PR);
    const int tid = F.tid, lane = F.lane, wave = F.wave, ch = tid & 63;
    const int fr = lane & 15, fq = lane >> 4, gdir = wave >> 2, gax = (wave >> 1) & 1, jb = (wave & 1) * 32;
    float* AGG = (float*)(a.ws + WS_AGG); bf16* LAB = (bf16*)(a.ws + WS_LAB);
    constexpr int NIT = NCHUNK * 16;
    if (F.vcu >= NIT) return;
    const int hd = F.vcu & 15, c0 = hd * 64;
    const float* cw = a.in[18] + (size_t)l * 4 * D + c0 + ch; const float cw0 = cw[0], cw1 = cw[D], cw2 = cw[2 * D], cw3 = cw[3 * D], cbb = a.in[19][(size_t)l * D + c0 + ch];
    const float* SP = (const float*)(a.ws + WS_SP) + (size_t)l * 2 * D + c0 + 2 * (tid & 31);
    const c2 spm0 = *(const c2*)SP * (c2){-8.0f, -8.0f}, spm1 = *(const c2*)(SP + D) * (c2){-8.0f, -8.0f};
    bf16x8 Bf[2][2]; f32x4 bv[2];
    { const bf16* Wc = (const bf16*)(a.ws + WS_WLRU) + (((size_t)l * 16 + hd) * 256 + 32 * wave) * 64;
#pragma unroll
      for (int nt = 0; nt < 2; ++nt)
#pragma unroll
          for (int ks = 0; ks < 2; ++ks) Bf[nt][ks] = *(const bf16x8*)(Wc + (nt * 16 + fr) * 64 + ks * 32 + fq * 8);
      const float* bias = (gax ? a.in[23] : a.in[21]) + ((size_t)l * 2 + gdir) * D + c0 + jb;
#pragma unroll
      for (int nt = 0; nt < 2; ++nt) bv[nt] = *(const f32x4*)(bias + nt * 16 + 4 * fq); }
    v4u rv[2];
    lru_rows(PR, F.vcu, tid, rv);
    for (int it = F.vcu; it < NIT; it += F.G) {
        const int q = it >> 4;
        const bool isctx = q >= 256; const int b = isctx ? (q - 256) >> 2 : q >> 5, qi = isctx ? (q - 256) & 3 : q & 31;
        const int L = isctx ? CTX : SEQ, seq0 = isctx ? MLAT + b * CTX : b * SEQ, t0 = qi * 64;
        __syncthreads();
#pragma unroll
        for (int k = 0; k < 2; ++k) { const int i = tid + 512 * k, t = t0 - 2 + (i >> 3); if (i < 67 * 8) { v4u r = rv[k]; if (t < 0 || t >= L) r = (v4u){0u, 0u, 0u, 0u};
            LAS float* d = raw + (i >> 3) * 64 + (i & 7) * 8; d[0] = bflo(r.x); d[1] = bfhi(r.x); d[2] = bflo(r.y); d[3] = bfhi(r.y); d[4] = bflo(r.z); d[5] = bfhi(r.z); d[6] = bflo(r.w); d[7] = bfhi(r.w); } }
        { const int itn = it + F.G < NIT ? it + F.G : it; lru_rows(PR, itn, tid, rv); }
        __syncthreads();
#pragma unroll
        for (int k = 0; k < 8; ++k) { const int tt = (tid >> 6) + 8 * k;
            const float x = cw0 * raw[tt * 64 + ch] + cw1 * raw[(tt + 1) * 64 + ch] + cw2 * raw[(tt + 2) * 64 + ch] + cw3 * raw[(tt + 3) * 64 + ch] + cbb;
            xc[tt * 65 + ch] = x; xcb[tt * 72 + ch] = (unsigned short)f2bf(x); }
        __syncthreads();
        {
          LAS float* gp = GT + (gdir * 2 + gax) * 64 * 65 + jb + 4 * fq;
#pragma unroll
          for (int mt = 0; mt < 4; ++mt) { f32x4 acc[2] = {bv[0], bv[1]};
#pragma unroll
              for (int ks = 0; ks < 2; ++ks) { const bf16x8 Af = *(const LAS bf16x8*)(xcb + (mt * 16 + fr) * 72 + ks * 32 + fq * 8);
#pragma unroll
                  for (int nt = 0; nt < 2; ++nt) acc[nt] = __builtin_amdgcn_mfma_f32_16x16x32_bf16(Bf[nt][ks], Af, acc[nt], 0, 0, 0); }
#pragma unroll
              for (int nt = 0; nt < 2; ++nt)
#pragma unroll
                  for (int r = 0; r < 4; ++r) gp[(mt * 16 + fr) * 65 + nt * 16 + r] = sigmoidf_(acc[nt][r]); } }
        __syncthreads();
        {
          const int cp = tid & 31;
#pragma unroll
          for (int k = 0; k < 8; ++k) { const int dir = k >> 2, tt = (tid >> 5) + 16 * (k & 3);
              LAS float* pr = GT + (dir * 2) * 64 * 65 + tt * 65 + 2 * cp; LAS float* pi = pr + 64 * 65;
              const c2 r = (c2){pr[0], pr[1]}, iv = (c2){pi[0], pi[1]}, xv = (c2){xc[tt * 65 + 2 * cp], xc[tt * 65 + 2 * cp + 1]};
              const c2 la = r * (dir ? spm1 : spm0);
              const unsigned labp = pg8::cvt_pk_bf16(la.x, la.y);
              const c2 lar = (c2){__builtin_bit_cast(float, labp << 16), __builtin_bit_cast(float, labp & 0xffff0000u)};
              const c2 ex = lar * (c2){1.4426950408889634f, 1.4426950408889634f};
              const c2 av = (c2){__builtin_amdgcn_exp2f(ex.x), __builtin_amdgcn_exp2f(ex.y)}, x2 = lar + lar;
              const c2 one = (c2){1.0f, 1.0f};
              const c2 pol = -(x2 * (one + x2 * ((c2){0.5f, 0.5f} + x2 * (c2){0.16666667f, 0.16666667f}))), sq = one - av * av;
              const c2 om = (c2){x2.x > -0.02f ? pol.x : sq.x, x2.y > -0.02f ? pol.y : sq.y};
              const c2 bv0 = (c2){__builtin_amdgcn_sqrtf(om.x), __builtin_amdgcn_sqrtf(om.y)} * (iv * xv);
              const unsigned bbp = pg8::cvt_pk_bf16(bv0.x, bv0.y);
              pr[0] = av.x; pr[1] = av.y; pi[0] = __builtin_bit_cast(float, bbp << 16); pi[1] = __builtin_bit_cast(float, bbp & 0xffff0000u);
              { unsigned* lp = (unsigned*)(LAB + (unsigned)((dir * 2 * MTOT + seq0 + t0 + tt) * D + c0 + 2 * cp)); lp[0] = labp; lp[(size_t)MTOT * D / 2] = bbp; } } }
        __syncthreads();
        const int sdir = tid >> 8, ssq = (tid >> 6) & 3, sch = tid & 63;
        const int tfirst = sdir == 0 ? 16 * ssq : 63 - 16 * ssq, tstep = sdir == 0 ? 1 : -1;
        LAS float* pa = GT + (sdir * 2) * 64 * 65 + sch; LAS float* pb = pa + 64 * 65;
        { float h = 0.f, ap = 1.f;
#pragma unroll
          for (int s = 0; s < 16; ++s) { const int tt = tfirst + tstep * s; const float av = pa[tt * 65]; h = av * h + pb[tt * 65]; ap *= av; }
          SA[((sdir * 4 + ssq) * 64 + sch) * 2] = ap; SA[((sdir * 4 + ssq) * 64 + sch) * 2 + 1] = h; }
        __syncthreads();

            if (tid < 128) { const int dir = tid >> 6; float h = 0.f, ap = 1.f;
#pragma unroll
                for (int s = 0; s < 4; ++s) { const float sa = SA[((dir * 4 + s) * 64 + ch) * 2], sb = SA[((dir * 4 + s) * 64 + ch) * 2 + 1]; h = sa * h + sb; ap *= sa; }
                *(f32x2*)(AGG + (((size_t)dir * NCHUNK + q) * D + c0 + ch) * 2) = (f32x2){ap, h}; }

    }
}
__device__ __forceinline__ void lru_item_p2(const Args& a, const Frame& F, int l, int q, int hd, int wit) {
    LAS float* GT = (LAS float*)F.lds;
    LAS float* SA = GT + 4 * 64 * 65;
    LAS float* CIN = SA + 2 * 4 * 64 * 2;
    const bf16* PR = (const bf16*)(a.ws + WS_PR); const bf16* LAB = (const bf16*)(a.ws + WS_LAB); const float* AGG = (const float*)(a.ws + WS_AGG);
    const bool isctx = q >= 256; const int b = isctx ? (q - 256) >> 2 : q >> 5, qi = isctx ? (q - 256) & 3 : q & 31;
    const int seq0 = isctx ? MLAT + b * CTX : b * SEQ, t0 = qi * 64, c0 = hd * 64;
    const int tid = F.tid, ch = tid & 63;
    v4u lv[4];
#pragma unroll
    for (int k = 0; k < 4; ++k) { const int tt = (tid >> 3) & 63, sg = tid & 7; lv[k] = *(const v4u*)(LAB + ((size_t)k * MTOT + seq0 + t0 + tt) * D + c0 + sg * 8); }
    const v4u gg = *(const v4u*)(PR + ((size_t)seq0 + t0 + (tid >> 3)) * NPR + PR_GELU + c0 + (tid & 7) * 8);
    float hcar = 0.f;
    if (tid < 128) { const int dir = tid >> 6; const float* ag = AGG + ((size_t)dir * NCHUNK) * D * 2 + (size_t)(c0 + ch) * 2;
        const int cbase = 256 + b * 4, lbase = b * 32;
        float ga[35], gb[35];
#pragma unroll
        for (int p = 0; p < 35; ++p) { int chunk; bool valid;
            if (isctx) { chunk = dir == 0 ? cbase + p : cbase + 3 - p; valid = dir == 0 ? p < qi : p < 3 - qi; }
            else if (p < 4) { chunk = dir == 0 ? cbase + p : cbase + 3 - p; valid = true; }
            else { chunk = dir == 0 ? lbase + (p - 4) : lbase + 31 - (p - 4); valid = dir == 0 ? (p - 4) < qi : (p - 4) < 31 - qi; }
            if (p >= 4 && isctx) valid = false;
            if (chunk < 0) chunk = 0; if (chunk > NCHUNK - 1) chunk = NCHUNK - 1;
            const f32x2 g = *(const f32x2*)(ag + (size_t)chunk * D * 2); ga[p] = valid ? g[0] : 1.f; gb[p] = valid ? g[1] : 0.f; }
#pragma unroll
        for (int p = 0; p < 35; ++p) hcar = ga[p] * hcar + gb[p]; }
    f32x4 wv[16]; unsigned char* wd = nullptr; size_t wK = 0; const bool have = wit < NITW;
    if (have) wx_load(a, l, wit, F.lane, wv, wd, wK);
    __syncthreads();
    { const int tt = tid >> 3, sg = tid & 7;
#pragma unroll
      for (int k = 0; k < 4; ++k) { LAS float* d = GT + k * 64 * 65 + tt * 65 + sg * 8; const v4u r = lv[k];
          float f[8] = {bflo(r.x), bfhi(r.x), bflo(r.y), bfhi(r.y), bflo(r.z), bfhi(r.z), bflo(r.w), bfhi(r.w)};
#pragma unroll
          for (int j = 0; j < 8; ++j) d[j] = (k & 1) ? f[j] : __expf(f[j]); } }
    if (tid < 128) CIN[tid] = hcar;
    __syncthreads();
    const int sdir = tid >> 8, ssq = (tid >> 6) & 3, sch = tid & 63;
    const int tfirst = sdir == 0 ? 16 * ssq : 63 - 16 * ssq, tstep = sdir == 0 ? 1 : -1;
    LAS float* pa = GT + (sdir * 2) * 64 * 65 + sch; LAS float* pb = pa + 64 * 65;
    float av[16], bw[16];
    { float h = 0.f, ap = 1.f;
#pragma unroll
      for (int s = 0; s < 16; ++s) { const int tt = tfirst + tstep * s; av[s] = pa[tt * 65]; bw[s] = pb[tt * 65]; h = av[s] * h + bw[s]; ap *= av[s]; }
      SA[((sdir * 4 + ssq) * 64 + sch) * 2] = ap; SA[((sdir * 4 + ssq) * 64 + sch) * 2 + 1] = h; }
    __syncthreads();
    { float h = CIN[sdir * 64 + sch];
#pragma unroll
      for (int s = 0; s < 3; ++s) if (s < ssq) { const float sa = SA[((sdir * 4 + s) * 64 + sch) * 2], sb = SA[((sdir * 4 + s) * 64 + sch) * 2 + 1]; h = sa * h + sb; }
#pragma unroll
      for (int s = 0; s < 16; ++s) { const int tt = tfirst + tstep * s; h = av[s] * h + bw[s]; pb[tt * 65] = h; } }
    __syncthreads();
    bf16* YB = (bf16*)(a.ws + WS_YCAT) + (size_t)MTOT * D;
    { const int tt = tid >> 3, sg = tid & 7; const size_t row = (size_t)seq0 + t0 + tt; const v4u g = gg;
      const LAS float* hf = GT + (0 * 2 + 1) * 64 * 65 + tt * 65 + sg * 8; const LAS float* hb = GT + (1 * 2 + 1) * 64 * 65 + tt * 65 + sg * 8;
      v4u o; o.x = pk2(bflo(g.x) * (hf[0] + hb[0]), bfhi(g.x) * (hf[1] + hb[1])); o.y = pk2(bflo(g.y) * (hf[2] + hb[2]), bfhi(g.y) * (hf[3] + hb[3]));
      o.z = pk2(bflo(g.z) * (hf[4] + hb[4]), bfhi(g.z) * (hf[5] + hb[5])); o.w = pk2(bflo(g.w) * (hf[6] + hb[6]), bfhi(g.w) * (hf[7] + hb[7]));
      *(v4u*)(YB + row * D + c0 + sg * 8) = o; }
    if (have) wx_store(wv, wd, wK, F.lane);
}
#ifndef REP_LRU1
#define REP_LRU1 1
#endif
#ifndef REP_HY
#define REP_HY 1
#endif
#ifndef REP_CTX
#define REP_CTX 1
#endif
#ifndef REP_SC
#define REP_SC 1
#endif
#ifndef REP_LRU2
#define REP_LRU2 1
#endif
#ifndef REP_TR
#define REP_TR 1
#endif
#ifndef REP_NORM2
#define REP_NORM2 1
#endif
#ifndef REP_RANK
#define REP_RANK 1
#endif
#ifndef MK_SINGLE
#define MK_SINGLE 1
#endif
__global__ void __launch_bounds__(512, 2) mk_fwd(Args args) {
    extern __shared__ __attribute__((aligned(16))) unsigned char lds[];
    Frame F;
    F.lds = (LAS unsigned char*)lds;
    F.tid = threadIdx.x; F.lane = F.tid & 63; F.wave = __builtin_amdgcn_readfirstlane(F.tid >> 6);
    F.G = gridDim.x; { const int bx = blockIdx.x; F.vcu = (F.G % 8 == 0) ? (bx % 8) * (F.G / 8) + bx / 8 : bx; }
    volatile LAS unsigned* MISC = (volatile LAS unsigned*)(F.lds + MISC_OFF);
    for (int u = F.tid; u < 32; u += 512) MISC[u] = 0u;
    __syncthreads();
    unsigned* ctl = (unsigned*)(args.ws + WS_CTL);
    XcdBarrier bar; bar.bar = ctl + CW_BAR + args.li * XCD_BAR_WORDS; bar.x = 0; bar.st = nullptr;
    if (MK_SINGLE) bar = xcd_barrier_post(ctl + CW_BAR + args.li * XCD_BAR_WORDS, MISC + 8);
    const int lo = args.ph_lo, hi = args.ph_hi;
#define IN(k) (lo <= (k) && (k) < hi)
#define SEAM(k) do { if (MK_SINGLE && IN((k) + 1)) xcd_barrier(bar); } while (0)
    const int bid = (int)blockIdx.x; const int vcu0 = F.vcu, G0 = F.G;
#define LAUNDER() do { int t_ = threadIdx.x; asm volatile("" : "+v"(t_)); F.tid = t_; F.lane = t_ & 63; F.wave = __builtin_amdgcn_readfirstlane(t_ >> 6); int g_ = G0, v_ = vcu0; asm volatile("" : "+s"(g_), "+s"(v_)); F.G = g_; F.vcu = v_; } while (0)
    LAS unsigned char* ring = F.lds;

    if (IN(0)) { LAUNDER(); ph_prologue(args, F); SEAM(0); }
    if (IN(1)) { LAUNDER(); ph_filters(args, F); SEAM(1); }
#pragma unroll 1
    for (int l = 0; l < 2; ++l) {
        const int pb = 2 + 10 * l;
        const int mrows = l == 0 ? MTOT : MLAT;
        bf16* WIN = (bf16*)(args.ws + WS_WIN) + (size_t)l * NIN * D; bf16* WOUT = (bf16*)(args.ws + WS_WOUT) + (size_t)l * 4 * D * D;
        bf16* H = (bf16*)(args.ws + WS_H); bf16* PR = (bf16*)(args.ws + WS_PR); bf16* YCAT = (bf16*)(args.ws + WS_YCAT);
        if (IN(pb + 0)) {
            LAUNDER();
            if (l == 0) ph_norm<0, false>(args, F, l); else ph_norm<0, true>(args, F, l);
            SEAM(pb + 0);
        }
        if (IN(pb + 1)) {
            { pg8::Gemm g{WIN, H, NHY, mrows, D}; RectOrder S; S.init(NHY / 256, mrows / 256, 0, 0, 0, 0, F.G, bid);
              EpiPlainBf16 E{(bf16*)(args.ws + WS_HYT), MTOT};
              pg8::gemm_phase<EpiPlainBf16, RectOrder, true, true>(ring, g, S, E); }
            { pg8::Gemm g{H, WIN + (size_t)NHY * D, MTOT, N2, D}; RectOrder S;
              if (l == 0) S.init(MTOT / 256, N2 / 256, 0, 0, 0, 0, F.G, bid); else S.init(MLAT / 256, N2 / 256, MCTX / 256, 4, MLAT / 256, 4, F.G, bid);
              EpiInProj E{PR};
              pg8::gemm_phase<EpiInProj, RectOrder, true, true>(ring, g, S, E); }
            SEAM(pb + 1);
        }
        if (IN(pb + 2)) {
            LAUNDER();
            for (int rep = 0; rep < REP_LRU1; ++rep) { if ((F.G & 15) == 0) ph_lru1(args, F, l); else for (int it = F.vcu; it < NCHUNK * 16; it += F.G) lru_item<1>(args, F, l, it >> 4, it & 15); }
            __syncthreads();
            LAUNDER();
            for (int rep = 0; rep < REP_HY; ++rep) ph_hyena_fft(args, F, l);
            LAUNDER();
            if (l == 0) for (int rep = 0; rep < REP_CTX; ++rep) ph_hyena_ctx(args, F, l);
            SEAM(pb + 2);
        }
        if (IN(pb + 3)) {
            LAUNDER();
            for (int rep = 0; rep < REP_TR; ++rep) ph_transpose_ya(args, F, mrows);
            __syncthreads();
            LAUNDER();
            {
              int wit = F.vcu * 8 + F.wave; const int NGW = F.G * 8;
              for (int it = F.vcu; it < (mrows / LCH) * 16; it += F.G) { lru_item_p2(args, F, l, it >> 4, it & 15, wit); wit += NGW; }
              for (; wit < NITW; wit += NGW) { f32x4 wv[16]; unsigned char* wd; size_t wK; wx_load(args, l, wit, F.lane, wv, wd, wK); wx_store(wv, wd, wK, F.lane); } }
            LAUNDER();
            for (int rep = 0; rep < REP_SC; ++rep) ph_sc(args, F, l, mrows);
            SEAM(pb + 3);
        }
        const bool redeal = MK_SINGLE && l == 0 && F.G == 256 && IN(pb + 4) && IN(pb + 5) && IN(pb + 6);
        if (redeal) {
            bf16* MB = (bf16*)(args.ws + WS_MB);
            const pg8::Gemm gg{YCAT, WOUT, 3 * MTOT, 3 * D, D}; const EpiGate3 EG{PR + PR_GATE, MB, MTOT / 256};
            const pg8::Gemm gw{MB, WOUT + 3ull * D * D, MTOT, D, D};
            const EpiResid ER{(float*)(args.ws + WS_X), (const float*)(args.ws + WS_MOD) + (size_t)l * 9 * 6144 + 2 * 1024};
            { TripleOrder S; S.init(MLAT / 256, MTOT / 256, F.G, bid); pg8::gemm_phase<EpiGate3, TripleOrder, true, true>(ring, gg, S, EG); }
            xcd_barrier(bar);
            if (bid < 32) { ListOrder S; S.init(0, bid, MTOT / 256); pg8::gemm_phase<EpiGate3, ListOrder, true, true>(ring, gg, S, EG); }
            else { ListOrder S; S.init(1, bid - 32, 0); pg8::gemm_phase<EpiResid, ListOrder, true, true>(ring, gw, S, ER); }
            xcd_barrier(bar);
            if (bid < 32) { ListOrder S; S.init(2, bid, 0); pg8::gemm_phase<EpiResid, ListOrder, true, true>(ring, gw, S, ER); }
            else { LAUNDER(); Frame F2 = F; F2.vcu = bid - 32; F2.G = 224; ph_norm<1, false>(args, F2, l, 0, MLAT); }
            xcd_barrier(bar);
            LAUNDER();
            ph_norm<1, false>(args, F, l, MLAT, MTOT);
            SEAM(pb + 6);
        }
        if (!redeal && IN(pb + 4)) {
            bf16* MB = (bf16*)(args.ws + WS_MB);
            TripleOrder S; S.init(mrows / 256, MTOT / 256, F.G, bid);
            pg8::Gemm g{YCAT, WOUT, 3 * MTOT, 3 * D, D}; EpiGate3 E{PR + PR_GATE, MB, MTOT / 256};
            pg8::gemm_phase<EpiGate3, TripleOrder, true, true>(ring, g, S, E);
            SEAM(pb + 4);
        }
        if (!redeal && IN(pb + 5)) {
            pg8::Gemm g{(bf16*)(args.ws + WS_MB), WOUT + 3ull * D * D, mrows, D, D}; RectOrder S; S.init(mrows / 256, 4, 0, 0, 0, 0, F.G, bid);
            EpiResid E{(float*)(args.ws + WS_X), (const float*)(args.ws + WS_MOD) + (size_t)l * 9 * 6144 + 2 * 1024};
            pg8::gemm_phase<EpiResid, RectOrder, true, true>(ring, g, S, E);
            SEAM(pb + 5);
        }
        if (!redeal && IN(pb + 6)) { LAUNDER(); for (int rep = 0; rep < REP_NORM2; ++rep) ph_norm<1, false>(args, F, l); SEAM(pb + 6); }
        if (IN(pb + 7)) { LAUNDER(); for (int rep = 0; rep < REP_RANK; ++rep) ph_rank(args, F, l); SEAM(pb + 7); }
        if (IN(pb + 8)) {
            pg8::Gemm g{(bf16*)(args.ws + WS_XS), (bf16*)(args.ws + WS_WGU + (size_t)l * NE * NGU * D), NE * EROWS, NE * NGU, D / 2}; GroupOrder S; S.init(NE, l == 0 ? 9 : 8, 9, 22, F.G, bid);
            EpiSwiglu E{args.ws + WS_HID};
            pg8::gemm_phase<EpiSwiglu, GroupOrder, true, true, true>(ring, g, S, E);
            SEAM(pb + 8);
        }
        if (IN(pb + 9)) {
            pg8::Gemm g{(bf16*)(args.ws + WS_HID), (bf16*)(args.ws + WS_WD + (size_t)l * NE * D * DE), NE * EROWS, NE * D, DE / 2}; GroupOrder S; S.init(NE, l == 0 ? 9 : 8, 9, 4, F.G, bid);
            EpiYs E{(bf16*)(args.ws + WS_YS)};
            pg8::gemm_phase<EpiYs, GroupOrder, true, true, true>(ring, g, S, E);
            SEAM(pb + 9);
        }
    }
    if (IN(22)) { LAUNDER(); ph_norm<2, true>(args, F, 1); }
#undef IN
#undef SEAM
}

extern "C" void kernel_launch(void* const* d_in, const int* in_sizes, int n_in, void* d_out, int out_size, void* d_ws, size_t ws_size, hipStream_t stream) {
    static int grid = 0;
    if (grid == 0) {
        if (n_in != 35 || out_size != MLAT * D || ws_size < WS_END) { fprintf(stderr, "kernel_launch: unexpected shapes (n_in %d, out %d, ws %zu < %zu)\n", n_in, out_size, ws_size, (size_t)WS_END); grid = -1; return; }
        int dev = 0, cus = 0, per_cu = 0;
        if (hipGetDevice(&dev) != hipSuccess || hipDeviceGetAttribute(&cus, hipDeviceAttributeMultiprocessorCount, dev) != hipSuccess) { grid = -1; return; }
        if (hipFuncSetAttribute((const void*)mk_fwd, hipFuncAttributeMaxDynamicSharedMemorySize, LDS_BYTES) != hipSuccess) { fprintf(stderr, "kernel_launch: hipFuncSetAttribute failed\n"); grid = -1; return; }
        if (hipOccupancyMaxActiveBlocksPerMultiprocessor(&per_cu, (const void*)mk_fwd, 512, LDS_BYTES) != hipSuccess || per_cu < 1) fprintf(stderr, "kernel_launch: occupancy query says %d\n", per_cu);
        (void)hipGetLastError();
        grid = cus;
    }
    if (grid < 0) return;
    if (hipMemsetAsync((char*)d_ws + WS_CTL, 0, CTL_ZERO_BYTES, stream) != hipSuccess) return;
    Args a{};
    for (int i = 0; i < 35; ++i) a.in[i] = (const float*)d_in[i];
    a.out = (float*)d_out; a.ws = (unsigned char*)d_ws; a.pad = 0;
#if defined(PROBE_LO)
    a.ph_lo = 0; a.ph_hi = PROBE_HI; a.li = 0; hipLaunchKernelGGL(mk_fwd, dim3(grid), dim3(512), LDS_BYTES, stream, a);
    a.ph_lo = PROBE_LO; a.ph_hi = NPHASE; a.li = 1; hipLaunchKernelGGL(mk_fwd, dim3(grid), dim3(512), LDS_BYTES, stream, a);
#elif MK_SINGLE
    a.ph_lo = 0; a.ph_hi = NPHASE; a.li = 0;
    hipLaunchKernelGGL(mk_fwd, dim3(grid), dim3(512), LDS_BYTES, stream, a);
#else
    for (int p = 0; p < NPHASE; ++p) { a.ph_lo = p; a.ph_hi = p + 1; a.li = 0; hipLaunchKernelGGL(mk_fwd, dim3(grid), dim3(512), LDS_BYTES, stream, a); }
#endif
}
```
